# Optimizing an MI355X kernel written in HIP

```python
import math
import jax, jax.numpy as jnp
from jax import lax
import numpy as np

D_MODEL = 2048
BATCH = 1
SEQ = 8192
DEPTH = 2
DEC_BATCH = 16
DEC_SEQ = 2048
PAST_LEN = 128

HEAD_DIM = 128
A_HEADS = 6
A_KV_HEADS = 2
B_HEADS = 6
B_PAIRS = ((128, 1), (512, 4), (2048, 16))
B_HEADS_PER_PAIR = 2
C_HEADS = 4
C_DK = 64
C_DV = 128
C_GATE_RANK = 16
C_GATE_NORM = 16.0
C_CHUNK = 16
GRID_W = 64
ROPE_THETA = 10000.0
Q_BLOCK = 128
REL_BUCKETS = 32
REL_MAX_DIST = 1024
N_EXPERTS = 16
EC_CAPACITY = 2
D_FF_EXPERT = 2048
DN_ALPHA = (2 * DEPTH) ** 0.25
DN_BETA = (8 * DEPTH) ** -0.25
LN_EPS = 1e-5
RMS_EPS = 1e-6
NEG_INF = -1e30

A_W = A_HEADS * HEAD_DIM
A_KV_W = A_KV_HEADS * HEAD_DIM
B_W = B_HEADS * HEAD_DIM
C_K_W = C_HEADS * C_DK
C_V_W = C_HEADS * C_DV
D_MIX = A_W + B_W + C_V_W
IN_SIZES = (A_W, A_KV_W, A_KV_W, B_W, B_W, B_W, C_K_W, C_K_W, C_V_W, C_V_W, C_GATE_RANK, C_GATE_RANK)
D_IN = 5152

kernel_name = "hybrid_bidir_encoder_gqa_dilated_gla_ec"

f32 = jnp.float32


def layer_norm(x, g, b):
    xf = x.astype(f32)
    mu = jnp.mean(xf, -1, keepdims=True)
    var = jnp.mean(jnp.square(xf - mu), -1, keepdims=True)
    return ((xf - mu) * lax.rsqrt(var + LN_EPS) * g.astype(f32) + b.astype(f32)).astype(x.dtype)


def rms_norm(x, g):
    xf = x.astype(f32)
    return xf * lax.rsqrt(jnp.mean(xf * xf, -1, keepdims=True) + RMS_EPS) * g.astype(f32)


def split_columns(proj):
    outs, start = [], 0
    for size in IN_SIZES:
        outs.append(proj[..., start:start + size])
        start += size
    return outs


def axial_rope_tables(T):
    rows = T // GRID_W
    r = jnp.broadcast_to(jnp.arange(rows)[:, None], (rows, GRID_W)).reshape(T).astype(f32)
    c = jnp.broadcast_to(jnp.arange(GRID_W)[None, :], (rows, GRID_W)).reshape(T).astype(f32)
    axis_dim = HEAD_DIM // 2
    inv = ROPE_THETA ** (-jnp.arange(0, axis_dim, 2, dtype=f32) / axis_dim)
    ang_r = r[:, None] * inv[None, :]
    ang_c = c[:, None] * inv[None, :]
    return jnp.cos(ang_r), jnp.sin(ang_r), jnp.cos(ang_c), jnp.sin(ang_c)


def rope_half(x, cos, sin):
    h = x.shape[-1] // 2
    x1, x2 = x[..., :h], x[..., h:]
    c = cos[:, None, :]
    s = sin[:, None, :]
    return jnp.concatenate([x1 * c - x2 * s, x1 * s + x2 * c], -1)


def apply_axial_rope(x, tabs):
    cr, sr, cc, sc = tabs
    h = HEAD_DIM // 2
    return jnp.concatenate([rope_half(x[..., :h], cr, sr), rope_half(x[..., h:], cc, sc)], -1)


def mixer_a(q, k, v, qn_g, kn_g):
    Bt, T = q.shape[:2]
    dt = q.dtype
    tabs = axial_rope_tables(T)
    q = (apply_axial_rope(rms_norm(q, qn_g), tabs) * HEAD_DIM ** -0.5).astype(dt)
    k = apply_axial_rope(rms_norm(k, kn_g), tabs).astype(dt)
    grp = A_HEADS // A_KV_HEADS
    nb = T // Q_BLOCK
    qb = q.reshape(Bt, nb, Q_BLOCK, A_KV_HEADS, grp, HEAD_DIM).transpose(1, 0, 2, 3, 4, 5)

    def block(qi):
        s = jnp.einsum('bqkgd,bskd->bkgqs', qi, k, preferred_element_type=f32)
        p = jax.nn.softmax(s, axis=-1).astype(dt)
        return jnp.einsum('bkgqs,bskd->bqkgd', p, v)

    o = lax.map(block, qb)
    return o.transpose(1, 0, 2, 3, 4, 5).reshape(Bt, T, A_W)


def t5_bucket(rel):
    half = REL_BUCKETS // 2
    max_exact = half // 2
    n = jnp.abs(rel)
    large = max_exact + (jnp.log(jnp.maximum(n, 1).astype(f32) / max_exact)
                         / math.log(REL_MAX_DIST / max_exact) * (half - max_exact)).astype(jnp.int32)
    large = jnp.minimum(large, half - 1)
    return jnp.where(rel > 0, half, 0) + jnp.where(n < max_exact, n, large)


def dilated_group(q, k, v, bias_table, window, dil):
    Bt, T, h, hd = q.shape
    R = (window // 2) // dil
    L = T // dil
    nb = -(-L // R)
    Lp = nb * R
    N = Bt * dil

    def to_sub(x):
        x = x.reshape(Bt, L, dil, h, hd).transpose(0, 2, 1, 3, 4).reshape(N, L, h, hd)
        return jnp.pad(x, ((0, 0), (0, Lp - L), (0, 0), (0, 0)))

    def key_blocks(x):
        xb = jnp.pad(to_sub(x).reshape(N, nb, R, h, hd), ((0, 0), (1, 1), (0, 0), (0, 0), (0, 0)))
        return jnp.concatenate([xb[:, :-2], xb[:, 1:-1], xb[:, 2:]], axis=2)

    qs = to_sub(q).reshape(N, nb, R, h, hd)
    ks = key_blocks(k)
    vs = key_blocks(v)
    rel = jnp.arange(3 * R)[None, :] - R - jnp.arange(R)[:, None]
    u_k = jnp.arange(nb)[:, None] * R - R + jnp.arange(3 * R)[None, :]
    valid = (jnp.abs(rel) <= R)[None] & ((u_k >= 0) & (u_k < L))[:, None, :]
    bias = bias_table.astype(f32)[t5_bucket(rel * dil)].transpose(2, 0, 1)
    s = jnp.einsum('nbqhd,nbkhd->nbhqk', qs, ks, preferred_element_type=f32) * hd ** -0.5 + bias[None, None]
    s = jnp.where(valid[None, :, None], s, NEG_INF)
    m = jnp.max(s, -1, keepdims=True)
    p = jnp.exp(s - m)
    den = jnp.sum(p, -1, keepdims=True)
    o = jnp.einsum('nbhqk,nbkhd->nbqhd', (p / den).astype(q.dtype), vs)
    lse = (m + jnp.log(den))[..., 0]
    o = o.reshape(Bt, dil, Lp, h, hd)[:, :, :L].transpose(0, 2, 1, 3, 4).reshape(Bt, T, h, hd)
    lse = lse.transpose(0, 1, 3, 2).reshape(Bt, dil, Lp, h)[:, :, :L].transpose(0, 2, 1, 3).reshape(Bt, T, h)
    return o, lse


def mixer_b(q, k, v, rel_bias):
    Bt, T = q.shape[:2]
    outs, lses = [], []
    for g, (window, dil) in enumerate(B_PAIRS):
        hs = slice(g * B_HEADS_PER_PAIR, (g + 1) * B_HEADS_PER_PAIR)
        o, l = dilated_group(q[:, :, hs], k[:, :, hs], v[:, :, hs], rel_bias[:, hs], window, dil)
        outs.append(o)
        lses.append(l)
    o = jnp.stack(outs, 2)
    wts = jax.nn.softmax(jnp.stack(lses, 2), axis=2)
    return (o * wts[..., None].astype(o.dtype)).reshape(Bt, T, B_W)


def gla_direction(q, k, v, log_a):
    Bt, T, H, dk = q.shape
    dv = v.shape[-1]
    nc = T // C_CHUNK
    q, k, log_a = (x.reshape(Bt, nc, C_CHUNK, H, dk) for x in (q, k, log_a))
    v = v.reshape(Bt, nc, C_CHUNK, H, dv)
    b = jnp.cumsum(log_a, axis=2)
    tri = jnp.tril(jnp.ones((C_CHUNK, C_CHUNK), bool))
    diff = b[:, :, :, None] - b[:, :, None, :]
    decay = jnp.exp(jnp.where(tri[None, None, :, :, None, None], diff, -jnp.inf))
    att = jnp.einsum('bnthk,bnshk,bntshk->bnhts', q, k, decay)
    o_intra = jnp.einsum('bnhts,bnshv->bnthv', att, v)
    b_last = b[:, :, -1]
    du = jnp.einsum('bnshk,bnshv->bnhkv', k * jnp.exp(b_last[:, :, None] - b), v)

    def step(S, inp):
        a, u = inp
        return a[..., None] * S + u, S

    S0 = jnp.zeros((Bt, H, dk, dv), f32)
    _, S_prev = lax.scan(step, S0, (jnp.exp(b_last).transpose(1, 0, 2, 3), du.transpose(1, 0, 2, 3, 4)))
    o_inter = jnp.einsum('bnthk,nbhkv->bnthv', q * jnp.exp(b), S_prev)
    return (o_intra + o_inter).reshape(Bt, T, H, dv)


def mixer_c(q, k, v, g, zf, zb, wf, bf, wb, bb, norm_g):
    Bt, T = q.shape[:2]
    dt = q.dtype
    q = q.astype(f32).reshape(Bt, T, C_HEADS, C_DK) * C_DK ** -0.5
    k = k.astype(f32).reshape(Bt, T, C_HEADS, C_DK)
    v = v.astype(f32).reshape(Bt, T, C_HEADS, C_DV)

    def log_decay(z, w, bias):
        pre = jnp.einsum('btr,rk->btk', z.astype(f32), w.astype(f32)) + bias.astype(f32)
        return (jax.nn.log_sigmoid(pre) / C_GATE_NORM).reshape(Bt, T, C_HEADS, C_DK)

    flip = lambda a: a[:, ::-1]
    o_f = gla_direction(q, k, v, log_decay(zf, wf, bf))
    o_b = flip(gla_direction(flip(q), flip(k), flip(v), flip(log_decay(zb, wb, bb))))
    o = rms_norm(o_f + o_b, norm_g)
    gate = jax.nn.silu(g.astype(f32)).reshape(Bt, T, C_HEADS, C_DV)
    return (o * gate).reshape(Bt, T, C_V_W).astype(dt)


def expert_choice_ffn(h, w_router, w_gate, w_up, w_down):
    Bt, T, D = h.shape
    n = Bt * T
    cap = EC_CAPACITY * n // N_EXPERTS
    xf = h.reshape(n, D)
    aff = jax.nn.softmax(jnp.einsum('nd,de->ne', xf, w_router, preferred_element_type=f32), axis=-1)
    gate, idx = lax.top_k(aff.T, cap)
    xe = xf[idx]
    hid = jax.nn.silu(jnp.einsum('ecd,edf->ecf', xe, w_gate)) * jnp.einsum('ecd,edf->ecf', xe, w_up)
    ye = jnp.einsum('ecf,efd->ecd', hid, w_down) * gate[..., None].astype(h.dtype)
    y = jnp.zeros((n, D), h.dtype).at[idx.reshape(-1)].add(ye.reshape(-1, D))
    return y.reshape(Bt, T, D)


def trunk(x, ln_in_g, ln_in_b, rel_bias, w_in, q_norm_a, k_norm_a, gla_wf, gla_bf, gla_wb, gla_bb,
          gla_norm, w_out, ln1_g, ln1_b, w_router, w_gate, w_up, w_down, ln2_g, ln2_b):
    Bt, T, _ = x.shape
    x = layer_norm(x, ln_in_g, ln_in_b)
    for l in range(DEPTH):
        proj = jnp.einsum('btd,de->bte', x, w_in[l])
        aq, ak, av, bq, bk, bv, cq, ck, cv, cg, czf, czb = split_columns(proj)
        o_a = mixer_a(aq.reshape(Bt, T, A_HEADS, HEAD_DIM), ak.reshape(Bt, T, A_KV_HEADS, HEAD_DIM),
                      av.reshape(Bt, T, A_KV_HEADS, HEAD_DIM), q_norm_a[l], k_norm_a[l])
        o_b = mixer_b(bq.reshape(Bt, T, B_HEADS, HEAD_DIM), bk.reshape(Bt, T, B_HEADS, HEAD_DIM),
                      bv.reshape(Bt, T, B_HEADS, HEAD_DIM), rel_bias)
        o_c = mixer_c(cq, ck, cv, cg, czf, czb, gla_wf[l], gla_bf[l], gla_wb[l], gla_bb[l], gla_norm[l])
        mix = jnp.einsum('btm,md->btd', jnp.concatenate([o_a, o_b, o_c], -1), w_out[l])
        x = layer_norm(DN_ALPHA * x + mix, ln1_g[l], ln1_b[l])
        ffn = expert_choice_ffn(x, w_router[l], w_gate[l], w_up[l], w_down[l])
        x = layer_norm(DN_ALPHA * x + ffn, ln2_g[l], ln2_b[l])
    return x


def setup_inputs(seed: int = 0) -> dict:
    key = jax.random.key(seed)
    ks = jax.random.split(key, 24)
    nrm = lambda k, shape, scale: jax.random.normal(k, shape, f32) * scale
    gain = lambda k, shape: 1.0 + 0.02 * jax.random.normal(k, shape, f32)
    return {
        "x_prompt": nrm(ks[0], (BATCH, SEQ, D_MODEL), 1.0),
        "x_sample": nrm(ks[1], (DEC_BATCH, DEC_SEQ, D_MODEL), 1.0),
        "ln_in_g": gain(ks[2], (D_MODEL,)),
        "ln_in_b": nrm(ks[3], (D_MODEL,), 0.02),
        "rel_bias": nrm(ks[4], (REL_BUCKETS, B_HEADS), 0.5),
        "w_in": nrm(ks[5], (DEPTH, D_MODEL, D_IN), D_MODEL ** -0.5),
        "q_norm_a": gain(ks[6], (DEPTH, HEAD_DIM)),
        "k_norm_a": gain(ks[7], (DEPTH, HEAD_DIM)),
        "gla_wf": nrm(ks[8], (DEPTH, C_GATE_RANK, C_K_W), C_GATE_RANK ** -0.5),
        "gla_bf": nrm(ks[9], (DEPTH, C_K_W), 0.1),
        "gla_wb": nrm(ks[10], (DEPTH, C_GATE_RANK, C_K_W), C_GATE_RANK ** -0.5),
        "gla_bb": nrm(ks[11], (DEPTH, C_K_W), 0.1),
        "gla_norm": gain(ks[12], (DEPTH, C_DV)),
        "w_out": nrm(ks[13], (DEPTH, D_MIX, D_MODEL), DN_BETA * D_MIX ** -0.5),
        "ln1_g": gain(ks[14], (DEPTH, D_MODEL)),
        "ln1_b": nrm(ks[15], (DEPTH, D_MODEL), 0.02),
        "w_router": nrm(ks[16], (DEPTH, D_MODEL, N_EXPERTS), D_MODEL ** -0.5),
        "w_gate": nrm(ks[17], (DEPTH, N_EXPERTS, D_MODEL, D_FF_EXPERT), D_MODEL ** -0.5),
        "w_up": nrm(ks[18], (DEPTH, N_EXPERTS, D_MODEL, D_FF_EXPERT), D_MODEL ** -0.5),
        "w_down": nrm(ks[19], (DEPTH, N_EXPERTS, D_FF_EXPERT, D_MODEL), DN_BETA * D_FF_EXPERT ** -0.5),
        "ln2_g": gain(ks[20], (DEPTH, D_MODEL)),
        "ln2_b": nrm(ks[21], (DEPTH, D_MODEL), 0.02),
    }


def reference(x_prompt, x_sample, ln_in_g, ln_in_b, rel_bias, w_in, q_norm_a, k_norm_a, gla_wf, gla_bf,
              gla_wb, gla_bb, gla_norm, w_out, ln1_g, ln1_b, w_router, w_gate, w_up, w_down, ln2_g, ln2_b):
    y_prompt = trunk(x_prompt, ln_in_g, ln_in_b, rel_bias, w_in, q_norm_a, k_norm_a, gla_wf, gla_bf,
                     gla_wb, gla_bb, gla_norm, w_out, ln1_g, ln1_b, w_router, w_gate, w_up, w_down, ln2_g, ln2_b)
    y_sample = trunk(x_sample, ln_in_g, ln_in_b, rel_bias, w_in, q_norm_a, k_norm_a, gla_wf, gla_bf,
                     gla_wb, gla_bb, gla_norm, w_out, ln1_g, ln1_b, w_router, w_gate, w_up, w_down, ln2_g, ln2_b)
    return (y_prompt, y_sample)
```

```cpp
#include <hip/hip_runtime.h>
#include <hip/hip_bf16.h>
#include <cstdio>
#include <cstdint>
#include <cmath>

constexpr int D = 2048, TP = 8192, NSAMP = 16, TS = 2048, M = TP + NSAMP * TS  , DEPTH = 2;
constexpr int DIN = 5152, DIN_PAD = 5376, PP = 5152  ;
constexpr int C_AQ = 0, C_AK = 768, C_AV = 1024, C_BQ = 1280, C_BK = 2048, C_BV = 2816, C_CQ = 3584, C_CK = 3840, C_CV = 4096, C_CG = 4608, C_ZF = 5120, C_ZB = 5136;
constexpr int MIX_B = 768, MIX_C = 1536;
constexpr int NEXP = 16, XE_PER_E = 5120  , XE_ROWS = NEXP * XE_PER_E, DFF = 2048;
constexpr float LN_EPS = 1e-5f, RMS_EPS = 1e-6f, DN_ALPHA = 1.41421356237309515f  ;
constexpr int NCHUNK = M / 64;
__host__ __device__ __forceinline__ int seq_start(int s) { return s == 0 ? 0 : TP + (s - 1) * TS; }
__host__ __device__ __forceinline__ int seq_len(int s) { return s == 0 ? TP : TS; }
namespace pg8 {
#define PG8_LAS __attribute__((address_space(3)))
typedef unsigned short bf16_t;
typedef short bf16x8 __attribute__((ext_vector_type(8)));
typedef float f32x4 __attribute__((ext_vector_type(4)));
typedef unsigned u32x4 __attribute__((ext_vector_type(4)));
constexpr int BM = 256, BK = 64, HALF = 128, HTB = HALF * BK * 2  , STAGE_BYTES = 8 * HTB, NXCD = 8, WGM = 8;

__host__ __device__ __forceinline__ int lds_byte(int r, int c) { const int st = (r >> 4) * 2 + (c >> 5), rr = r & 15, cc = c & 31, ob = rr * 64 + cc * 2; return st * 1024 + (ob ^ (((ob >> 9) & 1) << 5)); }
__host__ __device__ __forceinline__ void stage_rc(int b, int& R, int& C) { const int st = b / 1024, sb = b % 1024, swz = sb ^ (((sb >> 9) & 1) << 5); R = (st >> 1) * 16 + swz / 64; C = (st & 1) * 32 + (swz % 64) / 2; }
__host__ __device__ __forceinline__ int perm32(int rho) { const int n = rho >> 4, i = rho & 15; return 8 * (i >> 2) + 4 * n + (i & 3); }
typedef int i32x4_t __attribute__((ext_vector_type(4)));
typedef float f32x2 __attribute__((ext_vector_type(2)));
typedef int i32x8_t __attribute__((ext_vector_type(8)));
struct Unit { int pm, pn, e; };
struct Gemm { const bf16_t* A; const bf16_t* Bt; int M, N, K; size_t bstride; };

struct StaticOrder {
    int nM, nN, nwg, G, c, tpe; int same = 0;
    __host__ __device__ void init(int M, int N, int G_, int c_, int tpe_ = 0) { nM = M / BM; nN = N / BM; nwg = nM * nN; G = G_; c = c_; tpe = tpe_; }
    __host__ __device__ bool next(int i, Unit& u) const {
        const long L = same ? (i < same ? (long)c : (long)nwg) : (long)i * G + c; if (L >= nwg) return false;
        int wgid = (int)L; { const int q = nwg / NXCD, r = nwg % NXCD, xcd = wgid % NXCD, off = wgid / NXCD; wgid = (xcd < r ? xcd * (q + 1) : r * (q + 1) + (xcd - r) * q) + off; }
        const int nig = WGM * nN, gid = wgid / nig, fm = gid * WGM, gsz = (nM - fm) < WGM ? (nM - fm) : WGM;
        u.pm = fm + ((wgid % nig) % gsz); u.pn = (wgid % nig) / gsz; u.e = tpe ? u.pm / tpe : 0; return true;
    }
    __device__ __forceinline__ void a_ready(const Unit&) const {}
    __device__ __forceinline__ void done(const Unit&) const {}
};
__device__ __forceinline__ unsigned cvt_pk_bf16(float lo, float hi) { unsigned r; asm volatile("v_cvt_pk_bf16_f32 %0, %1, %2" : "=v"(r) : "v"(lo), "v"(hi)); return r; }

struct EpiProj {
    static constexpr bool PERM = true, AFTER_DRAIN = false;
    bf16_t* O; int ldc; int nvalid;
    __device__ __forceinline__ void operator()(const f32x4 (&acc)[2][2][4][2], const Unit& u, int wr, int wc, int fr, int fq) const {
        const int row0 = u.pm * BM + wr * 64 + fr, col0 = u.pn * BM + wc * 32 + 8 * fq;
#pragma unroll
        for (int ai = 0; ai < 2; ++ai)
#pragma unroll
            for (int m = 0; m < 4; ++m) { bf16_t* rowp = O + (size_t)(row0 + ai * HALF + m * 16) * ldc + col0;
#pragma unroll
                for (int bj = 0; bj < 2; ++bj) { if (col0 + bj * HALF < nvalid) { const f32x4 v0 = acc[ai][bj][m][0], v1 = acc[ai][bj][m][1];
                    u32x4 w; w.x = cvt_pk_bf16(v0[0], v0[1]); w.y = cvt_pk_bf16(v0[2], v0[3]); w.z = cvt_pk_bf16(v1[0], v1[1]); w.w = cvt_pk_bf16(v1[2], v1[3]);
                    *(u32x4*)(rowp + bj * HALF) = w; } } }
    }
};
struct EpiResid {
    static constexpr bool PERM = false, AFTER_DRAIN = false;
    float* X; int ldc; float alpha;
    __device__ __forceinline__ void operator()(const f32x4 (&acc)[2][2][4][2], const Unit& u, int wr, int wc, int fr, int fq) const {
        const int row0 = u.pm * BM + wr * 64 + fr, col0 = u.pn * BM + wc * 32 + 4 * fq;
#pragma unroll
        for (int ai = 0; ai < 2; ++ai)
#pragma unroll
            for (int m = 0; m < 4; ++m) { float* rowp = X + (size_t)(row0 + ai * HALF + m * 16) * ldc + col0;
#pragma unroll
                for (int bj = 0; bj < 2; ++bj)
#pragma unroll
                    for (int n = 0; n < 2; ++n) { f32x4* p = (f32x4*)(rowp + bj * HALF + n * 16); const f32x4 x = *p; *p = x * alpha + acc[ai][bj][m][n]; } }
    }
};
__device__ __forceinline__ float silu_f(float g) { return g * __builtin_amdgcn_rcpf(1.0f + __builtin_amdgcn_exp2f(-1.4426950408889634f * g)); }
struct EpiSwiGLU {
    static constexpr bool PERM = true, AFTER_DRAIN = false;
    bf16_t* H; int ldc;
    __device__ __forceinline__ void operator()(const f32x4 (&acc)[2][2][4][2], const Unit& u, int wr, int wc, int fr, int fq) const {
        const int row0 = u.pm * BM + wr * 64 + fr, col0 = u.pn * HALF + wc * 32 + 8 * fq;
#pragma unroll
        for (int ai = 0; ai < 2; ++ai)
#pragma unroll
            for (int m = 0; m < 4; ++m) { bf16_t* rowp = H + (size_t)(row0 + ai * HALF + m * 16) * ldc + col0;
                const f32x4 g0 = acc[ai][0][m][0], g1 = acc[ai][0][m][1], u0 = acc[ai][1][m][0], u1 = acc[ai][1][m][1];
                float h[8];
#pragma unroll
                for (int i = 0; i < 4; ++i) { h[i] = silu_f(g0[i]) * u0[i]; h[4 + i] = silu_f(g1[i]) * u1[i]; }
                u32x4 w; w.x = cvt_pk_bf16(h[0], h[1]); w.y = cvt_pk_bf16(h[2], h[3]); w.z = cvt_pk_bf16(h[4], h[5]); w.w = cvt_pk_bf16(h[6], h[7]);
                *(u32x4*)rowp = w; }
    }
};
struct EpiGate {
    static constexpr bool PERM = true, AFTER_DRAIN = false;
    bf16_t* O; int ldc; const float* gate;
    __device__ __forceinline__ void operator()(const f32x4 (&acc)[2][2][4][2], const Unit& u, int wr, int wc, int fr, int fq) const {
        const int row0 = u.pm * BM + wr * 64 + fr, col0 = u.pn * BM + wc * 32 + 8 * fq;
#pragma unroll
        for (int ai = 0; ai < 2; ++ai)
#pragma unroll
            for (int m = 0; m < 4; ++m) { const int row = row0 + ai * HALF + m * 16; const float gt = gate[row]; bf16_t* rowp = O + (size_t)row * ldc + col0;
#pragma unroll
                for (int bj = 0; bj < 2; ++bj) { const f32x4 v0 = acc[ai][bj][m][0] * gt, v1 = acc[ai][bj][m][1] * gt;
                    u32x4 w; w.x = cvt_pk_bf16(v0[0], v0[1]); w.y = cvt_pk_bf16(v0[2], v0[3]); w.z = cvt_pk_bf16(v1[0], v1[1]); w.w = cvt_pk_bf16(v1[2], v1[3]);
                    *(u32x4*)(rowp + bj * HALF) = w; } }
    }
};

__device__ __forceinline__ unsigned cvt4_fp8(float a, float b, float c, float d) { unsigned w = 0u; w = __builtin_amdgcn_cvt_pk_fp8_f32(a, b, w, false); w = __builtin_amdgcn_cvt_pk_fp8_f32(c, d, w, true); return w; }
typedef unsigned u32x2 __attribute__((ext_vector_type(2)));
struct EpiSwiGLU8 {
    static constexpr bool PERM = true, AFTER_DRAIN = false;
    unsigned char* H; int ldc; float inv_ws;
    __device__ __forceinline__ void operator()(const f32x4 (&acc)[2][2][4][2], const Unit& u, int wr, int wc, int fr, int fq) const {
        const int row0 = u.pm * BM + wr * 64 + fr, col0 = u.pn * HALF + wc * 32 + 8 * fq;
#pragma unroll
        for (int ai = 0; ai < 2; ++ai)
#pragma unroll
            for (int m = 0; m < 4; ++m) { unsigned char* rowp = H + (size_t)(row0 + ai * HALF + m * 16) * ldc + col0;
                const f32x4 g0 = acc[ai][0][m][0] * inv_ws, g1 = acc[ai][0][m][1] * inv_ws, u0 = acc[ai][1][m][0] * inv_ws, u1 = acc[ai][1][m][1] * inv_ws;
                float h[8];
#pragma unroll
                for (int i = 0; i < 4; ++i) { h[i] = silu_f(g0[i]) * u0[i]; h[4 + i] = silu_f(g1[i]) * u1[i]; }
                u32x2 w; w.x = cvt4_fp8(h[0], h[1], h[2], h[3]); w.y = cvt4_fp8(h[4], h[5], h[6], h[7]);
                *(u32x2*)rowp = w; }
    }
};
struct EpiGate8 {
    static constexpr bool PERM = true, AFTER_DRAIN = false;
    unsigned char* O; int ldc; const float* gate; float inv_ws;
    bool nul = false;
    __device__ __forceinline__ void operator()(const f32x4 (&acc)[2][2][4][2], const Unit& u, int wr, int wc, int fr, int fq) const {
        if (nul) return;
        const int row0 = u.pm * BM + wr * 64 + fr, col0 = u.pn * BM + wc * 32 + 8 * fq;
#pragma unroll
        for (int ai = 0; ai < 2; ++ai)
#pragma unroll
            for (int m = 0; m < 4; ++m) { const int row = row0 + ai * HALF + m * 16; const float gt = gate[row] * inv_ws; unsigned char* rowp = O + (size_t)row * ldc + col0;
#pragma unroll
                for (int bj = 0; bj < 2; ++bj) { const f32x4 v0 = acc[ai][bj][m][0] * gt, v1 = acc[ai][bj][m][1] * gt;
                    u32x2 w; w.x = cvt4_fp8(v0[0], v0[1], v0[2], v0[3]); w.y = cvt4_fp8(v1[0], v1[1], v1[2], v1[3]);
                    *(u32x2*)(rowp + bj * HALF) = w; } }
    }
};
struct EpiProjS {
    static constexpr bool PERM = true, AFTER_DRAIN = false;
    bf16_t* O; int ldc; int nvalid; int colbase; float scale;
    __device__ __forceinline__ void operator()(const f32x4 (&acc)[2][2][4][2], const Unit& u, int wr, int wc, int fr, int fq) const {
        const int row0 = u.pm * BM + wr * 64 + fr, col0 = colbase + u.pn * BM + wc * 32 + 8 * fq;
#pragma unroll
        for (int ai = 0; ai < 2; ++ai)
#pragma unroll
            for (int m = 0; m < 4; ++m) { bf16_t* rowp = O + (size_t)(row0 + ai * HALF + m * 16) * ldc + col0;
#pragma unroll
                for (int bj = 0; bj < 2; ++bj) { if (col0 + bj * HALF < nvalid) { const f32x4 v0 = acc[ai][bj][m][0] * scale, v1 = acc[ai][bj][m][1] * scale;
                    u32x4 w; w.x = cvt_pk_bf16(v0[0], v0[1]); w.y = cvt_pk_bf16(v0[2], v0[3]); w.z = cvt_pk_bf16(v1[0], v1[1]); w.w = cvt_pk_bf16(v1[2], v1[3]);
                    *(u32x4*)(rowp + bj * HALF) = w; } } }
    }
};

struct EpiProjI8 {
    static constexpr bool PERM = true, AFTER_DRAIN = false;
    bf16_t* O; int ldc; int nvalid; int colbase; const float* rowscale; const float* colscale;
    __device__ __forceinline__ void operator()(const f32x4 (&acc)[2][2][4][2], const Unit& u, int wr, int wc, int fr, int fq) const {
        const int row0 = u.pm * BM + wr * 64 + fr, tcol0 = u.pn * BM + wc * 32 + 8 * fq, col0 = colbase + tcol0;
        f32x4 cs[2][2];
#pragma unroll
        for (int bj = 0; bj < 2; ++bj) { cs[bj][0] = *(const f32x4*)(colscale + tcol0 + bj * HALF); cs[bj][1] = *(const f32x4*)(colscale + tcol0 + bj * HALF + 4); }
#pragma unroll
        for (int ai = 0; ai < 2; ++ai)
#pragma unroll
            for (int m = 0; m < 4; ++m) { const int row = row0 + ai * HALF + m * 16; const float rs = rowscale[row]; bf16_t* rowp = O + (size_t)row * ldc + col0;
#pragma unroll
                for (int bj = 0; bj < 2; ++bj) { if (col0 + bj * HALF < nvalid) {
                    const i32x4_t a0 = __builtin_bit_cast(i32x4_t, acc[ai][bj][m][0]), a1 = __builtin_bit_cast(i32x4_t, acc[ai][bj][m][1]);
                    const f32x4 v0 = (f32x4){(float)a0[0], (float)a0[1], (float)a0[2], (float)a0[3]} * cs[bj][0] * rs, v1 = (f32x4){(float)a1[0], (float)a1[1], (float)a1[2], (float)a1[3]} * cs[bj][1] * rs;
                    u32x4 w; w.x = cvt_pk_bf16(v0[0], v0[1]); w.y = cvt_pk_bf16(v0[2], v0[3]); w.z = cvt_pk_bf16(v1[0], v1[1]); w.w = cvt_pk_bf16(v1[2], v1[3]);
                    *(u32x4*)(rowp + bj * HALF) = w; } } }
    }
};

struct EpiSwiGLUI8 {
    static constexpr bool PERM = true, AFTER_DRAIN = false;
    unsigned char* H; int ldc; const float* rowscale; const float* colscale;
    __device__ __forceinline__ void operator()(const f32x4 (&acc)[2][2][4][2], const Unit& u, int wr, int wc, int fr, int fq) const {
        const int row0 = u.pm * BM + wr * 64 + fr, tcol0 = u.pn * BM + wc * 32 + 8 * fq, col0 = u.pn * HALF + wc * 32 + 8 * fq;
        const float* cs = colscale + (size_t)u.e * 4096 + tcol0;
        const f32x4 cg0 = *(const f32x4*)cs, cg1 = *(const f32x4*)(cs + 4), cu0 = *(const f32x4*)(cs + HALF), cu1 = *(const f32x4*)(cs + HALF + 4);
#pragma unroll
        for (int ai = 0; ai < 2; ++ai)
#pragma unroll
            for (int m = 0; m < 4; ++m) { const int row = row0 + ai * HALF + m * 16; const float rs = rowscale[row]; unsigned char* rowp = H + (size_t)row * ldc + col0;
                const i32x4_t ig0 = __builtin_bit_cast(i32x4_t, acc[ai][0][m][0]), ig1 = __builtin_bit_cast(i32x4_t, acc[ai][0][m][1]), iu0 = __builtin_bit_cast(i32x4_t, acc[ai][1][m][0]), iu1 = __builtin_bit_cast(i32x4_t, acc[ai][1][m][1]);
                const f32x4 g0 = (f32x4){(float)ig0[0], (float)ig0[1], (float)ig0[2], (float)ig0[3]} * cg0 * rs, g1 = (f32x4){(float)ig1[0], (float)ig1[1], (float)ig1[2], (float)ig1[3]} * cg1 * rs;
                const f32x4 u0 = (f32x4){(float)iu0[0], (float)iu0[1], (float)iu0[2], (float)iu0[3]} * cu0 * rs, u1 = (f32x4){(float)iu1[0], (float)iu1[1], (float)iu1[2], (float)iu1[3]} * cu1 * rs;
                float h[8];
#pragma unroll
                for (int i = 0; i < 4; ++i) { h[i] = silu_f(g0[i]) * u0[i]; h[4 + i] = silu_f(g1[i]) * u1[i]; }
                u32x2 w; w.x = cvt4_fp8(h[0], h[1], h[2], h[3]); w.y = cvt4_fp8(h[4], h[5], h[6], h[7]);
                *(u32x2*)rowp = w; }
    }
};
template <class Epi, class Sched, bool ALIGN_EPI = false, bool SP2 = false, bool GATHER = false, bool FP8 = false, bool I8 = false>
__device__ __forceinline__ void gemm_phase(PG8_LAS unsigned char* lds, const Gemm g, const Sched& S, const Epi& E, const int* gidx = nullptr) {
    static_assert((!GATHER && !FP8) || SP2, "gathered A rows / fp8 operands: SP2 loop only");
    int tid_ = threadIdx.x; asm volatile("" : "+v"(tid_));
    const int tid = tid_, wid = __builtin_amdgcn_readfirstlane(tid >> 6), lane = tid & 63, wr = wid >> 2, wc = wid & 3, fr = lane & 15, fq = lane >> 4;
    const int K = g.K, nt = K / BK;
    unsigned voffA[2], voffB[2];
#pragma unroll
    for (int i = 0; i < 2; ++i) { int R, C; stage_rc(tid * 16 + i * 8192, R, C); const int Rb = Epi::PERM ? ((R & ~31) + perm32(R & 31)) : R;
        voffA[i] = (unsigned)(R * K + C) * 2u; voffB[i] = (unsigned)(Rb * K + C) * 2u; }
    PG8_LAS unsigned* gofs = (PG8_LAS unsigned*)(lds + STAGE_BYTES) + tid;
#define PG8_GVO(u, slot) do { _Pragma("unroll") for (int _i = 0; _i < 2; ++_i) { int R_, C_; stage_rc(tid * 16 + _i * 8192, R_, C_); \
        gofs[(((slot) * 2 + 0) * 2 + _i) * 512] = (unsigned)gidx[(u).pm * BM + R_] * (unsigned)(K * 2) + (unsigned)(C_ * 2); \
        gofs[(((slot) * 2 + 1) * 2 + _i) * 512] = (unsigned)gidx[(u).pm * BM + HALF + R_] * (unsigned)(K * 2) + (unsigned)(C_ * 2); } } while (0)
#define PG8_STAGE_A(bufoff, base, hh, slot) do { if constexpr (GATHER) { unsigned o_[2]; o_[0] = gofs[(((slot) * 2 + (hh)) * 2 + 0) * 512]; o_[1] = gofs[(((slot) * 2 + (hh)) * 2 + 1) * 512]; PG8_STAGE(bufoff, base, o_); } \
        else PG8_STAGE(bufoff, (base) + (hh) * hstep, voffA); } while (0)
    const size_t kstep = (size_t)(BK * 2);
    const size_t hstep = (size_t)HALF * K * 2;
    const size_t tstep = 2 * hstep;
    const unsigned ldsw = (unsigned)wid * 1024u;
    const int aoff = lds_byte(wr * 64 + fr, fq * 8), boff = lds_byte(wc * 32 + fr, fq * 8);
#define PG8_SA(b, h) (((b) * 2 + (h)) * HTB)
#define PG8_SB(b, h) ((4 + (b) * 2 + (h)) * HTB)
#define PG8_STAGE(bufoff, gbase, voff) do { _Pragma("unroll") for (int _i = 0; _i < 2; ++_i) \
        __builtin_amdgcn_global_load_lds((const unsigned*)((const char*)(gbase) + (voff)[_i]), (PG8_LAS unsigned*)(lds + (bufoff) + ldsw + _i * 8192), 16, 0, 0); } while (0)
#define PG8_LDA(dst, b, h) do { _Pragma("unroll") for (int m = 0; m < 4; ++m) _Pragma("unroll") for (int k = 0; k < 2; ++k) dst[m][k] = *(const PG8_LAS bf16x8*)(lds + PG8_SA(b, h) + aoff + m * 2048 + k * 1024); } while (0)
#define PG8_LDB(dst, b, h) do { _Pragma("unroll") for (int n = 0; n < 2; ++n) _Pragma("unroll") for (int k = 0; k < 2; ++k) dst[n][k] = *(const PG8_LAS bf16x8*)(lds + PG8_SB(b, h) + boff + n * 2048 + k * 1024); } while (0)
#define PG8_LDA8(dst, b, h) do { _Pragma("unroll") for (int m = 0; m < 4; ++m) dst[m] = __builtin_shufflevector(*(const PG8_LAS i32x4_t*)(lds + PG8_SA(b, h) + aoff + m * 2048), *(const PG8_LAS i32x4_t*)(lds + PG8_SA(b, h) + aoff + m * 2048 + 1024), 0, 1, 2, 3, 4, 5, 6, 7); } while (0)
#define PG8_LDB8(dst, b, h) do { _Pragma("unroll") for (int n = 0; n < 2; ++n) dst[n] = __builtin_shufflevector(*(const PG8_LAS i32x4_t*)(lds + PG8_SB(b, h) + boff + n * 2048), *(const PG8_LAS i32x4_t*)(lds + PG8_SB(b, h) + boff + n * 2048 + 1024), 0, 1, 2, 3, 4, 5, 6, 7); } while (0)
#define PG8_MMA8(ai, bj, A8, Bx8) do { _Pragma("unroll") for (int m = 0; m < 4; ++m) _Pragma("unroll") for (int n = 0; n < 2; ++n) \
        acc[ai][bj][m][n] = __builtin_amdgcn_mfma_scale_f32_16x16x128_f8f6f4(Bx8[n], A8[m], acc[ai][bj][m][n], 0, 0, 0, 0x7F7F7F7F, 0, 0x7F7F7F7F); __builtin_amdgcn_s_setprio(0); } while (0)
#define PG8_MMA(ai, bj, At, Bt) do { __builtin_amdgcn_s_setprio(1); _Pragma("unroll") for (int m = 0; m < 4; ++m) _Pragma("unroll") for (int n = 0; n < 2; ++n) _Pragma("unroll") for (int k = 0; k < 2; ++k) \
        { if constexpr (I8) acc[ai][bj][m][n] = __builtin_bit_cast(f32x4, __builtin_amdgcn_mfma_i32_16x16x64_i8(__builtin_bit_cast(i32x4_t, Bt[n][k]), __builtin_bit_cast(i32x4_t, At[m][k]), __builtin_bit_cast(i32x4_t, acc[ai][bj][m][n]), 0, 0, 0)); \
          else acc[ai][bj][m][n] = __builtin_amdgcn_mfma_f32_16x16x32_bf16(Bt[n][k], At[m][k], acc[ai][bj][m][n], 0, 0, 0); } __builtin_amdgcn_s_setprio(0); } while (0)
#define PG8_WAIT_V(n) asm volatile("s_waitcnt vmcnt(" #n ")" ::: "memory")
#define PG8_WAIT_L(n) asm volatile("s_waitcnt lgkmcnt(" #n ")" ::: "memory")
#define PG8_BAR __builtin_amdgcn_s_barrier()
#define PG8_SCHED __builtin_amdgcn_sched_barrier(0)
    Unit cur, nxt; int ui = 0;
    if (!S.next(0, cur)) return;
    f32x4 acc[2][2][4][2];
#pragma unroll
    for (int a = 0; a < 2; ++a)
#pragma unroll
        for (int b = 0; b < 2; ++b)
#pragma unroll
            for (int m = 0; m < 4; ++m)
#pragma unroll
                for (int n = 0; n < 2; ++n) acc[a][b][m][n] = (f32x4){0.f, 0.f, 0.f, 0.f};
    bf16x8 At[4][2], B0[2][2], B1[2][2];
    i32x8_t At8[4], B08[2], B18[2];
    const char* cA = GATHER ? (const char*)g.A : (const char*)g.A + (size_t)cur.pm * tstep; if constexpr (GATHER) PG8_GVO(cur, 0);
    const char* cB = (const char*)g.Bt + (size_t)cur.e * g.bstride + (size_t)cur.pn * tstep;
    S.a_ready(cur);
    if constexpr (SP2) {
        PG8_STAGE(PG8_SB(0, 0), cB, voffB); PG8_STAGE(PG8_SB(0, 1), cB + hstep, voffB); PG8_STAGE_A(PG8_SA(0, 0), cA, 0, 0); PG8_STAGE_A(PG8_SA(0, 1), cA, 1, 0);
        if (wr == 1) PG8_BAR;
        PG8_WAIT_V(2); PG8_BAR;
        PG8_STAGE(PG8_SB(1, 0), cB + kstep, voffB); PG8_STAGE_A(PG8_SA(1, 0), cA + kstep, 0, 0); PG8_STAGE(PG8_SB(1, 1), cB + hstep + kstep, voffB);
        PG8_WAIT_V(6); PG8_BAR;
    } else {
        PG8_STAGE(PG8_SB(0, 0), cB, voffB); PG8_STAGE(PG8_SA(0, 0), cA, voffA); PG8_STAGE(PG8_SB(0, 1), cB + hstep, voffB); PG8_STAGE(PG8_SA(0, 1), cA + hstep, voffA);
        if (wr == 1) PG8_BAR;
        PG8_WAIT_V(4); PG8_BAR;
        PG8_STAGE(PG8_SB(1, 0), cB + kstep, voffB); PG8_STAGE(PG8_SA(1, 0), cA + kstep, voffA); PG8_STAGE(PG8_SB(1, 1), cB + hstep + kstep, voffB);
        PG8_WAIT_V(6); PG8_BAR;
    }
    for (;;) {
        const bool has_next = S.next(ui + 1, nxt);
        const char* nA = GATHER ? cA : (has_next ? (const char*)g.A + (size_t)nxt.pm * tstep : cA);
        const int cslot = ui & 1, nslot = has_next ? (cslot ^ 1) : cslot;
        if constexpr (GATHER) { if (has_next) PG8_GVO(nxt, nslot); } const char* nB = has_next ? (const char*)g.Bt + (size_t)nxt.e * g.bstride + (size_t)nxt.pn * tstep : cB;
        for (int t = 0; t < nt; t += 2) {
            const bool last = (t == nt - 2);
            const char* a1 = cA + (size_t)(t + 1) * kstep;
            const char* a2 = last ? nA : cA + (size_t)(t + 2) * kstep; const char* b2 = last ? nB : cB + (size_t)(t + 2) * kstep;
            const char* a3 = a2 + kstep; const char* b3 = b2 + kstep;
            if (last && has_next) S.a_ready(nxt);
            const int xslot = last ? nslot : cslot;
            if constexpr (SP2) {
            if constexpr (FP8) { PG8_LDB8(B08, 0, 0); PG8_LDB8(B18, 0, 1); PG8_SCHED; PG8_LDA8(At8, 0, 0); } else { PG8_LDB(B0, 0, 0); PG8_LDB(B1, 0, 1); PG8_SCHED; PG8_LDA(At, 0, 0); } PG8_STAGE_A(PG8_SA(1, 1), a1, 1, cslot);
            PG8_WAIT_V(8); PG8_WAIT_L(0); PG8_BAR; if constexpr (FP8) { PG8_MMA8(0, 0, At8, B08); PG8_MMA8(0, 1, At8, B18); } else { PG8_MMA(0, 0, At, B0); PG8_MMA(0, 1, At, B1); } PG8_BAR; PG8_SCHED;
            if constexpr (FP8) PG8_LDA8(At8, 0, 1); else PG8_LDA(At, 0, 1); PG8_STAGE(PG8_SB(0, 0), b2, voffB); PG8_STAGE(PG8_SB(0, 1), b2 + hstep, voffB); PG8_STAGE_A(PG8_SA(0, 0), a2, 0, xslot);
            PG8_WAIT_V(8); PG8_WAIT_L(0); PG8_BAR; if constexpr (FP8) { PG8_MMA8(1, 0, At8, B08); PG8_MMA8(1, 1, At8, B18); } else { PG8_MMA(1, 0, At, B0); PG8_MMA(1, 1, At, B1); } PG8_BAR; PG8_SCHED;
            if constexpr (FP8) { PG8_LDB8(B08, 1, 0); PG8_LDB8(B18, 1, 1); PG8_SCHED; PG8_LDA8(At8, 1, 0); } else { PG8_LDB(B0, 1, 0); PG8_LDB(B1, 1, 1); PG8_SCHED; PG8_LDA(At, 1, 0); } PG8_STAGE_A(PG8_SA(0, 1), a2, 1, xslot);
            PG8_WAIT_V(8); PG8_WAIT_L(0); PG8_BAR; if constexpr (FP8) { PG8_MMA8(0, 0, At8, B08); PG8_MMA8(0, 1, At8, B18); } else { PG8_MMA(0, 0, At, B0); PG8_MMA(0, 1, At, B1); } PG8_BAR; PG8_SCHED;
            if constexpr (FP8) PG8_LDA8(At8, 1, 1); else PG8_LDA(At, 1, 1); PG8_STAGE(PG8_SB(1, 0), b3, voffB); PG8_STAGE(PG8_SB(1, 1), b3 + hstep, voffB); PG8_STAGE_A(PG8_SA(1, 0), a3, 0, xslot);
            PG8_WAIT_V(8); PG8_WAIT_L(0); PG8_BAR; if constexpr (FP8) { PG8_MMA8(1, 0, At8, B08); PG8_MMA8(1, 1, At8, B18); } else { PG8_MMA(1, 0, At, B0); PG8_MMA(1, 1, At, B1); } PG8_BAR; PG8_SCHED;
            } else {
            PG8_LDB(B0, 0, 0); PG8_SCHED; PG8_LDA(At, 0, 0); PG8_STAGE(PG8_SA(1, 1), a1 + hstep, voffA);
            PG8_WAIT_L(8); PG8_BAR; PG8_WAIT_L(0); PG8_MMA(0, 0, At, B0); PG8_BAR; PG8_SCHED;
            PG8_LDB(B1, 0, 1); PG8_STAGE(PG8_SB(0, 0), b2, voffB);
            PG8_BAR; PG8_WAIT_L(0); PG8_MMA(0, 1, At, B1); PG8_BAR;
            PG8_LDA(At, 0, 1); PG8_STAGE(PG8_SA(0, 0), a2, voffA);
            PG8_BAR; PG8_WAIT_L(0); PG8_MMA(1, 0, At, B0); PG8_BAR; PG8_SCHED;
            PG8_STAGE(PG8_SB(0, 1), b2 + hstep, voffB);
            PG8_WAIT_V(6); PG8_BAR; PG8_MMA(1, 1, At, B1); PG8_BAR;
            PG8_LDB(B0, 1, 0); PG8_SCHED; PG8_LDA(At, 1, 0); PG8_STAGE(PG8_SA(0, 1), a2 + hstep, voffA);
            PG8_WAIT_L(8); PG8_BAR; PG8_WAIT_L(0); PG8_MMA(0, 0, At, B0); PG8_BAR; PG8_SCHED;
            PG8_LDB(B1, 1, 1); PG8_STAGE(PG8_SB(1, 0), b3, voffB);
            PG8_BAR; PG8_WAIT_L(0); PG8_MMA(0, 1, At, B1); PG8_BAR;
            PG8_LDA(At, 1, 1); PG8_STAGE(PG8_SA(1, 0), a3, voffA);
            PG8_BAR; PG8_WAIT_L(0); PG8_MMA(1, 0, At, B0); PG8_BAR; PG8_SCHED;
            PG8_STAGE(PG8_SB(1, 1), b3 + hstep, voffB);
            PG8_WAIT_V(6); PG8_BAR; PG8_MMA(1, 1, At, B1); PG8_BAR;
            }
        }
        if constexpr (ALIGN_EPI) { if (wr == 0) PG8_BAR; }
        if constexpr (!Epi::AFTER_DRAIN) { E(acc, cur, wr, wc, fr, fq); S.done(cur); }
        if (!has_next) break;
#pragma unroll
        for (int a = 0; a < 2; ++a)
#pragma unroll
            for (int b = 0; b < 2; ++b)
#pragma unroll
                for (int m = 0; m < 4; ++m)
#pragma unroll
                    for (int n = 0; n < 2; ++n) acc[a][b][m][n] = (f32x4){0.f, 0.f, 0.f, 0.f};
        cur = nxt; cA = nA; cB = nB; ++ui;
        if constexpr (ALIGN_EPI) { if (wr == 1) PG8_BAR; }
    }
    PG8_WAIT_V(0);
    if constexpr (!ALIGN_EPI) { if (wr == 0) PG8_BAR; }
    PG8_BAR;
    if constexpr (Epi::AFTER_DRAIN) { E.fused(acc, cur, wr, wc, fr, fq, lds, wid, lane); S.done(cur); }
#undef PG8_SA
#undef PG8_GVO
#undef PG8_STAGE_A
#undef PG8_SB
#undef PG8_STAGE
#undef PG8_LDA
#undef PG8_LDB
#undef PG8_MMA
#undef PG8_LDA8
#undef PG8_LDB8
#undef PG8_MMA8
#undef PG8_WAIT_V
#undef PG8_WAIT_L
#undef PG8_BAR
#undef PG8_SCHED
}
}
namespace attn {
using bf16 = __hip_bfloat16;
constexpr int   D = 128, NW = 8, QBLK = 32, KVBLK = 64;
constexpr float SCALE = 0.088388347648318440f;
constexpr float THR = 8.f;
constexpr int SDEPTH = 1;
constexpr int LDQ = PP, LDK = PP, LDO = ::D;
constexpr size_t SHM_V = KVBLK * D * 2, SHM_K = KVBLK * D * 2, SHM_ATTN = 2 * SHM_V + 2 * SHM_K + NW * 64 * 4;
using bf16x8 = __attribute__((ext_vector_type(8))) short;
using s16x4  = __attribute__((ext_vector_type(4))) short;
using f32x16 = __attribute__((ext_vector_type(16))) float;
using f32x8  = __attribute__((ext_vector_type(8))) float;
using u32x4  = __attribute__((ext_vector_type(4))) unsigned;
#define KSWZ(row, colB) ((row) * 256 + ((colB) ^ (((row) & 7) << 4)))
#define SBAR() __builtin_amdgcn_sched_barrier(0)
__device__ __forceinline__ int crow(int r, int hi) { return (r & 3) + 8 * (r >> 2) + 4 * hi; }
__device__ __forceinline__ unsigned cvtpk(float lo, float hi) {
  unsigned r; asm volatile("v_cvt_pk_bf16_f32 %0, %1, %2" : "=v"(r) : "v"(lo), "v"(hi)); return r;
}
template <typename TIn> struct Stage;
template <> struct Stage<bf16>  { using T = bf16x8;
  __device__ static __forceinline__ T ld8(const bf16* p) { return *reinterpret_cast<const bf16x8*>(p); }
  __device__ static __forceinline__ bf16x8 tobf(T x) { return x; } };
template <> struct Stage<float> { using T = f32x8;
  __device__ static __forceinline__ T ld8(const float* p) { return *reinterpret_cast<const f32x8*>(p); }
  __device__ static __forceinline__ bf16x8 tobf(T x) {
    u32x4 w = {cvtpk(x[0], x[1]), cvtpk(x[2], x[3]), cvtpk(x[4], x[5]), cvtpk(x[6], x[7])}; return *reinterpret_cast<bf16x8*>(&w); } };

__device__ __forceinline__ void partialSM(f32x16& p0, f32x16& p1, float& m_reg, float& mn, float& alpha) {
  constexpr float C = SCALE * 1.4426950408889634f;
  float pmax = p0[0]; for (int r = 1; r < 16; ++r) pmax = fmaxf(pmax, p0[r]); for (int r = 0; r < 16; ++r) pmax = fmaxf(pmax, p1[r]);
  { auto rr = __builtin_amdgcn_permlane32_swap(__float_as_uint(pmax), __float_as_uint(pmax), false, false);
    pmax = fmaxf(__uint_as_float(rr[0]), __uint_as_float(rr[1])); }
  if (__builtin_expect(__all(pmax - m_reg <= THR / SCALE), 1)) { mn = m_reg; alpha = 1.f; }
  else { mn = fmaxf(m_reg, pmax); alpha = __builtin_amdgcn_exp2f((m_reg - mn) * C); m_reg = mn; }
  float mnC = -mn * C;
  for (int r = 0; r < 16; ++r) p0[r] = fmaf(p0[r], C, mnC); for (int r = 0; r < 16; ++r) p1[r] = fmaf(p1[r], C, mnC);
  for (int r = 0; r < 16; ++r) p0[r] = __builtin_amdgcn_exp2f(p0[r]);
}
__device__ __forceinline__ void finishSM(f32x16& p0, f32x16& p1, float alpha, float& l_reg, bf16x8& pa0, bf16x8& pa1, bf16x8& pa2, bf16x8& pa3) {
  for (int r = 0; r < 16; ++r) p1[r] = __builtin_amdgcn_exp2f(p1[r]);
  float ps = 0; for (int r = 0; r < 16; ++r) ps += p0[r]; for (int r = 0; r < 16; ++r) ps += p1[r];
  { auto rr = __builtin_amdgcn_permlane32_swap(__float_as_uint(ps), __float_as_uint(ps), false, false);
    ps = __uint_as_float(rr[0]) + __uint_as_float(rr[1]); }
  l_reg = l_reg * alpha + ps;
#define PK4(P, BASE, OUT) do { unsigned a0 = cvtpk(P[BASE + 0], P[BASE + 1]), a1 = cvtpk(P[BASE + 2], P[BASE + 3]);   \
    unsigned b0 = cvtpk(P[BASE + 4], P[BASE + 5]), b1 = cvtpk(P[BASE + 6], P[BASE + 7]);                              \
    auto r0 = __builtin_amdgcn_permlane32_swap(a0, b0, false, false); auto r1 = __builtin_amdgcn_permlane32_swap(a1, b1, false, false); \
    u32x4 w = {r0[0], r1[0], r0[1], r1[1]}; OUT = *reinterpret_cast<bf16x8*>(&w); } while (0)
  PK4(p0, 0, pa0); PK4(p0, 8, pa1); PK4(p1, 0, pa2); PK4(p1, 8, pa3);
#undef PK4
}
__device__ __forceinline__ void qkt(f32x16& p0, f32x16& p1, const bf16* Ks, const bf16x8* qr, int r32, int hi) {
  p0 = f32x16{}; p1 = f32x16{};
  for (int d0 = 0; d0 < 8; ++d0) { int cb = (d0 * 16 + hi * 8) * 2;
    bf16x8 b0 = *reinterpret_cast<const bf16x8*>((const char*)Ks + KSWZ(r32, cb));
    bf16x8 b1 = *reinterpret_cast<const bf16x8*>((const char*)Ks + KSWZ(32 + r32, cb));
    p0 = __builtin_amdgcn_mfma_f32_32x32x16_bf16(b0, qr[d0], p0, 0, 0, 0);
    p1 = __builtin_amdgcn_mfma_f32_32x32x16_bf16(b1, qr[d0], p1, 0, 0, 0); }
}
__device__ __forceinline__ int v_st(int k, int c) { const int kk = (k & ~0xC) | ((k & 4) << 1) | ((k & 8) >> 1); return ((kk >> 3) * 4 + (c >> 5)) * 512 + ((kk & 7) * 32 + (c & 31)) * 2; }
__device__ __forceinline__ int v_rd_base(int lane) { return ((lane & 3) << 3) | (((lane >> 2) & 3) << 6) | (((lane >> 4) & 1) << 5) | (((lane >> 5) & 1) << 8); }
constexpr int v_rd_off(int d0, int ks, int half) { return d0 * 512 + ks * 4096 + half * 2048; }
template <int OFF> __device__ __forceinline__ s16x4 tr_read(int vb) {
  s16x4 r; asm volatile("ds_read_b64_tr_b16 %0, %1 offset:%2" : "=&v"(r) : "v"(vb), "i"(OFF) : "memory"); return r;
}
template <int D0> __device__ __forceinline__ void pv_one(f32x16& od, int vb, bf16x8 pa0, bf16x8 pa1, bf16x8 pa2, bf16x8 pa3) {
  const s16x4 l0 = tr_read<v_rd_off(D0, 0, 0)>(vb), h0 = tr_read<v_rd_off(D0, 0, 1)>(vb), l1 = tr_read<v_rd_off(D0, 1, 0)>(vb), h1 = tr_read<v_rd_off(D0, 1, 1)>(vb);
  const s16x4 l2 = tr_read<v_rd_off(D0, 2, 0)>(vb), h2 = tr_read<v_rd_off(D0, 2, 1)>(vb), l3 = tr_read<v_rd_off(D0, 3, 0)>(vb), h3 = tr_read<v_rd_off(D0, 3, 1)>(vb);
  asm volatile("s_waitcnt lgkmcnt(0)" ::: "memory"); SBAR();
#define PK(L, H) (bf16x8){L[0], L[1], L[2], L[3], H[0], H[1], H[2], H[3]}
  od = __builtin_amdgcn_mfma_f32_32x32x16_bf16(pa0, PK(l0, h0), od, 0, 0, 0);
  od = __builtin_amdgcn_mfma_f32_32x32x16_bf16(pa1, PK(l1, h1), od, 0, 0, 0);
  od = __builtin_amdgcn_mfma_f32_32x32x16_bf16(pa2, PK(l2, h2), od, 0, 0, 0);
  od = __builtin_amdgcn_mfma_f32_32x32x16_bf16(pa3, PK(l3, h3), od, 0, 0, 0);
#undef PK
}
__device__ __forceinline__ void pv_d0(f32x16* o, int vb, bf16x8 pa0, bf16x8 pa1, bf16x8 pa2, bf16x8 pa3) {
  pv_one<0>(o[0], vb, pa0, pa1, pa2, pa3); pv_one<1>(o[1], vb, pa0, pa1, pa2, pa3); pv_one<2>(o[2], vb, pa0, pa1, pa2, pa3); pv_one<3>(o[3], vb, pa0, pa1, pa2, pa3);
}

using i32x8 = __attribute__((ext_vector_type(8))) int;
using i32x4 = __attribute__((ext_vector_type(4))) int;
constexpr int LDK8 = 256;
#define K8SWZ(row, colB) ((row) * 128 + ((colB) ^ ((((row) >> 1) & 7) << 4)))
__device__ __forceinline__ void qkt8(f32x16& p0, f32x16& p1, const bf16* Ks, const i32x8* qr, int r32, int hi) {
  p0 = f32x16{}; p1 = f32x16{};
#pragma unroll
  for (int d0 = 0; d0 < 2; ++d0) { const int cb = d0 * 64 + hi * 32;
    const i32x4 a0 = *reinterpret_cast<const i32x4*>((const char*)Ks + K8SWZ(r32, cb)), a1 = *reinterpret_cast<const i32x4*>((const char*)Ks + K8SWZ(r32, cb + 16));
    const i32x4 b0 = *reinterpret_cast<const i32x4*>((const char*)Ks + K8SWZ(32 + r32, cb)), b1 = *reinterpret_cast<const i32x4*>((const char*)Ks + K8SWZ(32 + r32, cb + 16));
    const i32x8 A0 = __builtin_shufflevector(a0, a1, 0, 1, 2, 3, 4, 5, 6, 7), A1 = __builtin_shufflevector(b0, b1, 0, 1, 2, 3, 4, 5, 6, 7);
    p0 = __builtin_amdgcn_mfma_scale_f32_32x32x64_f8f6f4(A0, qr[d0], p0, 0, 0, 0, 0x7F7F7F7F, 0, 0x7F7F7F7F);
    p1 = __builtin_amdgcn_mfma_scale_f32_32x32x64_f8f6f4(A1, qr[d0], p1, 0, 0, 0, 0x7F7F7F7F, 0, 0x7F7F7F7F); }
}
__device__ __forceinline__ void attn_dense_body(const bf16* __restrict__ Qb, const bf16* __restrict__ Kh, const bf16* __restrict__ Vh,
                                                bf16* __restrict__ Ob, int seq, char* lds) {
  using TQ = bf16; using St = Stage<bf16>; using SQ = Stage<TQ>;
  int tid_ = threadIdx.x; asm volatile("" : "+v"(tid_));
  const int tid = tid_, wid = tid >> 6, lane = tid & 63, r32 = lane & 31, hi = lane >> 5;
  bf16* V_lds = (bf16*)lds; bf16* K_lds = (bf16*)(lds + 2 * SHM_V);
  float* ws = (float*)(lds + 2 * SHM_V + 2 * SHM_K) + wid * 64; float* li_l = ws; float* al_l = ws + 32;
  float m_reg = -1e30f, l_reg = 0; f32x16 o[4] = {}; bf16x8 qr[8];
  const TQ* Qw = Qb + (long)(wid * QBLK + r32) * LDQ + hi * 8;
#pragma unroll
  for (int d0 = 0; d0 < 8; ++d0) qr[d0] = SQ::tobf(SQ::ld8(Qw + d0 * 16));
  const int sr = tid >> 4, sc = (tid & 15) * 8, vst0 = v_st(sr, sc), vst1 = v_st(32 + sr, sc);
  const int vb0 = (int)(uintptr_t)V_lds + v_rd_base(lane);
  struct { typename St::T vs0, vs1, ks0, ks1; } sr_[SDEPTH];
#define SLOAD(i, k0) do { sr_[i].vs0 = St::ld8(&Vh[(long)((k0) + sr) * LDK + sc]); sr_[i].vs1 = St::ld8(&Vh[(long)((k0) + 32 + sr) * LDK + sc]); \
    sr_[i].ks0 = St::ld8(&Kh[(long)((k0) + sr) * LDK + sc]); sr_[i].ks1 = St::ld8(&Kh[(long)((k0) + 32 + sr) * LDK + sc]); } while (0)
#define SWRITE(b, i) do { *(bf16x8*)((char*)V_lds + (b) * SHM_V + vst0) = St::tobf(sr_[i].vs0);          \
    *(bf16x8*)((char*)V_lds + (b) * SHM_V + vst1) = St::tobf(sr_[i].vs1); int kc = sc * 2;               \
    *(bf16x8*)((char*)K_lds + (b) * SHM_K + KSWZ(sr, kc)) = St::tobf(sr_[i].ks0);                       \
    *(bf16x8*)((char*)K_lds + (b) * SHM_K + KSWZ(32 + sr, kc)) = St::tobf(sr_[i].ks1); } while (0)
#define SWAIT() do { if constexpr (SDEPTH == 2) asm volatile("s_waitcnt vmcnt(4)" ::: "memory"); else asm volatile("s_waitcnt vmcnt(0)" ::: "memory"); } while (0)
#define RESC(a) do { if (__any((a) < 1.f)) { if (hi == 0) al_l[r32] = (a); asm volatile("s_waitcnt lgkmcnt(0)" ::: "memory"); \
    for (int d = 0; d < 4; ++d) for (int r = 0; r < 16; ++r) o[d][r] *= al_l[crow(r, hi)]; } } while (0)
  f32x16 pA0, pA1, pB0, pB1; float mnA, mnB, alA, alB; bf16x8 pa0, pa1, pa2, pa3; const int NT = seq / KVBLK;
  constexpr int SE = 0, SO = SDEPTH - 1;
  SLOAD(SE, 0); asm volatile("s_waitcnt vmcnt(0)" ::: "memory"); SWRITE(0, SE); __syncthreads();
  qkt(pA0, pA1, K_lds, qr, r32, hi); partialSM(pA0, pA1, m_reg, mnA, alA);
  SLOAD(SO, KVBLK); if constexpr (SDEPTH == 2) { if (2 < NT) SLOAD(SE, 2 * KVBLK); }
  SWAIT(); SWRITE(1, SO); __syncthreads();
  for (int j = 1; j + 1 < NT; j += 2) {
    SBAR(); qkt(pB0, pB1, (bf16*)((char*)K_lds + SHM_K), qr, r32, hi);
    finishSM(pA0, pA1, alA, l_reg, pa0, pa1, pa2, pa3); SBAR();
    SLOAD(SO, (j + SDEPTH) * KVBLK); SBAR();
    pv_d0(o, vb0, pa0, pa1, pa2, pa3); partialSM(pB0, pB1, m_reg, mnB, alB);
    __syncthreads(); SWAIT(); SWRITE(0, SE);
    RESC(alB); __syncthreads();
    SBAR(); qkt(pA0, pA1, K_lds, qr, r32, hi);
    finishSM(pB0, pB1, alB, l_reg, pa0, pa1, pa2, pa3); SBAR();
    if (SDEPTH == 1 || j + 3 < NT) SLOAD(SE, (j + 1 + SDEPTH) * KVBLK); SBAR();
    pv_d0(o, vb0 + (int)SHM_V, pa0, pa1, pa2, pa3); partialSM(pA0, pA1, m_reg, mnA, alA);
    __syncthreads(); SWAIT(); SWRITE(1, SO);
    RESC(alA); __syncthreads();
  }
  SBAR(); qkt(pB0, pB1, (bf16*)((char*)K_lds + SHM_K), qr, r32, hi);
  finishSM(pA0, pA1, alA, l_reg, pa0, pa1, pa2, pa3); SBAR();
  pv_d0(o, vb0, pa0, pa1, pa2, pa3); partialSM(pB0, pB1, m_reg, mnB, alB);
  __syncthreads(); RESC(alB);
  finishSM(pB0, pB1, alB, l_reg, pa0, pa1, pa2, pa3); SBAR();
  pv_d0(o, vb0 + (int)SHM_V, pa0, pa1, pa2, pa3);
  if (hi == 0) li_l[r32] = l_reg; asm volatile("s_waitcnt lgkmcnt(0)" ::: "memory");
  float rli[16];
#pragma unroll
  for (int r = 0; r < 16; ++r) rli[r] = __builtin_amdgcn_rcpf(li_l[crow(r, hi)]);
  bf16* Ow = Ob + (long)(wid * QBLK) * LDO;
#pragma unroll
  for (int r = 0; r < 16; ++r) { int orow = crow(r, hi);
    for (int d0 = 0; d0 < 4; ++d0) Ow[(long)orow * LDO + d0 * 32 + r32] = __float2bfloat16(o[d0][r] * rli[r]); }
  __syncthreads();
#undef SLOAD
#undef SWRITE
#undef SWAIT
#undef RESC
}

__device__ __forceinline__ void attn_dense_body8(const bf16* __restrict__ Qb, const unsigned char* __restrict__ K8h, const bf16* __restrict__ Vh,
                                                 bf16* __restrict__ Ob, int seq, char* lds) {
  using TQ = bf16; using St = Stage<bf16>; using SQ = Stage<TQ>;
  int tid_ = threadIdx.x; asm volatile("" : "+v"(tid_));
  const int tid = tid_, wid = tid >> 6, lane = tid & 63, r32 = lane & 31, hi = lane >> 5;
  bf16* V_lds = (bf16*)lds; bf16* K_lds = (bf16*)(lds + 2 * SHM_V);
  float* ws = (float*)(lds + 2 * SHM_V + 2 * SHM_K) + wid * 64; float* li_l = ws; float* al_l = ws + 32;
  float m_reg = -1e30f, l_reg = 0; f32x16 o[4] = {}; i32x8 qr[2];
  const TQ* Qw = Qb + (long)(wid * QBLK + r32) * LDQ + hi * 32;
#pragma unroll
  for (int d0 = 0; d0 < 2; ++d0) {
#pragma unroll
    for (int c = 0; c < 4; ++c) { const bf16x8 x = *reinterpret_cast<const bf16x8*>(Qw + d0 * 64 + c * 8); const unsigned* xu = reinterpret_cast<const unsigned*>(&x);
      unsigned w0 = 0u, w1 = 0u;
      w0 = __builtin_amdgcn_cvt_pk_fp8_f32(__uint_as_float(xu[0] << 16), __uint_as_float(xu[0] & 0xffff0000u), w0, false); w0 = __builtin_amdgcn_cvt_pk_fp8_f32(__uint_as_float(xu[1] << 16), __uint_as_float(xu[1] & 0xffff0000u), w0, true);
      w1 = __builtin_amdgcn_cvt_pk_fp8_f32(__uint_as_float(xu[2] << 16), __uint_as_float(xu[2] & 0xffff0000u), w1, false); w1 = __builtin_amdgcn_cvt_pk_fp8_f32(__uint_as_float(xu[3] << 16), __uint_as_float(xu[3] & 0xffff0000u), w1, true);
      qr[d0][2 * c] = (int)w0; qr[d0][2 * c + 1] = (int)w1; } }
  const int sr = tid >> 4, sc = (tid & 15) * 8, vst0 = v_st(sr, sc), vst1 = v_st(32 + sr, sc);
  const int vb0 = (int)(uintptr_t)V_lds + v_rd_base(lane);
  const int kr8 = tid >> 3, kc8 = (tid & 7) * 16;
  struct { typename St::T vs0, vs1; i32x4 k8; } sr_[SDEPTH];
#define SLOAD(i, k0) do { sr_[i].vs0 = St::ld8(&Vh[(long)((k0) + sr) * LDK + sc]); sr_[i].vs1 = St::ld8(&Vh[(long)((k0) + 32 + sr) * LDK + sc]); \
    sr_[i].k8 = *reinterpret_cast<const i32x4*>(K8h + (long)((k0) + kr8) * LDK8 + kc8); } while (0)
#define SWRITE(b, i) do { *(bf16x8*)((char*)V_lds + (b) * SHM_V + vst0) = St::tobf(sr_[i].vs0);          \
    *(bf16x8*)((char*)V_lds + (b) * SHM_V + vst1) = St::tobf(sr_[i].vs1);                                \
    *(i32x4*)((char*)K_lds + (b) * SHM_K + K8SWZ(kr8, kc8)) = sr_[i].k8; } while (0)
#define SWAIT() do { if constexpr (SDEPTH == 2) asm volatile("s_waitcnt vmcnt(4)" ::: "memory"); else asm volatile("s_waitcnt vmcnt(0)" ::: "memory"); } while (0)
#define RESC(a) do { if (__any((a) < 1.f)) { if (hi == 0) al_l[r32] = (a); asm volatile("s_waitcnt lgkmcnt(0)" ::: "memory"); \
    for (int d = 0; d < 4; ++d) for (int r = 0; r < 16; ++r) o[d][r] *= al_l[crow(r, hi)]; } } while (0)
  f32x16 pA0, pA1, pB0, pB1; float mnA, mnB, alA, alB; bf16x8 pa0, pa1, pa2, pa3; const int NT = seq / KVBLK;
  constexpr int SE = 0, SO = SDEPTH - 1;
  SLOAD(SE, 0); asm volatile("s_waitcnt vmcnt(0)" ::: "memory"); SWRITE(0, SE); __syncthreads();
  qkt8(pA0, pA1, K_lds, qr, r32, hi); partialSM(pA0, pA1, m_reg, mnA, alA);
  SLOAD(SO, KVBLK); if constexpr (SDEPTH == 2) { if (2 < NT) SLOAD(SE, 2 * KVBLK); }
  SWAIT(); SWRITE(1, SO); __syncthreads();
  for (int j = 1; j + 1 < NT; j += 2) {
    SBAR(); qkt8(pB0, pB1, (bf16*)((char*)K_lds + SHM_K), qr, r32, hi);
    finishSM(pA0, pA1, alA, l_reg, pa0, pa1, pa2, pa3); SBAR();
    SLOAD(SO, (j + SDEPTH) * KVBLK); SBAR();
    pv_d0(o, vb0, pa0, pa1, pa2, pa3); partialSM(pB0, pB1, m_reg, mnB, alB);
    __syncthreads(); SWAIT(); SWRITE(0, SE);
    RESC(alB); __syncthreads();
    SBAR(); qkt8(pA0, pA1, K_lds, qr, r32, hi);
    finishSM(pB0, pB1, alB, l_reg, pa0, pa1, pa2, pa3); SBAR();
    if (SDEPTH == 1 || j + 3 < NT) SLOAD(SE, (j + 1 + SDEPTH) * KVBLK); SBAR();
    pv_d0(o, vb0 + (int)SHM_V, pa0, pa1, pa2, pa3); partialSM(pA0, pA1, m_reg, mnA, alA);
    __syncthreads(); SWAIT(); SWRITE(1, SO);
    RESC(alA); __syncthreads();
  }
  SBAR(); qkt8(pB0, pB1, (bf16*)((char*)K_lds + SHM_K), qr, r32, hi);
  finishSM(pA0, pA1, alA, l_reg, pa0, pa1, pa2, pa3); SBAR();
  pv_d0(o, vb0, pa0, pa1, pa2, pa3); partialSM(pB0, pB1, m_reg, mnB, alB);
  __syncthreads(); RESC(alB);
  finishSM(pB0, pB1, alB, l_reg, pa0, pa1, pa2, pa3); SBAR();
  pv_d0(o, vb0 + (int)SHM_V, pa0, pa1, pa2, pa3);
  if (hi == 0) li_l[r32] = l_reg; asm volatile("s_waitcnt lgkmcnt(0)" ::: "memory");
  float rli[16];
#pragma unroll
  for (int r = 0; r < 16; ++r) rli[r] = __builtin_amdgcn_rcpf(li_l[crow(r, hi)]);
  bf16* Ow = Ob + (long)(wid * QBLK) * LDO;
#pragma unroll
  for (int r = 0; r < 16; ++r) { int orow = crow(r, hi);
    for (int d0 = 0; d0 < 4; ++d0) Ow[(long)orow * LDO + d0 * 32 + r32] = __float2bfloat16(o[d0][r] * rli[r]); }
  __syncthreads();
#undef SLOAD
#undef SWRITE
#undef SWAIT
#undef RESC
}

#define V8SWZ(row, colB) ((row) * 64 + ((colB) ^ ((((row) >> 2) & 3) << 4)))
__device__ __forceinline__ unsigned pk4_fp8(float a, float b, float c, float d) { unsigned w = 0u; w = __builtin_amdgcn_cvt_pk_fp8_f32(a, b, w, false); w = __builtin_amdgcn_cvt_pk_fp8_f32(c, d, w, true); return w; }
constexpr float PB8 = 6.f, THR8 = 2.f;
typedef float f32x2v __attribute__((ext_vector_type(2)));
__device__ __forceinline__ void partialSM8(f32x16& p0, f32x16& p1, float& m_reg, float& mn, float& alpha) {
  constexpr float C = SCALE * 1.4426950408889634f;
  float pmax = p0[0]; for (int r = 1; r < 16; ++r) pmax = fmaxf(pmax, p0[r]); for (int r = 0; r < 16; ++r) pmax = fmaxf(pmax, p1[r]);
  { auto rr = __builtin_amdgcn_permlane32_swap(__float_as_uint(pmax), __float_as_uint(pmax), false, false);
    pmax = fmaxf(__uint_as_float(rr[0]), __uint_as_float(rr[1])); }
  if (__builtin_expect(__all(pmax - m_reg <= THR8 / C), 1)) { mn = m_reg; alpha = 1.f; }
  else { mn = fmaxf(m_reg, pmax); alpha = __builtin_amdgcn_exp2f((m_reg - mn) * C); m_reg = mn; }
  const float mnC = PB8 - mn * C; const f32x2v C2 = {C, C}, M2 = {mnC, mnC};
#pragma unroll
  for (int r = 0; r < 16; r += 2) { const f32x2v a = __builtin_elementwise_fma((f32x2v){p0[r], p0[r + 1]}, C2, M2), b = __builtin_elementwise_fma((f32x2v){p1[r], p1[r + 1]}, C2, M2);
    p0[r] = a.x; p0[r + 1] = a.y; p1[r] = b.x; p1[r + 1] = b.y; }
  for (int r = 0; r < 16; ++r) p0[r] = __builtin_amdgcn_exp2f(p0[r]);
}
__device__ __forceinline__ unsigned pk4_fp8n(float a, float b, float c, float d) {
  unsigned w = __float_as_uint(a); w = __builtin_amdgcn_cvt_pk_fp8_f32(a, b, w, false); w = __builtin_amdgcn_cvt_pk_fp8_f32(c, d, w, true); return w; }
__device__ __forceinline__ void finishSM8(f32x16& p0, f32x16& p1, float alpha, float& l_reg, i32x8& P8) {
  for (int r = 0; r < 16; ++r) p1[r] = __builtin_amdgcn_exp2f(p1[r]);
  f32x2v s2 = {p0[0], p0[1]};
#pragma unroll
  for (int r = 2; r < 16; r += 2) s2 += (f32x2v){p0[r], p0[r + 1]};
#pragma unroll
  for (int r = 0; r < 16; r += 2) s2 += (f32x2v){p1[r], p1[r + 1]};
  float ps = s2.x + s2.y;
  { auto rr = __builtin_amdgcn_permlane32_swap(__float_as_uint(ps), __float_as_uint(ps), false, false);
    ps = __uint_as_float(rr[0]) + __uint_as_float(rr[1]); }
  l_reg = l_reg * alpha + ps;
#pragma unroll
  for (int k = 0; k < 4; ++k) { P8[k] = (int)pk4_fp8n(p0[4 * k], p0[4 * k + 1], p0[4 * k + 2], p0[4 * k + 3]); P8[4 + k] = (int)pk4_fp8n(p1[4 * k], p1[4 * k + 1], p1[4 * k + 2], p1[4 * k + 3]); }
}
__device__ __forceinline__ void pv8_load(i32x8* va, const char* Vs, int r32, int hi) {
#pragma unroll
  for (int db = 0; db < 4; ++db) {
    const i32x4 a0 = *reinterpret_cast<const i32x4*>(Vs + V8SWZ(32 * db + r32, 32 * hi)), a1 = *reinterpret_cast<const i32x4*>(Vs + V8SWZ(32 * db + r32, 32 * hi + 16));
    va[db] = __builtin_shufflevector(a0, a1, 0, 1, 2, 3, 4, 5, 6, 7); }
}
__device__ __forceinline__ void pv8_mma(f32x16* o, const i32x8* va, const i32x8& P8) {
#pragma unroll
  for (int db = 0; db < 4; ++db) o[db] = __builtin_amdgcn_mfma_scale_f32_32x32x64_f8f6f4(va[db], P8, o[db], 0, 0, 0, 0x7F7F7F7F, 0, 0x7F7F7F7F);
}
#define PIN16(p) do { _Pragma("unroll") for (int r_ = 0; r_ < 16; ++r_) asm volatile("" : "+v"((p)[r_])); } while (0)
#define PV_SCHED() do { __builtin_amdgcn_sched_group_barrier(0x002, 20, 0); __builtin_amdgcn_sched_group_barrier(0x008, 1, 0); __builtin_amdgcn_sched_group_barrier(0x002, 20, 0); __builtin_amdgcn_sched_group_barrier(0x008, 1, 0); \
    __builtin_amdgcn_sched_group_barrier(0x002, 20, 0); __builtin_amdgcn_sched_group_barrier(0x008, 1, 0); __builtin_amdgcn_sched_group_barrier(0x002, 6, 0); __builtin_amdgcn_sched_group_barrier(0x008, 1, 0); } while (0)
#define QK_SCHED16() do { __builtin_amdgcn_sched_group_barrier(0x100, 16, 0); __builtin_amdgcn_sched_group_barrier(0x002, 14, 0); __builtin_amdgcn_sched_group_barrier(0x008, 1, 0); __builtin_amdgcn_sched_group_barrier(0x002, 14, 0); \
    __builtin_amdgcn_sched_group_barrier(0x008, 1, 0); __builtin_amdgcn_sched_group_barrier(0x002, 14, 0); __builtin_amdgcn_sched_group_barrier(0x008, 1, 0); __builtin_amdgcn_sched_group_barrier(0x002, 14, 0); __builtin_amdgcn_sched_group_barrier(0x008, 1, 0); } while (0)
#define QK_SCHED() do { __builtin_amdgcn_sched_group_barrier(0x100, 8, 0); __builtin_amdgcn_sched_group_barrier(0x002, 14, 0); __builtin_amdgcn_sched_group_barrier(0x008, 1, 0); __builtin_amdgcn_sched_group_barrier(0x002, 14, 0); \
    __builtin_amdgcn_sched_group_barrier(0x008, 1, 0); __builtin_amdgcn_sched_group_barrier(0x002, 14, 0); __builtin_amdgcn_sched_group_barrier(0x008, 1, 0); __builtin_amdgcn_sched_group_barrier(0x002, 14, 0); __builtin_amdgcn_sched_group_barrier(0x008, 1, 0); } while (0)
__device__ __forceinline__ void attn_dense_body88(const bf16* __restrict__ Qb, const unsigned char* __restrict__ K8h, const unsigned char* __restrict__ VT8h,
                                                  bf16* __restrict__ Ob, int seq, char* lds) {
  using TQ = bf16;
  int tid_ = threadIdx.x; asm volatile("" : "+v"(tid_));
  const int tid = tid_, wid = tid >> 6, lane = tid & 63, r32 = lane & 31, hi = lane >> 5;
  char* V_lds = lds; bf16* K_lds = (bf16*)(lds + 2 * SHM_V);
  float m_reg = -1e30f, l_reg = 0; f32x16 o[4] = {}; i32x8 qr[2];
  const TQ* Qw = Qb + (long)(wid * QBLK + r32) * LDQ + hi * 32;
#pragma unroll
  for (int d0 = 0; d0 < 2; ++d0) {
#pragma unroll
    for (int c = 0; c < 4; ++c) { const bf16x8 x = *reinterpret_cast<const bf16x8*>(Qw + d0 * 64 + c * 8); const unsigned* xu = reinterpret_cast<const unsigned*>(&x);
      qr[d0][2 * c] = (int)pk4_fp8(__uint_as_float(xu[0] << 16), __uint_as_float(xu[0] & 0xffff0000u), __uint_as_float(xu[1] << 16), __uint_as_float(xu[1] & 0xffff0000u));
      qr[d0][2 * c + 1] = (int)pk4_fp8(__uint_as_float(xu[2] << 16), __uint_as_float(xu[2] & 0xffff0000u), __uint_as_float(xu[3] << 16), __uint_as_float(xu[3] & 0xffff0000u)); } }
  const int kr8 = tid >> 3, kc8 = (tid & 7) * 16;
  constexpr int SD8 = 1;
  struct { i32x4 v8, k8; } sr_[SD8];
#define SLOAD(i, k0) do { sr_[i].v8 = *reinterpret_cast<const i32x4*>(VT8h + (long)((k0) >> 6) * 8192 + tid * 16); \
    sr_[i].k8 = *reinterpret_cast<const i32x4*>(K8h + (long)((k0) + kr8) * LDK8 + kc8); } while (0)
#define SWRITE(b, i) do { *(i32x4*)(V_lds + (b) * SHM_V + V8SWZ(tid >> 2, (tid & 3) * 16)) = sr_[i].v8; \
    *(i32x4*)((char*)K_lds + (b) * SHM_K + K8SWZ(kr8, kc8)) = sr_[i].k8; } while (0)
#define SWAIT(more) do { if (SD8 == 2 && (more)) asm volatile("s_waitcnt vmcnt(2)" ::: "memory"); else asm volatile("s_waitcnt vmcnt(0)" ::: "memory"); } while (0)
#define RESC(a) do { if (__any((a) < 1.f)) { for (int d = 0; d < 4; ++d) for (int r = 0; r < 16; ++r) o[d][r] *= (a); } } while (0)
  f32x16 pA0, pA1, pB0, pB1; float mnA, mnB, alA, alB; i32x8 P8; i32x8 va[4]; const int NT = seq / KVBLK;
  constexpr int SE = 0, SO = SD8 - 1;
  SLOAD(SE, 0); asm volatile("s_waitcnt vmcnt(0)" ::: "memory"); SWRITE(0, SE); __syncthreads();
  qkt8(pA0, pA1, K_lds, qr, r32, hi); partialSM8(pA0, pA1, m_reg, mnA, alA);
  SLOAD(SO, KVBLK); if constexpr (SD8 == 2) { if (2 < NT) SLOAD(SE, 2 * KVBLK); }
  SWAIT(2 < NT); SWRITE(1, SO); __syncthreads();
  for (int j = 1; j + 1 < NT; j += 2) {
    SBAR(); qkt8(pB0, pB1, (bf16*)((char*)K_lds + SHM_K), qr, r32, hi);
    finishSM8(pA0, pA1, alA, l_reg, P8); QK_SCHED(); SBAR();
    SLOAD(SO, (j + SD8) * KVBLK); pv8_load(va, V_lds, r32, hi); SBAR();
    pv8_mma(o, va, P8); partialSM8(pB0, pB1, m_reg, mnB, alB); PIN16(pB0); PIN16(pB1); PV_SCHED(); SBAR();
    __syncthreads(); SWAIT(true); SWRITE(0, SE);
    RESC(alB); __syncthreads();
    SBAR(); qkt8(pA0, pA1, K_lds, qr, r32, hi);
    finishSM8(pB0, pB1, alB, l_reg, P8); QK_SCHED(); SBAR();
    if (SD8 == 1 || j + 3 < NT) SLOAD(SE, (j + 1 + SD8) * KVBLK); pv8_load(va, V_lds + SHM_V, r32, hi); SBAR();
    pv8_mma(o, va, P8); partialSM8(pA0, pA1, m_reg, mnA, alA); PIN16(pA0); PIN16(pA1); PV_SCHED(); SBAR();
    __syncthreads(); SWAIT(j + 3 < NT); SWRITE(1, SO);
    RESC(alA); __syncthreads();
  }
  SBAR(); qkt8(pB0, pB1, (bf16*)((char*)K_lds + SHM_K), qr, r32, hi);
  finishSM8(pA0, pA1, alA, l_reg, P8); QK_SCHED(); SBAR();
  pv8_load(va, V_lds, r32, hi); SBAR(); pv8_mma(o, va, P8); partialSM8(pB0, pB1, m_reg, mnB, alB); PIN16(pB0); PIN16(pB1); PV_SCHED(); SBAR();
  __syncthreads(); RESC(alB);
  finishSM8(pB0, pB1, alB, l_reg, P8); SBAR();
  pv8_load(va, V_lds + SHM_V, r32, hi); pv8_mma(o, va, P8);
  const float rl = __builtin_amdgcn_rcpf(l_reg);
  bf16* Ow = Ob + (long)(wid * QBLK + r32) * LDO;
#pragma unroll
  for (int db = 0; db < 4; ++db)
#pragma unroll
    for (int g = 0; g < 4; ++g) { const unsigned lo = cvtpk(o[db][4 * g] * rl, o[db][4 * g + 1] * rl), hw = cvtpk(o[db][4 * g + 2] * rl, o[db][4 * g + 3] * rl);
      *reinterpret_cast<unsigned long long*>(Ow + 32 * db + 8 * g + 4 * hi) = (unsigned long long)lo | ((unsigned long long)hw << 32); }
  __syncthreads();
#undef SLOAD
#undef SWRITE
#undef SWAIT
#undef RESC
}

__device__ __forceinline__ void attn_dense_body88p(const bf16* __restrict__ Qb, const unsigned char* __restrict__ K8h, const unsigned char* __restrict__ VT8h,
                                                  bf16* __restrict__ Ob, int seq, char* lds) {
  using TQ = bf16;
  int tid_ = threadIdx.x; asm volatile("" : "+v"(tid_));
  const int tid = tid_, wid = tid >> 6, lane = tid & 63, r32 = lane & 31, hi = lane >> 5;
  char* V_lds = lds; bf16* K_lds = (bf16*)(lds + 2 * SHM_V);
  float m_reg = -1e30f, l_reg = 0; f32x16 o[4] = {}; i32x8 qr[2];
  const TQ* Qw = Qb + (long)(wid * QBLK + r32) * LDQ + hi * 32;
#pragma unroll
  for (int d0 = 0; d0 < 2; ++d0) {
#pragma unroll
    for (int c = 0; c < 4; ++c) { const bf16x8 x = *reinterpret_cast<const bf16x8*>(Qw + d0 * 64 + c * 8); const unsigned* xu = reinterpret_cast<const unsigned*>(&x);
      qr[d0][2 * c] = (int)pk4_fp8(__uint_as_float(xu[0] << 16), __uint_as_float(xu[0] & 0xffff0000u), __uint_as_float(xu[1] << 16), __uint_as_float(xu[1] & 0xffff0000u));
      qr[d0][2 * c + 1] = (int)pk4_fp8(__uint_as_float(xu[2] << 16), __uint_as_float(xu[2] & 0xffff0000u), __uint_as_float(xu[3] << 16), __uint_as_float(xu[3] & 0xffff0000u)); } }
  const int kr8 = tid >> 3, kc8 = (tid & 7) * 16;
  struct { i32x4 v8[2], k8[2]; } sr_;
#define SLOADP(pr) do { _Pragma("unroll") for (int s_ = 0; s_ < 2; ++s_) { const long tl_ = 2 * (long)(pr) + s_; \
    sr_.v8[s_] = *reinterpret_cast<const i32x4*>(VT8h + tl_ * 8192 + tid * 16); sr_.k8[s_] = *reinterpret_cast<const i32x4*>(K8h + (tl_ * 64 + kr8) * LDK8 + kc8); } } while (0)
#define SWRITEP(b) do { _Pragma("unroll") for (int s_ = 0; s_ < 2; ++s_) { *(i32x4*)(V_lds + (b) * SHM_V + s_ * 8192 + V8SWZ(tid >> 2, (tid & 3) * 16)) = sr_.v8[s_]; \
    *(i32x4*)((char*)K_lds + (b) * SHM_K + s_ * 8192 + K8SWZ(kr8, kc8)) = sr_.k8[s_]; } } while (0)
#define RESC(a) do { if (__any((a) < 1.f)) { for (int d = 0; d < 4; ++d) for (int r = 0; r < 16; ++r) o[d][r] *= (a); } } while (0)
#define KT(b, s) ((const bf16*)((const char*)K_lds + (b) * SHM_K + (s) * 8192))
#define VT(b, s) (V_lds + (b) * SHM_V + (s) * 8192)
#define STEP(pN0, pN1, mnN, alN, pC0, pC1, alC, KP, VP) do { \
    SBAR(); qkt8(pN0, pN1, KP, qr, r32, hi); finishSM8(pC0, pC1, alC, l_reg, P8); QK_SCHED(); SBAR(); \
    pv8_load(va, VP, r32, hi); SBAR(); \
    pv8_mma(o, va, P8); partialSM8(pN0, pN1, m_reg, mnN, alN); PIN16(pN0); PIN16(pN1); PV_SCHED(); SBAR(); \
    RESC(alN); } while (0)
  f32x16 pA0, pA1, pB0, pB1; float mnA, mnB, alA, alB; i32x8 P8; i32x8 va[4]; const int NT = seq / KVBLK, NP = NT >> 1, NI = NT >> 2;
  SLOADP(0); asm volatile("s_waitcnt vmcnt(0)" ::: "memory"); SWRITEP(0); SLOADP(1); __syncthreads();
  qkt8(pA0, pA1, KT(0, 0), qr, r32, hi); partialSM8(pA0, pA1, m_reg, mnA, alA);
  SWRITEP(1); if (2 < NP) SLOADP(2);
  for (int i = 0; i + 1 < NI; ++i) {
    STEP(pB0, pB1, mnB, alB, pA0, pA1, alA, KT(0, 1), VT(0, 0));
    __syncthreads();
    STEP(pA0, pA1, mnA, alA, pB0, pB1, alB, KT(1, 0), VT(0, 1));
    __syncthreads();
    SWRITEP(0); SLOADP(2 * i + 3);
    STEP(pB0, pB1, mnB, alB, pA0, pA1, alA, KT(1, 1), VT(1, 0));
    __syncthreads();
    STEP(pA0, pA1, mnA, alA, pB0, pB1, alB, KT(0, 0), VT(1, 1));
    __syncthreads();
    SWRITEP(1); if (2 * i + 4 < NP) SLOADP(2 * i + 4);
  }
  STEP(pB0, pB1, mnB, alB, pA0, pA1, alA, KT(0, 1), VT(0, 0));
  __syncthreads();
  STEP(pA0, pA1, mnA, alA, pB0, pB1, alB, KT(1, 0), VT(0, 1));
  STEP(pB0, pB1, mnB, alB, pA0, pA1, alA, KT(1, 1), VT(1, 0));
  finishSM8(pB0, pB1, alB, l_reg, P8); SBAR();
  pv8_load(va, VT(1, 1), r32, hi); pv8_mma(o, va, P8);
  const float rl = __builtin_amdgcn_rcpf(l_reg);
  bf16* Ow = Ob + (long)(wid * QBLK + r32) * LDO;
#pragma unroll
  for (int db = 0; db < 4; ++db)
#pragma unroll
    for (int g = 0; g < 4; ++g) { const unsigned lo = cvtpk(o[db][4 * g] * rl, o[db][4 * g + 1] * rl), hw = cvtpk(o[db][4 * g + 2] * rl, o[db][4 * g + 3] * rl);
      *reinterpret_cast<unsigned long long*>(Ow + 32 * db + 8 * g + 4 * hi) = (unsigned long long)lo | ((unsigned long long)hw << 32); }
  __syncthreads();
#undef SLOADP
#undef SWRITEP
#undef RESC
#undef KT
#undef VT
#undef STEP
}

__device__ __forceinline__ void attn_dense_body88q(const bf16* __restrict__ Qb, const unsigned char* __restrict__ K8h, const unsigned char* __restrict__ VT8h,
                                                  bf16* __restrict__ Ob, int seq, char* lds) {
  using TQ = bf16;
  int tid_ = threadIdx.x; asm volatile("" : "+v"(tid_));
  const int tid = tid_, wid = tid >> 6, lane = tid & 63, r32 = lane & 31, hi = lane >> 5;
  char* V_lds = lds; bf16* K_lds = (bf16*)(lds + 2 * SHM_V);
  float m_reg = -1e30f, l_reg = 0; f32x16 o[4] = {}; i32x8 qr[2];
  const TQ* Qw = Qb + (long)(wid * QBLK + r32) * LDQ + hi * 32;
#pragma unroll
  for (int d0 = 0; d0 < 2; ++d0) {
#pragma unroll
    for (int c = 0; c < 4; ++c) { const bf16x8 x = *reinterpret_cast<const bf16x8*>(Qw + d0 * 64 + c * 8); const unsigned* xu = reinterpret_cast<const unsigned*>(&x);
      qr[d0][2 * c] = (int)pk4_fp8(__uint_as_float(xu[0] << 16), __uint_as_float(xu[0] & 0xffff0000u), __uint_as_float(xu[1] << 16), __uint_as_float(xu[1] & 0xffff0000u));
      qr[d0][2 * c + 1] = (int)pk4_fp8(__uint_as_float(xu[2] << 16), __uint_as_float(xu[2] & 0xffff0000u), __uint_as_float(xu[3] << 16), __uint_as_float(xu[3] & 0xffff0000u)); } }
  const int kr8 = tid >> 3, kc8 = (tid & 7) * 16;
  typedef __attribute__((address_space(3))) char aldsc; typedef __attribute__((address_space(3))) i32x4 aldsc_i4;
#define LDS_BASE(expr) ({ unsigned u_ = (unsigned)(uintptr_t)(aldsc*)(expr); asm volatile("" : "+v"(u_)); (aldsc*)(uintptr_t)u_; })
  aldsc* const kb00 = LDS_BASE(lds + 65536 + K8SWZ(r32, hi * 32)),      * const kb01 = LDS_BASE(lds + 65536 + K8SWZ(r32, hi * 32 + 16));
  aldsc* const kb10 = LDS_BASE(lds + 65536 + K8SWZ(r32, 64 + hi * 32)), * const kb11 = LDS_BASE(lds + 65536 + K8SWZ(r32, 64 + hi * 32 + 16));
  aldsc* const vb0 = LDS_BASE(lds + V8SWZ(r32, 32 * hi)), * const vb1 = LDS_BASE(lds + V8SWZ(r32, 32 * hi + 16));
  aldsc* const kw = LDS_BASE(lds + 65536 + K8SWZ(kr8, kc8)), * const vw = LDS_BASE(lds + V8SWZ(tid >> 2, (tid & 3) * 16));
#define LD4(p) (*(const aldsc_i4*)(p))
#define CAT8(x, y) __builtin_shufflevector(x, y, 0, 1, 2, 3, 4, 5, 6, 7)
#define QKT8Q(p0, p1, ko) do { p0 = f32x16{}; p1 = f32x16{}; \
    { const i32x8 A0 = CAT8(LD4(kb00 + (ko)), LD4(kb01 + (ko))), A1 = CAT8(LD4(kb00 + (ko) + 4096), LD4(kb01 + (ko) + 4096)); \
      p0 = __builtin_amdgcn_mfma_scale_f32_32x32x64_f8f6f4(A0, qr[0], p0, 0, 0, 0, 0x7F7F7F7F, 0, 0x7F7F7F7F); p1 = __builtin_amdgcn_mfma_scale_f32_32x32x64_f8f6f4(A1, qr[0], p1, 0, 0, 0, 0x7F7F7F7F, 0, 0x7F7F7F7F); } \
    { const i32x8 A0 = CAT8(LD4(kb10 + (ko)), LD4(kb11 + (ko))), A1 = CAT8(LD4(kb10 + (ko) + 4096), LD4(kb11 + (ko) + 4096)); \
      p0 = __builtin_amdgcn_mfma_scale_f32_32x32x64_f8f6f4(A0, qr[1], p0, 0, 0, 0, 0x7F7F7F7F, 0, 0x7F7F7F7F); p1 = __builtin_amdgcn_mfma_scale_f32_32x32x64_f8f6f4(A1, qr[1], p1, 0, 0, 0, 0x7F7F7F7F, 0, 0x7F7F7F7F); } } while (0)
#define PV8LQ(vo) do { _Pragma("unroll") for (int db_ = 0; db_ < 4; ++db_) va[db_] = CAT8(LD4(vb0 + (vo) + 2048 * db_), LD4(vb1 + (vo) + 2048 * db_)); } while (0)
  struct { i32x4 v8[2], k8[2]; } sr_;
#define SLOADH(qd, h) do { _Pragma("unroll") for (int s_ = 0; s_ < 2; ++s_) { const long tl_ = 4 * (long)(qd) + 2 * (h) + s_; \
    sr_.v8[s_] = *reinterpret_cast<const i32x4*>(VT8h + tl_ * 8192 + tid * 16); sr_.k8[s_] = *reinterpret_cast<const i32x4*>(K8h + (tl_ * 64 + kr8) * LDK8 + kc8); } } while (0)
#define SWRITEH(b, h) do { _Pragma("unroll") for (int s_ = 0; s_ < 2; ++s_) { *(aldsc_i4*)(vw + (b) * 32768 + (2 * (h) + s_) * 8192) = sr_.v8[s_]; \
    *(aldsc_i4*)(kw + (b) * 32768 + (2 * (h) + s_) * 8192) = sr_.k8[s_]; } } while (0)
#define RESC(a) do { if (__any((a) < 1.f)) { for (int d = 0; d < 4; ++d) for (int r = 0; r < 16; ++r) o[d][r] *= (a); } } while (0)
#define KT(b, s) ((b) * 32768 + (s) * 8192)
#define VT(b, s) ((b) * 32768 + (s) * 8192)
#define STEP(pN0, pN1, mnN, alN, pC0, pC1, alC, KP, VP) do { \
    SBAR(); QKT8Q(pN0, pN1, KP); finishSM8(pC0, pC1, alC, l_reg, P8); QK_SCHED(); SBAR(); \
    PV8LQ(VP); SBAR(); \
    pv8_mma(o, va, P8); partialSM8(pN0, pN1, m_reg, mnN, alN); PIN16(pN0); PIN16(pN1); PV_SCHED(); SBAR(); \
    RESC(alN); } while (0)
#define STEP_E(KP, VP) STEP(pB0, pB1, mnB, alB, pA0, pA1, alA, KP, VP)
#define STEP_O(KP, VP) STEP(pA0, pA1, mnA, alA, pB0, pB1, alB, KP, VP)
  static_assert(65536 + 2 * 32768 <= 147456, "attention quad buffers");
  f32x16 pA0, pA1, pB0, pB1; float mnA, mnB, alA, alB; i32x8 P8; i32x8 va[4]; const int NT = seq / KVBLK, NQ = NT >> 2, NI = NT >> 3;
  SLOADH(0, 0); asm volatile("s_waitcnt vmcnt(0)" ::: "memory"); SWRITEH(0, 0); SLOADH(0, 1); SWRITEH(0, 1); SLOADH(1, 0); __syncthreads();
  QKT8Q(pA0, pA1, KT(0, 0)); partialSM8(pA0, pA1, m_reg, mnA, alA);
  SWRITEH(1, 0); SLOADH(1, 1);
  for (int i = 0; i + 1 < NI; ++i) {
    STEP_E(KT(0, 1), VT(0, 0)); STEP_O(KT(0, 2), VT(0, 1));
    SWRITEH(1, 1); SLOADH(2 * i + 2, 0);
    STEP_E(KT(0, 3), VT(0, 2));
    __syncthreads();
    STEP_O(KT(1, 0), VT(0, 3));
    __syncthreads();
    SWRITEH(0, 0); SLOADH(2 * i + 2, 1);
    STEP_E(KT(1, 1), VT(1, 0)); STEP_O(KT(1, 2), VT(1, 1));
    SWRITEH(0, 1); SLOADH(2 * i + 3, 0);
    STEP_E(KT(1, 3), VT(1, 2));
    __syncthreads();
    STEP_O(KT(0, 0), VT(1, 3));
    __syncthreads();
    SWRITEH(1, 0); SLOADH(2 * i + 3, 1);
  }
  STEP_E(KT(0, 1), VT(0, 0)); STEP_O(KT(0, 2), VT(0, 1));
  SWRITEH(1, 1);
  STEP_E(KT(0, 3), VT(0, 2));
  __syncthreads();
  STEP_O(KT(1, 0), VT(0, 3));
  STEP_E(KT(1, 1), VT(1, 0)); STEP_O(KT(1, 2), VT(1, 1)); STEP_E(KT(1, 3), VT(1, 2));
  finishSM8(pB0, pB1, alB, l_reg, P8); SBAR();
  PV8LQ(VT(1, 3)); pv8_mma(o, va, P8);
  const float rl = __builtin_amdgcn_rcpf(l_reg);
  bf16* Ow = Ob + (long)(wid * QBLK + r32) * LDO;
#pragma unroll
  for (int db = 0; db < 4; ++db)
#pragma unroll
    for (int g = 0; g < 4; ++g) { const unsigned lo = cvtpk(o[db][4 * g] * rl, o[db][4 * g + 1] * rl), hw = cvtpk(o[db][4 * g + 2] * rl, o[db][4 * g + 3] * rl);
      *reinterpret_cast<unsigned long long*>(Ow + 32 * db + 8 * g + 4 * hi) = (unsigned long long)lo | ((unsigned long long)hw << 32); }
  __syncthreads();
#undef SLOADH
#undef SWRITEH
#undef LDS_BASE
#undef LD4
#undef CAT8
#undef QKT8Q
#undef PV8LQ
#undef RESC
#undef KT
#undef VT
#undef STEP
#undef STEP_E
#undef STEP_O
}

}
#define GAS __attribute__((address_space(1)))
#define LAS __attribute__((address_space(3)))
typedef unsigned short bfu;
typedef unsigned v4u __attribute__((ext_vector_type(4)));
typedef float f32x4 __attribute__((ext_vector_type(4)));
typedef short bf16x8 __attribute__((ext_vector_type(8)));
typedef GAS unsigned gu32;
typedef GAS unsigned long long gu64;
#define RLX_AGENT __ATOMIC_RELAXED, __HIP_MEMORY_SCOPE_AGENT
#define LDS_WAIT() asm volatile("s_waitcnt lgkmcnt(0)" ::: "memory")
#define VM_WAIT() asm volatile("s_waitcnt vmcnt(0)" ::: "memory")
__device__ __forceinline__ unsigned long long rt() { return __builtin_amdgcn_s_memrealtime(); }
__device__ __forceinline__ unsigned f2bf(float f) { unsigned u = __builtin_bit_cast(unsigned, f); return (u + 0x7fffu + ((u >> 16) & 1u)) >> 16; }
__device__ __forceinline__ unsigned pk2(float lo, float hi) { return f2bf(lo) | (f2bf(hi) << 16); }

#define XB_TMO      128
#define XB_XCNT(j)  (256  + 64 * (j))
#define XB_XSUB(j)  (1280 + 64 * (j))
#define XB_XGEN(j)  (2304 + 64 * (j))
#define XB_TOP      3328
#define XB_TOPGEN   3392
#define XCD_BAR_WORDS 3456
#define XB_SPIN_CAP (1u << 18)

__device__ __forceinline__ unsigned xb_ld(unsigned* p)              { return __hip_atomic_load(p, __ATOMIC_RELAXED, __HIP_MEMORY_SCOPE_AGENT); }
__device__ __forceinline__ unsigned xb_add(unsigned* p, unsigned v) { return __hip_atomic_fetch_add(p, v, __ATOMIC_RELAXED, __HIP_MEMORY_SCOPE_AGENT); }
__device__ __forceinline__ unsigned xb_xcc_id() { return (unsigned)__builtin_amdgcn_s_getreg((3 << 11) | 20) & 0xFu; }
#define XB_SPIN(cond, bar) do { unsigned _sp = 0; while (cond) { __builtin_amdgcn_s_sleep(1); \
    if ((++_sp & 255u) == 0u) { if (xb_ld(&(bar)[XB_TMO])) break; if (_sp > XB_SPIN_CAP) { atomicAdd(&(bar)[XB_TMO], 1u); break; } } } } while (0)

struct XcdBarrier {
    unsigned* bar; unsigned x;
    volatile LAS unsigned* st;
};

__device__ __forceinline__ XcdBarrier xcd_barrier_post(unsigned* bar, volatile LAS unsigned* st) {
    XcdBarrier b; b.bar = bar; b.x = xb_xcc_id(); b.st = st;
    if (threadIdx.x == 0) (void)xb_add(&bar[XB_XCNT(b.x)], 1u);
    return b;
}
__device__ __forceinline__ void xcd_barrier_complete(unsigned* bar, unsigned x, unsigned& nloc, unsigned& nx) {
    const unsigned G = gridDim.x * gridDim.y * gridDim.z;
    unsigned sum, cnt, mine, sp = 0u;
    for (;;) {
        sum = 0u; cnt = 0u; mine = 0u;
#pragma unroll
        for (unsigned j = 0; j < 16; ++j) { const unsigned c = xb_ld(&bar[XB_XCNT(j)]); sum += c; cnt += (c > 0u) ? 1u : 0u; mine = (j == x) ? c : mine; }
        if (sum == G) break;
        __builtin_amdgcn_s_sleep(1);
        if ((++sp & 255u) == 0u) { if (xb_ld(&bar[XB_TMO])) break; if (sp > XB_SPIN_CAP) { atomicAdd(&bar[XB_TMO], 1u); break; } }
    }
    nloc = mine > 0u ? mine : 1u; nx = cnt > 0u ? cnt : 1u;
}

__device__ __forceinline__ void xcd_barrier(const XcdBarrier& b) {
    asm volatile("s_waitcnt vmcnt(0)" ::: "memory");
    __syncthreads();
    if (threadIdx.x == 0) {
        unsigned* bar = b.bar;
        __builtin_amdgcn_s_waitcnt(0);
        unsigned nloc = b.st[0], nx = b.st[1];
        if (nloc == 0u) { xcd_barrier_complete(bar, b.x, nloc, nx); b.st[0] = nloc; b.st[1] = nx; }
#if defined(BAR_ALL_RELEASE)
        __builtin_amdgcn_fence(__ATOMIC_RELEASE, "agent"); asm volatile("s_waitcnt vmcnt(0)" ::: "memory");
#endif
        const unsigned old = xb_add(&bar[XB_XSUB(b.x)], 1u);
        const unsigned gen = old / nloc;
        if (old + 1u == (gen + 1u) * nloc) {
            __builtin_amdgcn_fence(__ATOMIC_RELEASE, "agent");
            asm volatile("s_waitcnt vmcnt(0)" ::: "memory");
            const unsigned og = xb_add(&bar[XB_TOP], 1u);
            const unsigned tg = og / nx;
            if (og + 1u == (tg + 1u) * nx) xb_add(&bar[XB_TOPGEN], 1u);
            else XB_SPIN(xb_ld(&bar[XB_TOPGEN]) == tg, bar);
            __builtin_amdgcn_fence(__ATOMIC_ACQUIRE, "agent");
            xb_add(&bar[XB_XGEN(b.x)], 1u);
            asm volatile("s_waitcnt vmcnt(0)" ::: "memory");
        } else {
            XB_SPIN(xb_ld(&bar[XB_XGEN(b.x)]) == gen, bar);
            __builtin_amdgcn_fence(__ATOMIC_ACQUIRE, "agent");
            asm volatile("s_waitcnt vmcnt(0)" ::: "memory");
        }
    }
    __syncthreads();
}
constexpr size_t MiB = 1u << 20;
constexpr size_t WS_CTL = 0, CTL_ZERO_BYTES = 1 * MiB;
constexpr size_t WS_WIN = 2 * MiB,  WIN_L = 21 * MiB;
constexpr size_t WS_WOUT = 44 * MiB, WOUT_L = 8 * MiB;
constexpr size_t WS_WGU = 60 * MiB, WGU_E = 8 * MiB, WGU_L = 16 * WGU_E;
constexpr size_t WS_WD = 316 * MiB, WD_E = 4 * MiB, WD_L = 16 * WD_E;
constexpr size_t WS_XN8 = 444 * MiB;
constexpr size_t WS_WIN8 = 524 * MiB, WIN8_L = 7 * MiB;
constexpr size_t WS_XNI8 = 540 * MiB;
constexpr size_t WS_WINI8 = 444 * MiB, WINI8_L = 11 * MiB;
constexpr size_t WS_MIXI8 = 632 * MiB;
constexpr size_t WS_WOUTI8 = 712 * MiB, WOUTI8_L = 4 * MiB;
constexpr size_t WS_K8 = 468 * MiB;
constexpr size_t WS_VT8 = 480 * MiB;
constexpr int NCOLI = 1792;
constexpr int NCOL8 = 3584;
constexpr float WGU_SCALE = 32.f, WD_SCALE = 64.f, WIN_SCALE = 32.f, YE_SCALE = 16.f;
constexpr size_t WS_XN = 828 * MiB;
constexpr size_t WS_PROJ = 988 * MiB;
constexpr size_t WS_MIX = 1392 * MiB;
constexpr size_t WS_HID = 1552 * MiB;
constexpr size_t WS_QKT = WS_HID + 160 * MiB;
constexpr size_t WS_MISC = 1872 * MiB;
constexpr size_t WS_LSE = WS_MISC, WS_AFFT = WS_MISC + 1 * MiB, WS_SLOT = WS_MISC + 4 * MiB, WS_IDX = WS_MISC + 7 * MiB, WS_GATE = WS_MISC + 7 * MiB + 512 * 1024, WS_ADEC = WS_MISC + 8 * MiB;
constexpr size_t WS_RSC = WS_MISC + 10 * MiB, WS_CSC = WS_MISC + 11 * MiB;
constexpr size_t WS_CSCGU = WS_MISC + 9 * MiB + 256 * 1024, WS_XRS = WS_MISC + 10 * MiB + 256 * 1024;
constexpr size_t WS_RSC2 = WS_MISC + 10 * MiB + 640 * 1024, WS_CSC2 = WS_MISC + 11 * MiB + 512 * 1024;
constexpr size_t WS_END = 1884 * MiB;
static_assert(WS_WIN + 2 * WIN_L <= WS_WOUT && WS_WOUT + 2 * WOUT_L <= WS_WGU && WS_WGU + 2 * WGU_L <= WS_WD && WS_WD + 2 * WD_L <= WS_WINI8 && WS_WINI8 + 2 * WINI8_L <= WS_K8 && WS_K8 + (size_t)M * 256 <= WS_VT8 && WS_VT8 + (size_t)2 * NCHUNK * 8192 <= WS_XNI8 && WS_XNI8 + (size_t)M * D <= WS_MIXI8 && WS_MIXI8 + (size_t)M * D <= WS_WOUTI8 && WS_WOUTI8 + 2 * WOUTI8_L <= WS_XN, "ws map (weights)");
static_assert(WS_XN + (size_t)M * D * 2 <= WS_PROJ && WS_PROJ + (size_t)M * PP * 2 <= WS_MIX && WS_PROJ + (size_t)XE_ROWS * D * 2 <= WS_MIX && WS_MIX + (size_t)M * D * 2 <= WS_HID, "ws map (activations)");
static_assert(WS_HID + (size_t)XE_ROWS * DFF <= WS_MISC && WS_HID + (size_t)NCHUNK * 8 * 8192 * 4 <= WS_MISC, "ws map (hid)");
static_assert((size_t)M * 6 * 4 <= 1 * MiB && (size_t)16 * M * 4 <= 3 * MiB && (size_t)XE_ROWS * 4 <= 512 * 1024 && (size_t)NCHUNK * 8 * 64 * 4 <= 2 * MiB, "ws map (misc)");
constexpr int CW_BAR = 4096;

#ifndef MK_ONE_LAUNCH
#define MK_ONE_LAUNCH 1
#endif
#ifndef CUT_MASK
#define CUT_MASK 0u
#endif
#define MK_FIXED_RANGE (MK_ONE_LAUNCH && CUT_MASK == 0u)
constexpr int SCR_BYTES = 147456;
constexpr int LDSCTL_OFF = SCR_BYTES, MISC_OFF = LDSCTL_OFF + 320;
constexpr int LDS_BYTES = 155648;
constexpr int NWAVES = 8, NTHR = 512;

struct Frame {
    LAS unsigned char* lds; char* ldsg;
    volatile LAS unsigned* MISC;
    gu32* ctl;
    int tid, lane, wave, vcu, G, bx;
    const float* in[22];
    float* X;
    unsigned char* ws;
};
__device__ __forceinline__ float wave_sum(float v) {
#pragma unroll
    for (int o = 1; o < 64; o <<= 1) v += __shfl_xor(v, o);
    return v;
}
__device__ __forceinline__ float wave_max(float v) {
#pragma unroll
    for (int o = 1; o < 64; o <<= 1) v = fmaxf(v, __shfl_xor(v, o));
    return v;
}
__device__ __forceinline__ float bf2f(unsigned short b) { return __uint_as_float((unsigned)b << 16); }
__device__ __forceinline__ void WG_SYNC() { __syncthreads(); }

__device__ __forceinline__ void ln_norm(f32x4 (&v)[8], const float* g, const float* b, int lane) {
    float s = 0.f;
#pragma unroll
    for (int j = 0; j < 8; ++j) s += (v[j].x + v[j].y) + (v[j].z + v[j].w);
    const float mean = wave_sum(s) * (1.f / D); float s2 = 0.f;
#pragma unroll
    for (int j = 0; j < 8; ++j) { v[j] = v[j] - mean; s2 += (v[j].x * v[j].x + v[j].y * v[j].y) + (v[j].z * v[j].z + v[j].w * v[j].w); }
    const float rstd = 1.f / sqrtf(wave_sum(s2) * (1.f / D) + LN_EPS);
#pragma unroll
    for (int j = 0; j < 8; ++j) { const int o = 8 * lane + 512 * (j >> 1) + 4 * (j & 1); const f32x4 gg = *(const f32x4*)(g + o), bb = *(const f32x4*)(b + o); v[j] = v[j] * rstd * gg + bb; }
}
__device__ __forceinline__ void row_load_f32(const float* row, f32x4 (&v)[8], int lane) {
#pragma unroll
    for (int j = 0; j < 8; ++j) v[j] = *(const f32x4*)(row + 8 * lane + 512 * (j >> 1) + 4 * (j & 1));
}
__device__ __forceinline__ void row_store_f32(float* row, const f32x4 (&v)[8], int lane) {
#pragma unroll
    for (int j = 0; j < 8; ++j) *(f32x4*)(row + 8 * lane + 512 * (j >> 1) + 4 * (j & 1)) = v[j];
}
__device__ __forceinline__ void row_store_bf16(bfu* row, const f32x4 (&v)[8], int lane) {
#pragma unroll
    for (int j = 0; j < 4; ++j) { v4u w; w.x = pk2(v[2 * j].x, v[2 * j].y); w.y = pk2(v[2 * j].z, v[2 * j].w); w.z = pk2(v[2 * j + 1].x, v[2 * j + 1].y); w.w = pk2(v[2 * j + 1].z, v[2 * j + 1].w);
        *(v4u*)(row + 8 * lane + 512 * j) = w; }
}
__device__ __forceinline__ void row_store_fp8(unsigned char* row, const f32x4 (&v)[8], int lane) {
#pragma unroll
    for (int j = 0; j < 4; ++j) { pg8::u32x2 w; w.x = pg8::cvt4_fp8(v[2 * j].x, v[2 * j].y, v[2 * j].z, v[2 * j].w); w.y = pg8::cvt4_fp8(v[2 * j + 1].x, v[2 * j + 1].y, v[2 * j + 1].z, v[2 * j + 1].w);
        *(pg8::u32x2*)(row + 8 * lane + 512 * j) = w; }
}
__device__ __forceinline__ void row_add_fp8(const unsigned char* row, f32x4 (&v)[8], int lane, float scale) {
#pragma unroll
    for (int j = 0; j < 4; ++j) { const pg8::u32x2 w = *(const pg8::u32x2*)(row + 8 * lane + 512 * j);
        const pg8::f32x2 a = __builtin_amdgcn_cvt_pk_f32_fp8(w.x, false), b = __builtin_amdgcn_cvt_pk_f32_fp8(w.x, true), c = __builtin_amdgcn_cvt_pk_f32_fp8(w.y, false), d = __builtin_amdgcn_cvt_pk_f32_fp8(w.y, true);
        v[2 * j].x += a.x * scale; v[2 * j].y += a.y * scale; v[2 * j].z += b.x * scale; v[2 * j].w += b.y * scale;
        v[2 * j + 1].x += c.x * scale; v[2 * j + 1].y += c.y * scale; v[2 * j + 1].z += d.x * scale; v[2 * j + 1].w += d.y * scale; }
}
__device__ __forceinline__ void row_store_i8(unsigned char* row, float* rsc_row, const f32x4 (&v)[8], int lane) {
    float mx = 0.f;
#pragma unroll
    for (int j = 0; j < 8; ++j) mx = fmaxf(mx, fmaxf(fmaxf(fabsf(v[j].x), fabsf(v[j].y)), fmaxf(fabsf(v[j].z), fabsf(v[j].w))));
    mx = wave_max(mx); mx = fmaxf(mx, 1e-20f);
    const float inv = 127.f / mx;
    if (lane == 0) *rsc_row = mx * (1.f / 127.f);
#pragma unroll
    for (int j = 0; j < 4; ++j) { pg8::u32x2 w;
        { const int a = __float2int_rn(v[2 * j].x * inv), b = __float2int_rn(v[2 * j].y * inv), c = __float2int_rn(v[2 * j].z * inv), d = __float2int_rn(v[2 * j].w * inv);
          w.x = (unsigned)(a & 255) | ((unsigned)(b & 255) << 8) | ((unsigned)(c & 255) << 16) | ((unsigned)(d & 255) << 24); }
        { const int a = __float2int_rn(v[2 * j + 1].x * inv), b = __float2int_rn(v[2 * j + 1].y * inv), c = __float2int_rn(v[2 * j + 1].z * inv), d = __float2int_rn(v[2 * j + 1].w * inv);
          w.y = (unsigned)(a & 255) | ((unsigned)(b & 255) << 8) | ((unsigned)(c & 255) << 16) | ((unsigned)(d & 255) << 24); }
        *(pg8::u32x2*)(row + 8 * lane + 512 * j) = w; }
}
__device__ __forceinline__ void row_load_bf16(const bfu* row, f32x4 (&v)[8], int lane, float scale) {
#pragma unroll
    for (int j = 0; j < 4; ++j) { const v4u w = *(const v4u*)(row + 8 * lane + 512 * j);
        v[2 * j] = (f32x4){__uint_as_float(w.x << 16) * scale, __uint_as_float(w.x & 0xffff0000u) * scale, __uint_as_float(w.y << 16) * scale, __uint_as_float(w.y & 0xffff0000u) * scale};
        v[2 * j + 1] = (f32x4){__uint_as_float(w.z << 16) * scale, __uint_as_float(w.z & 0xffff0000u) * scale, __uint_as_float(w.w << 16) * scale, __uint_as_float(w.w & 0xffff0000u) * scale}; }
}
__device__ __forceinline__ void row_add_bf16(const bfu* row, f32x4 (&v)[8], int lane) {
#pragma unroll
    for (int j = 0; j < 4; ++j) { const v4u w = *(const v4u*)(row + 8 * lane + 512 * j);
        v[2 * j].x += __uint_as_float(w.x << 16); v[2 * j].y += __uint_as_float(w.x & 0xffff0000u); v[2 * j].z += __uint_as_float(w.y << 16); v[2 * j].w += __uint_as_float(w.y & 0xffff0000u);
        v[2 * j + 1].x += __uint_as_float(w.z << 16); v[2 * j + 1].y += __uint_as_float(w.z & 0xffff0000u); v[2 * j + 1].z += __uint_as_float(w.w << 16); v[2 * j + 1].w += __uint_as_float(w.w & 0xffff0000u); }
}

__device__ __forceinline__ void p0_transpose_item(const float* W, int K, int N, bfu* WT, int k0, int n0, int dst_row0, LAS float* scr, int lane) {
#pragma unroll 8
    for (int i = 0; i < 32; ++i) { const int kk = 2 * i + (lane >> 5); scr[kk * 33 + (lane & 31)] = W[(size_t)(k0 + kk) * N + n0 + (lane & 31)]; }
    LDS_WAIT(); asm volatile("" ::: "memory");
    const int c = lane & 7;
#pragma unroll
    for (int j = 0; j < 4; ++j) { const int n = (lane >> 3) + 8 * j; const LAS float* s = scr + (8 * c) * 33 + n;
        v4u o; o.x = pk2(s[0 * 33], s[1 * 33]); o.y = pk2(s[2 * 33], s[3 * 33]); o.z = pk2(s[4 * 33], s[5 * 33]); o.w = pk2(s[6 * 33], s[7 * 33]);
        *(GAS v4u*)(WT + (size_t)(dst_row0 + n) * K + k0 + 8 * c) = o; }
    LDS_WAIT(); asm volatile("" ::: "memory");
}
__device__ __forceinline__ void p0_transpose_item_fp8(const float* W, int K, int N, unsigned char* WT, int k0, int n0, int dst_row0, float wscale, LAS float* scr, int lane) {
#pragma unroll 8
    for (int i = 0; i < 32; ++i) { const int kk = 2 * i + (lane >> 5); scr[kk * 33 + (lane & 31)] = W[(size_t)(k0 + kk) * N + n0 + (lane & 31)]; }
    LDS_WAIT(); asm volatile("" ::: "memory");
#pragma unroll
    for (int j = 0; j < 2; ++j) { const int c = lane + 64 * j, n = c >> 2, kq = (c & 3) * 16; const LAS float* sp = scr + kq * 33 + n;
        v4u o;
        { unsigned w = 0u; w = __builtin_amdgcn_cvt_pk_fp8_f32(sp[0 * 33] * wscale, sp[1 * 33] * wscale, w, false); w = __builtin_amdgcn_cvt_pk_fp8_f32(sp[2 * 33] * wscale, sp[3 * 33] * wscale, w, true); o.x = w; }
        { unsigned w = 0u; w = __builtin_amdgcn_cvt_pk_fp8_f32(sp[4 * 33] * wscale, sp[5 * 33] * wscale, w, false); w = __builtin_amdgcn_cvt_pk_fp8_f32(sp[6 * 33] * wscale, sp[7 * 33] * wscale, w, true); o.y = w; }
        { unsigned w = 0u; w = __builtin_amdgcn_cvt_pk_fp8_f32(sp[8 * 33] * wscale, sp[9 * 33] * wscale, w, false); w = __builtin_amdgcn_cvt_pk_fp8_f32(sp[10 * 33] * wscale, sp[11 * 33] * wscale, w, true); o.z = w; }
        { unsigned w = 0u; w = __builtin_amdgcn_cvt_pk_fp8_f32(sp[12 * 33] * wscale, sp[13 * 33] * wscale, w, false); w = __builtin_amdgcn_cvt_pk_fp8_f32(sp[14 * 33] * wscale, sp[15 * 33] * wscale, w, true); o.w = w; }
        *(GAS v4u*)(WT + (size_t)(dst_row0 + n) * K + k0 + kq) = o; }
    LDS_WAIT(); asm volatile("" ::: "memory");
}
constexpr int CONV_E_ITEMS = 3 * NEXP * 2048;
constexpr int CONV_QW = 14336;
__device__ __forceinline__ void conv_expert_item(Frame& F, int l, int idx, LAS float* scr) {
    const int which = idx / (NEXP * 2048); int r = idx % (NEXP * 2048);
    const int e = r / 2048; r %= 2048; const int kb = r / 64, nb = r % 64, n0 = 32 * nb;
    const size_t woff = ((size_t)l * NEXP + e) * (size_t)D * DFF;
    if (which == 0)      p0_transpose_item_fp8(F.in[17] + woff, D, DFF, F.ws + WS_WGU + l * WGU_L + e * WGU_E, 64 * kb, n0, (n0 >> 7) * 256 + (n0 & 127), WGU_SCALE, scr, F.lane);
    else if (which == 1) p0_transpose_item_fp8(F.in[18] + woff, D, DFF, F.ws + WS_WGU + l * WGU_L + e * WGU_E, 64 * kb, n0, (n0 >> 7) * 256 + 128 + (n0 & 127), WGU_SCALE, scr, F.lane);
    else                 p0_transpose_item_fp8(F.in[19] + woff, DFF, D, F.ws + WS_WD + l * WD_L + e * WD_E, 64 * kb, n0, n0, WD_SCALE, scr, F.lane);
}
__device__ __forceinline__ void conv_i8_block(Frame& F, const float* W, int ldw, int n0, bool valid, unsigned char* WT, int drow0, float* csc) {
    float* red = (float*)(F.ldsg + 8 * 16384);
    const int tid = F.tid, lane = F.lane, wave = F.wave;
    if (!valid) {
        for (int i = tid; i < 32 * D / 16; i += NTHR) *(GAS v4u*)(WT + (size_t)drow0 * D + (size_t)i * 16) = (v4u){0u, 0u, 0u, 0u};
        if (tid < 32) csc[tid] = 0.f;
        return; }
    f32x4 t[4][8];
#pragma unroll
    for (int j = 0; j < 4; ++j)
#pragma unroll
        for (int i = 0; i < 8; ++i) t[j][i] = __builtin_nontemporal_load((const f32x4*)(W + (size_t)(64 * (wave + 8 * j) + (lane >> 3) + 8 * i) * ldw + n0 + (lane & 7) * 4));
    f32x4 mx = {0.f, 0.f, 0.f, 0.f};
#pragma unroll
    for (int j = 0; j < 4; ++j)
#pragma unroll
        for (int i = 0; i < 8; ++i) { mx.x = fmaxf(mx.x, fabsf(t[j][i].x)); mx.y = fmaxf(mx.y, fabsf(t[j][i].y)); mx.z = fmaxf(mx.z, fabsf(t[j][i].z)); mx.w = fmaxf(mx.w, fabsf(t[j][i].w)); }
#pragma unroll
    for (int o = 8; o < 64; o <<= 1) { mx.x = fmaxf(mx.x, __shfl_xor(mx.x, o)); mx.y = fmaxf(mx.y, __shfl_xor(mx.y, o)); mx.z = fmaxf(mx.z, __shfl_xor(mx.z, o)); mx.w = fmaxf(mx.w, __shfl_xor(mx.w, o)); }
    WG_SYNC();
    if (lane < 8) { float* r_ = red + wave * 32 + lane * 4; r_[0] = mx.x; r_[1] = mx.y; r_[2] = mx.z; r_[3] = mx.w; }
    WG_SYNC();
    if (tid < 32) { float m = 1e-30f;
#pragma unroll
        for (int q = 0; q < 8; ++q) m = fmaxf(m, red[q * 32 + tid]);
        csc[tid] = m * (1.f / 127.f); red[256 + tid] = 127.f / m; }
    WG_SYNC();
    LAS float* scr = (LAS float*)(F.lds + wave * 16384);
#pragma unroll
    for (int j = 0; j < 4; ++j) { const int k0 = 64 * (wave + 8 * j);
#pragma unroll
        for (int i = 0; i < 8; ++i) { LAS float* d_ = scr + ((lane >> 3) + 8 * i) * 33 + (lane & 7) * 4; d_[0] = t[j][i].x; d_[1] = t[j][i].y; d_[2] = t[j][i].z; d_[3] = t[j][i].w; }
        LDS_WAIT(); asm volatile("" ::: "memory");
#pragma unroll
        for (int jj = 0; jj < 2; ++jj) { const int c = lane + 64 * jj, n = c >> 2, kqq = (c & 3) * 16; const LAS float* sp = scr + kqq * 33 + n; const float inv = red[256 + n];
            v4u o; unsigned* ou = (unsigned*)&o;
#pragma unroll
            for (int g = 0; g < 4; ++g) { const int a = __float2int_rn(sp[(4 * g) * 33] * inv), b = __float2int_rn(sp[(4 * g + 1) * 33] * inv), cc = __float2int_rn(sp[(4 * g + 2) * 33] * inv), d = __float2int_rn(sp[(4 * g + 3) * 33] * inv);
                ou[g] = (unsigned)(a & 255) | ((unsigned)(b & 255) << 8) | ((unsigned)(cc & 255) << 16) | ((unsigned)(d & 255) << 24); }
            *(GAS v4u*)(WT + (size_t)(drow0 + n) * D + k0 + kqq) = o; }
        LDS_WAIT(); asm volatile("" ::: "memory");
    }
}
struct ConvSrc { const float* W; unsigned char* WT; int K, N, k0, n0, drow; float sc; };
__device__ __forceinline__ ConvSrc conv_decode(Frame& F, int l, int idx) {
    const int which = idx / (NEXP * 2048); int r = idx % (NEXP * 2048);
    const int e = r / 2048; r %= 2048; const int kb = r / 64, nb = r % 64, n0 = 32 * nb;
    const size_t woff = ((size_t)l * NEXP + e) * (size_t)D * DFF;
    ConvSrc c; c.K = which == 2 ? DFF : D; c.N = which == 2 ? D : DFF; c.k0 = 64 * kb; c.n0 = n0;
    const float* wg_ = F.in[17]; const float* wu_ = F.in[18]; const float* wd_ = F.in[19];
    asm volatile("" : "+s"(wg_), "+s"(wu_), "+s"(wd_));
    c.W = (which == 0 ? wg_ : which == 1 ? wu_ : wd_) + woff;
    c.WT = which == 2 ? F.ws + WS_WD + l * WD_L + e * WD_E : F.ws + WS_WGU + l * WGU_L + e * WGU_E;
    c.drow = which == 2 ? n0 : (n0 >> 7) * 256 + (which == 1 ? 128 : 0) + (n0 & 127); c.sc = which == 2 ? WD_SCALE : WGU_SCALE;
    return c;
}
__device__ __forceinline__ void conv_load(const ConvSrc& c, f32x4 (&t)[8], int lane) {
#pragma unroll
    for (int i = 0; i < 8; ++i) t[i] = __builtin_nontemporal_load((const f32x4*)(c.W + (size_t)(c.k0 + (lane >> 3) + 8 * i) * c.N + c.n0 + (lane & 7) * 4));
}
__device__ __forceinline__ void conv_finish(const ConvSrc& c, const f32x4 (&t)[8], LAS float* scr, int lane) {
#pragma unroll
    for (int i = 0; i < 8; ++i) { LAS float* d_ = scr + ((lane >> 3) + 8 * i) * 33 + (lane & 7) * 4; d_[0] = t[i].x; d_[1] = t[i].y; d_[2] = t[i].z; d_[3] = t[i].w; }
    LDS_WAIT(); asm volatile("" ::: "memory");
#pragma unroll
    for (int j = 0; j < 2; ++j) { const int cc = lane + 64 * j, n = cc >> 2, kq = (cc & 3) * 16; const LAS float* sp = scr + kq * 33 + n; const float ws_ = c.sc;
        v4u o;
        { unsigned w = 0u; w = __builtin_amdgcn_cvt_pk_fp8_f32(sp[0 * 33] * ws_, sp[1 * 33] * ws_, w, false); w = __builtin_amdgcn_cvt_pk_fp8_f32(sp[2 * 33] * ws_, sp[3 * 33] * ws_, w, true); o.x = w; }
        { unsigned w = 0u; w = __builtin_amdgcn_cvt_pk_fp8_f32(sp[4 * 33] * ws_, sp[5 * 33] * ws_, w, false); w = __builtin_amdgcn_cvt_pk_fp8_f32(sp[6 * 33] * ws_, sp[7 * 33] * ws_, w, true); o.y = w; }
        { unsigned w = 0u; w = __builtin_amdgcn_cvt_pk_fp8_f32(sp[8 * 33] * ws_, sp[9 * 33] * ws_, w, false); w = __builtin_amdgcn_cvt_pk_fp8_f32(sp[10 * 33] * ws_, sp[11 * 33] * ws_, w, true); o.z = w; }
        { unsigned w = 0u; w = __builtin_amdgcn_cvt_pk_fp8_f32(sp[12 * 33] * ws_, sp[13 * 33] * ws_, w, false); w = __builtin_amdgcn_cvt_pk_fp8_f32(sp[14 * 33] * ws_, sp[15 * 33] * ws_, w, true); o.w = w; }
        *(GAS v4u*)(c.WT + (size_t)(c.drow + n) * c.K + c.k0 + kq) = o; }
    LDS_WAIT(); asm volatile("" ::: "memory");
}
__device__ __forceinline__ void conv_gu_block(Frame& F, int b) {
    const int l = b >> 11, e = (b >> 7) & 15, which = (b >> 6) & 1, nbk = b & 63, n0 = 32 * nbk;
    const size_t woff = ((size_t)l * NEXP + e) * (size_t)D * DFF;
    const float* wg_ = F.in[17]; const float* wu_ = F.in[18];
    asm volatile("" : "+s"(wg_), "+s"(wu_));
    const int drow0 = (n0 >> 7) * 256 + (which ? 128 : 0) + (n0 & 127);
    conv_i8_block(F, (which ? wu_ : wg_) + woff, DFF, n0, true, F.ws + WS_WGU + l * WGU_L + e * WGU_E, drow0, (float*)(F.ws + WS_CSCGU) + ((size_t)l * NEXP + e) * 4096 + drow0);
}
constexpr int CONV_GU_BLOCKS = DEPTH * NEXP * 128;
constexpr int WIN_BLOCKS = 896;
constexpr int DOWN_ITEMS = NEXP * 2048;
constexpr int NCONV = 96;
constexpr int CONV_TOTAL = 2 * DOWN_ITEMS;
__device__ __forceinline__ void conv_window(Frame& F, int w, int rank, int nrank) {
    LAS float* scr = (LAS float*)(F.lds + F.wave * 16384);
    (void)scr;
    for (int bk = w * WIN_BLOCKS + rank; bk < (w + 1) * WIN_BLOCKS; bk += nrank) conv_gu_block(F, CONV_GU_BLOCKS / 2 + bk);
}
__device__ __forceinline__ void conv_worker(Frame& F, int rank, int nrank) {
    constexpr int NB_W = CONV_GU_BLOCKS / 2 + (CONV_GU_BLOCKS / 2 - 2 * WIN_BLOCKS);
    for (int i = rank; i < NB_W; i += nrank) conv_gu_block(F, i < CONV_GU_BLOCKS / 2 ? i : i + 2 * WIN_BLOCKS);
    LAS float* scr = (LAS float*)(F.lds + F.wave * 16384);
    const int stride = nrank * NWAVES; int it = rank * NWAVES + F.wave;
    if (it >= CONV_TOTAL) return;
#define CONV_DEC(ix) conv_decode(F, (ix) < DOWN_ITEMS ? 0 : 1, 2 * NEXP * 2048 + ((ix) < DOWN_ITEMS ? (ix) : (ix) - DOWN_ITEMS))
    ConvSrc c = CONV_DEC(it);
    f32x4 t[8]; conv_load(c, t, F.lane);
    for (;;) {
        const int nx = it + stride; const bool more = nx < CONV_TOTAL; const int ny = more ? nx : it;
        const ConvSrc cn = CONV_DEC(ny);
        f32x4 tn[8]; conv_load(cn, tn, F.lane);
        conv_finish(c, t, scr, F.lane);
        if (!more) break;
        c = cn; it = nx;
#pragma unroll
        for (int i = 0; i < 8; ++i) t[i] = tn[i];
    }
#undef CONV_DEC
}
__device__ __forceinline__ void p0_prologue(Frame& F) {
    { constexpr int NB_IN = DIN_PAD / 32, NB_OUT = D / 32, NB_L = NB_IN + NB_OUT;
      for (int it = F.vcu; it < DEPTH * NB_L; it += F.G) { const int l = it / NB_L, r = it % NB_L;
          const bool isin = r < NB_IN; const int nb = isin ? r : r - NB_IN, n0 = 32 * nb;
          const float* win_ = F.in[5]; const float* wout_ = F.in[13]; asm volatile("" : "+s"(win_), "+s"(wout_));
          conv_i8_block(F, isin ? win_ + (size_t)l * D * DIN : wout_ + (size_t)l * D * D, isin ? DIN : D, n0, isin ? n0 < DIN : true,
                        isin ? F.ws + WS_WINI8 + l * WINI8_L : F.ws + WS_WOUTI8 + l * WOUTI8_L, 32 * nb, isin ? (float*)(F.ws + WS_CSC) + l * DIN_PAD + 32 * nb : (float*)(F.ws + WS_CSC2) + l * D + 32 * nb); } }
    LAS float* scr = (LAS float*)(F.lds + F.wave * 16384);
    const int gw = F.vcu * NWAVES + F.wave, NGW = F.G * NWAVES;
    constexpr int I_IN = 32 * (DIN / 32), I_OUT = 32 * 64;
    constexpr int E1_FIRST = 2 * CONV_QW;
    const bool conv_later = F.G > 2 * NCONV;
    if (!conv_later) { for (int bk = F.vcu; bk < CONV_GU_BLOCKS; bk += F.G) conv_gu_block(F, bk); }
    const int PER_L0 = I_IN + I_OUT + (conv_later ? 0 : DOWN_ITEMS), PER_L1 = I_IN + I_OUT + (conv_later ? 0 : DOWN_ITEMS), NITEMS = PER_L0 + PER_L1;
    for (int it = gw; it < NITEMS; it += NGW) {
        const int l = it < PER_L0 ? 0 : 1; int r = it - l * PER_L0;
        if (r < I_IN) continue;
        r -= I_IN;
        if (r < I_OUT) continue;
        r -= I_OUT;
        conv_expert_item(F, l, 2 * NEXP * 2048 + r, scr);
    }
    { const int gt = F.vcu * NTHR + F.tid, NGT = F.G * NTHR; constexpr int PADV = (DIN_PAD - DIN) * D * 2 / 16;
      for (int i = gt; i < DEPTH * PADV; i += NGT) { const int l = i / PADV, j = i % PADV; *(GAS v4u*)(F.ws + WS_WIN + l * WIN_L + (size_t)DIN * D * 2 + (size_t)j * 16) = (v4u){0u, 0u, 0u, 0u}; } }
    f32x4 pv[8];
#pragma unroll
    for (int j = 0; j < 8; ++j) pv[j] = (f32x4){0.f, 0.f, 0.f, 0.f};
    if (gw < M) row_load_f32(gw < TP ? F.in[0] + (size_t)gw * D : F.in[1] + (size_t)(gw - TP) * D, pv, F.lane);
    for (int m = gw; m < M; m += NGW) {
        f32x4 v[8];
#pragma unroll
        for (int j = 0; j < 8; ++j) v[j] = pv[j];
        if (m + NGW < M) { const int mn = m + NGW; row_load_f32(mn < TP ? F.in[0] + (size_t)mn * D : F.in[1] + (size_t)(mn - TP) * D, pv, F.lane); }
        ln_norm(v, F.in[2], F.in[3], F.lane);
        row_store_bf16((bfu*)(F.ws + WS_XN) + (size_t)m * D, v, F.lane);
        row_store_i8(F.ws + WS_XNI8 + (size_t)m * D, (float*)(F.ws + WS_RSC) + m, v, F.lane);
    }
}

__device__ __forceinline__ void qk_prep(Frame& F, int l) {
    const int gw = F.vcu * NWAVES + F.wave, NGW = F.G * NWAVES, lane = F.lane;
    const int hh = lane >> 3, sub = lane & 7, half = sub >> 2, a1 = 64 * half + 8 * (sub & 3);
    const float* gn = (hh < 6 ? F.in[6] : F.in[7]) + l * 128;
    float g1[8], g2[8], inv[8];
#pragma unroll
    for (int c = 0; c < 8; ++c) { g1[c] = gn[a1 + c]; g2[c] = gn[a1 + 32 + c]; inv[c] = exp2f(-(float)(2 * (8 * (sub & 3) + c)) * (13.287712379549449f / 64.f)) * 0.15915494309189535f; }
    bfu* P = (bfu*)(F.ws + WS_PROJ);
    const int coff = (hh < 6 ? C_AQ + hh * 128 : C_AK + (hh - 6) * 128) + a1;
    v4u w1 = {0u, 0u, 0u, 0u}, w2 = {0u, 0u, 0u, 0u};
    if (gw < M) { const bfu* p = P + (size_t)gw * PP + coff; w1 = *(const v4u*)p; w2 = *(const v4u*)(p + 32); }
    for (int m = gw; m < M; m += NGW) {
        const v4u c1 = w1, c2 = w2;
        if (m + NGW < M) { const bfu* p = P + (size_t)(m + NGW) * PP + coff; w1 = *(const v4u*)p; w2 = *(const v4u*)(p + 32); }
        const int t = m < TP ? m : (m - TP) % TS;
        const float pos = (float)(half == 0 ? (t >> 6) : (t & 63));
        float x1[8], x2[8]; float ss = 0.f;
        const unsigned* u1 = (const unsigned*)&c1; const unsigned* u2 = (const unsigned*)&c2;
#pragma unroll
        for (int k = 0; k < 4; ++k) { x1[2 * k] = __uint_as_float(u1[k] << 16); x1[2 * k + 1] = __uint_as_float(u1[k] & 0xffff0000u); x2[2 * k] = __uint_as_float(u2[k] << 16); x2[2 * k + 1] = __uint_as_float(u2[k] & 0xffff0000u); }
#pragma unroll
        for (int c = 0; c < 8; ++c) ss += x1[c] * x1[c] + x2[c] * x2[c];
        ss += __shfl_xor(ss, 1); ss += __shfl_xor(ss, 2); ss += __shfl_xor(ss, 4);
        const float rstd = 1.f / sqrtf(ss * (1.f / 128.f) + RMS_EPS);
        float o1[8], o2[8];
#pragma unroll
        for (int c = 0; c < 8; ++c) { const float rev = pos * inv[c]; const float cs = __builtin_amdgcn_cosf(rev), sn = __builtin_amdgcn_sinf(rev);
            const float n1 = x1[c] * rstd * g1[c], n2 = x2[c] * rstd * g2[c]; o1[c] = n1 * cs - n2 * sn; o2[c] = n1 * sn + n2 * cs; }
        v4u r1, r2; r1.x = pk2(o1[0], o1[1]); r1.y = pk2(o1[2], o1[3]); r1.z = pk2(o1[4], o1[5]); r1.w = pk2(o1[6], o1[7]); r2.x = pk2(o2[0], o2[1]); r2.y = pk2(o2[2], o2[3]); r2.z = pk2(o2[4], o2[5]); r2.w = pk2(o2[6], o2[7]);
        bfu* q = P + (size_t)m * PP + coff; *(v4u*)q = r1; *(v4u*)(q + 32) = r2;
        if (hh >= 6) { unsigned char* k8 = F.ws + WS_K8 + (size_t)m * 256 + (hh - 6) * 128 + a1;
            pg8::u32x2 e1, e2; e1.x = pg8::cvt4_fp8(o1[0], o1[1], o1[2], o1[3]); e1.y = pg8::cvt4_fp8(o1[4], o1[5], o1[6], o1[7]); e2.x = pg8::cvt4_fp8(o2[0], o2[1], o2[2], o2[3]); e2.y = pg8::cvt4_fp8(o2[4], o2[5], o2[6], o2[7]);
            *(pg8::u32x2*)k8 = e1; *(pg8::u32x2*)(k8 + 32) = e2; }
    }
}

__device__ __forceinline__ void vt8_pass(Frame& F) {
    const bfu* P = (const bfu*)(F.ws + WS_PROJ); unsigned char* T = (unsigned char*)F.ldsg;
    const int tid = F.tid, s_ = tid >> 3, d0 = (tid & 7) * 16;
    const int pos = 32 * ((s_ >> 2) & 1) + (s_ & 3) + 4 * ((s_ & 31) >> 3) + (s_ >= 32 ? 16 : 0);
    for (int u = F.vcu; u < 2 * NCHUNK; u += F.G) { const int kvh = u / NCHUNK, tt = u % NCHUNK;
        const bfu* src = P + (size_t)(64 * tt + s_) * PP + C_AV + kvh * 128 + d0;
        const attn::bf16x8 va = *(const attn::bf16x8*)src, vb = *(const attn::bf16x8*)(src + 8);
        WG_SYNC();
#pragma unroll
        for (int i = 0; i < 8; ++i) { const float x = bf2f((bfu)va[i]), y = bf2f((bfu)vb[i]);
            T[(d0 + i) * 64 + pos] = (unsigned char)(__builtin_amdgcn_cvt_pk_fp8_f32(x, x, 0, false) & 0xff); T[(d0 + 8 + i) * 64 + pos] = (unsigned char)(__builtin_amdgcn_cvt_pk_fp8_f32(y, y, 0, false) & 0xff); }
        WG_SYNC();
        *(v4u*)(F.ws + WS_VT8 + ((size_t)(kvh * NCHUNK + tt) * 128) * 64 + (size_t)tid * 16) = *(const v4u*)(T + tid * 16);
    }
    WG_SYNC();
}
__device__ __forceinline__ void attn_a_unit(Frame& F, int id) {
    int row0, kv0, nkeys, h;
    if (id < 192) { h = id >> 5; const int qb = id & 31; row0 = qb * 256; kv0 = 0; nkeys = TP; }
    else { const int j = id - 192, s = j / 48, rem = j % 48; h = rem >> 3; const int qb = rem & 7; kv0 = TP + s * TS; row0 = kv0 + qb * 256; nkeys = TS; }
    const attn::bf16* P = (const attn::bf16*)(F.ws + WS_PROJ);
    const int kvh = h / 3;
    attn::attn_dense_body88q(P + (size_t)row0 * PP + C_AQ + h * 128, F.ws + WS_K8 + (size_t)kv0 * 256 + kvh * 128, F.ws + WS_VT8 + ((size_t)kvh * NCHUNK + kv0 / 64) * 8192,
                            (attn::bf16*)(F.ws + WS_MIX) + (size_t)row0 * D + h * 128, nkeys, F.ldsg);
}
__device__ __forceinline__ void attn_a_phase(Frame& F) {
    const int c = F.vcu;
    const int cnt = (F.G == 256) ? (c < 192 ? 3 : 6) : (960 - c + F.G - 1) / F.G;
    for (int i = 0; i < cnt; ++i) {
        int id;
        if (F.G == 256) id = c < 192 ? (i == 0 ? c : 192 + 2 * c + (i - 1)) : 192 + 384 + (c - 192) * 6 + i;
        else id = c + i * F.G;
        attn_a_unit(F, id);
    }
}

namespace mixb {
using attn::bf16x8; using attn::f32x16; using attn::u32x4;
constexpr float NEG = -1e30f;
__device__ __forceinline__ int t5_bucket(int rp) {
    const int n = rp < 0 ? -rp : rp;
    int large = 8 + (int)(logf((float)(n > 1 ? n : 1) / 8.f) / 4.852030263919617f * 8.f);
    large = large < 15 ? large : 15;
    return (rp > 0 ? 16 : 0) + (n < 8 ? n : large);
}
__device__ __forceinline__ void stage_tile(Frame& F, char* slot, bool isV, int bn, int nb, int tok0, int dil, int colbase, int tp) {
    const bfu* P = (const bfu*)(F.ws + WS_PROJ);
    const bool valid = bn >= 0 && bn < nb; const int sr = tp >> 4, sc = (tp & 15) * 8;
    bf16x8 v[8];
#pragma unroll
    for (int i = 0; i < 8; ++i) { const int kk = sr + 8 * i; v[i] = (bf16x8){0, 0, 0, 0, 0, 0, 0, 0};
        if (valid) v[i] = *(const bf16x8*)(P + (size_t)(tok0 + (64 * bn + kk) * dil) * PP + colbase + sc); }
#pragma unroll
    for (int i = 0; i < 8; ++i) { const int kk = sr + 8 * i;
        if (isV) *(bf16x8*)(slot + attn::v_st(kk, sc)) = v[i]; else *(bf16x8*)(slot + KSWZ(kk, sc * 2)) = v[i]; }
}
__device__ __forceinline__ void stage_load(Frame& F, bf16x8 (&v)[8], int bn, int nb, int tok0, int dil, int colbase, int tp) {
    const bfu* P = (const bfu*)(F.ws + WS_PROJ);
    const bool valid = bn >= 0 && bn < nb; const int sr = tp >> 4, sc = (tp & 15) * 8;
#pragma unroll
    for (int i = 0; i < 8; ++i) { const int kk = sr + 8 * i; v[i] = (bf16x8){0, 0, 0, 0, 0, 0, 0, 0};
        if (valid) v[i] = *(const bf16x8*)(P + (size_t)(tok0 + (64 * bn + kk) * dil) * PP + colbase + sc); }
}
__device__ __forceinline__ void stage_write(char* slot, bool isV, const bf16x8 (&v)[8], int tp) {
    const int sr = tp >> 4, sc = (tp & 15) * 8;
#pragma unroll
    for (int i = 0; i < 8; ++i) { const int kk = sr + 8 * i;
        if (isV) *(bf16x8*)(slot + attn::v_st(kk, sc)) = v[i]; else *(bf16x8*)(slot + KSWZ(kk, sc * 2)) = v[i]; }
}
#define MB_PK4(P, BASE, OUT) do { unsigned a0 = attn::cvtpk(P[BASE + 0], P[BASE + 1]), a1 = attn::cvtpk(P[BASE + 2], P[BASE + 3]);   \
    unsigned b0 = attn::cvtpk(P[BASE + 4], P[BASE + 5]), b1 = attn::cvtpk(P[BASE + 6], P[BASE + 7]);                              \
    auto r0 = __builtin_amdgcn_permlane32_swap(a0, b0, false, false); auto r1 = __builtin_amdgcn_permlane32_swap(a1, b1, false, false); \
    u32x4 w = {r0[0], r1[0], r0[1], r1[1]}; OUT = *reinterpret_cast<bf16x8*>(&w); } while (0)
__device__ __forceinline__ float score_fix(f32x16& p0, f32x16& p1, int kt, bool bvalid, int iq, int hi, const float* bt, float mx) {
#pragma unroll
    for (int r = 0; r < 16; ++r) {
        const int kk = attn::crow(r, hi);
        { const int rel = 64 * (kt - 1) + kk - iq; const bool ok = bvalid && rel >= -64 && rel <= 64; const int bi = ok ? rel + 64 : 64;
          const float s = ok ? p0[r] * attn::SCALE + bt[bi] : NEG; p0[r] = s; mx = fmaxf(mx, s); }
        { const int rel = 64 * (kt - 1) + kk + 32 - iq; const bool ok = bvalid && rel >= -64 && rel <= 64; const int bi = ok ? rel + 64 : 64;
          const float s = ok ? p1[r] * attn::SCALE + bt[bi] : NEG; p1[r] = s; mx = fmaxf(mx, s); }
    }
    return mx;
}
__device__ __forceinline__ float score_exp(f32x16& p0, f32x16& p1, float m) {
    float sum = 0.f;
#pragma unroll
    for (int r = 0; r < 16; ++r) { p0[r] = __builtin_amdgcn_exp2f((p0[r] - m) * 1.4426950408889634f); p1[r] = __builtin_amdgcn_exp2f((p1[r] - m) * 1.4426950408889634f); sum += p0[r] + p1[r]; }
    return sum;
}
#define MB_LBAR() do { asm volatile("s_waitcnt lgkmcnt(0)" ::: "memory"); __builtin_amdgcn_s_barrier(); asm volatile("" ::: "memory"); } while (0)
__device__ __forceinline__ void mixer_b_phase(Frame& F) {
    const int tid = F.tid, lane = F.lane, wave = F.wave, r32 = lane & 31, hi = lane >> 5;
    const int p = wave >> 1, wq = wave & 1, tp = tid & 127;
    char* slotA = F.ldsg + p * 32768; char* slotB = slotA + 16384;
    float* bt = (float*)(F.ldsg + 131072 + p * 528);
    float* li_l = (float*)(F.ldsg + 131072 + 2112 + wave * 128);
    const float* rel_bias = F.in[4];
    bfu* MIXp = (bfu*)(F.ws + WS_MIX); float* LSE = (float*)(F.ws + WS_LSE);
    const bfu* P = (const bfu*)(F.ws + WS_PROJ);
    for (int ui = F.vcu; ui < 960; ui += F.G) {
        const int qid = ui * 4 + p, head6 = qid / 640, blk = qid % 640;
        const int s = blk < 128 ? 0 : 1 + (blk - 128) / 32, lb = blk < 128 ? blk : (blk - 128) % 32;
        const int g = head6 >> 1, dil = 1 << (2 * g), T = seq_len(s), L = T / dil, nb = L / 64, r = lb / nb, n = lb % nb;
        const int tok0 = seq_start(s) + r;
        const int kcol = C_BK + head6 * 128, vcol = C_BV + head6 * 128;
        bf16x8 va[8], vb[8];
        stage_load(F, va, n - 1, nb, tok0, dil, kcol, tp); stage_load(F, vb, n, nb, tok0, dil, kcol, tp);
        MB_LBAR();
        for (int bi = tp; bi < 129; bi += 128) bt[bi] = rel_bias[t5_bucket((bi - 64) * dil) * 6 + head6];
        const int iq = 32 * wq + r32;
        bf16x8 qr[8];
        { const bfu* Qw = P + (size_t)(tok0 + (64 * n + iq) * dil) * PP + C_BQ + head6 * 128 + hi * 8;
#pragma unroll
          for (int d0 = 0; d0 < 8; ++d0) qr[d0] = *(const bf16x8*)(Qw + d0 * 16); }
        f32x16 s00, s01, s10, s11, s20, s21;
        stage_write(slotA, false, va, tp); stage_write(slotB, false, vb, tp);
        stage_load(F, va, n + 1, nb, tok0, dil, kcol, tp); stage_load(F, vb, n - 1, nb, tok0, dil, vcol, tp);
        MB_LBAR();
        attn::qkt(s00, s01, (const attn::bf16*)slotA, qr, r32, hi); attn::qkt(s10, s11, (const attn::bf16*)slotB, qr, r32, hi);
        MB_LBAR();
        stage_write(slotA, false, va, tp); stage_write(slotB, true, vb, tp);
        stage_load(F, va, n, nb, tok0, dil, vcol, tp);
        MB_LBAR();
        attn::qkt(s20, s21, (const attn::bf16*)slotA, qr, r32, hi);
        float mx = NEG;
        mx = score_fix(s00, s01, 0, n - 1 >= 0, iq, hi, bt, mx); mx = score_fix(s10, s11, 1, true, iq, hi, bt, mx); mx = score_fix(s20, s21, 2, n + 1 < nb, iq, hi, bt, mx);
        { auto rr = __builtin_amdgcn_permlane32_swap(__float_as_uint(mx), __float_as_uint(mx), false, false); mx = fmaxf(__uint_as_float(rr[0]), __uint_as_float(rr[1])); }
        float den = score_exp(s00, s01, mx) + score_exp(s10, s11, mx) + score_exp(s20, s21, mx);
        { auto rr = __builtin_amdgcn_permlane32_swap(__float_as_uint(den), __float_as_uint(den), false, false); den = __uint_as_float(rr[0]) + __uint_as_float(rr[1]); }
        f32x16 o[4] = {};
        bf16x8 pa[3][4];
        MB_PK4(s00, 0, pa[0][0]); MB_PK4(s00, 8, pa[0][1]); MB_PK4(s01, 0, pa[0][2]); MB_PK4(s01, 8, pa[0][3]);
        MB_PK4(s10, 0, pa[1][0]); MB_PK4(s10, 8, pa[1][1]); MB_PK4(s11, 0, pa[1][2]); MB_PK4(s11, 8, pa[1][3]);
        MB_PK4(s20, 0, pa[2][0]); MB_PK4(s20, 8, pa[2][1]); MB_PK4(s21, 0, pa[2][2]); MB_PK4(s21, 8, pa[2][3]);
        stage_load(F, vb, n + 1, nb, tok0, dil, vcol, tp);
        const int vbA = (int)(uintptr_t)slotA + attn::v_rd_base(lane), vbB = (int)(uintptr_t)slotB + attn::v_rd_base(lane);
        attn::pv_d0(o, vbB, pa[0][0], pa[0][1], pa[0][2], pa[0][3]);
        MB_LBAR();
        stage_write(slotA, true, va, tp); stage_write(slotB, true, vb, tp);
        MB_LBAR();
        attn::pv_d0(o, vbA, pa[1][0], pa[1][1], pa[1][2], pa[1][3]);
        attn::pv_d0(o, vbB, pa[2][0], pa[2][1], pa[2][2], pa[2][3]);
        if (hi == 0) { li_l[r32] = den; LSE[(size_t)(tok0 + (64 * n + iq) * dil) * 6 + head6] = mx + logf(den); }
        asm volatile("s_waitcnt lgkmcnt(0)" ::: "memory");
#pragma unroll
        for (int rr = 0; rr < 16; ++rr) { const int q = attn::crow(rr, hi); const float rl = __builtin_amdgcn_rcpf(li_l[q]);
            bfu* orow = MIXp + (size_t)(tok0 + (64 * n + 32 * wq + q) * dil) * D + MIX_B + head6 * 128 + r32;
#pragma unroll
            for (int d0 = 0; d0 < 4; ++d0) orow[d0 * 32] = (bfu)f2bf(o[d0][rr] * rl); }
    }
    WG_SYNC();
}
__device__ __forceinline__ void mix_row_pass(Frame& F) {
    const int gw = F.vcu * NWAVES + F.wave, NGW = F.G * NWAVES, lane = F.lane;
    const bfu* MIXp = (const bfu*)(F.ws + WS_MIX); const float* LSE = (const float*)(F.ws + WS_LSE);
    for (int m = gw; m < M; m += NGW) {
        const float* l6 = LSE + (size_t)m * 6;
        float w[6];
#pragma unroll
        for (int j = 0; j < 2; ++j) { const float a = l6[j], b = l6[2 + j], c = l6[4 + j], mx = fmaxf(a, fmaxf(b, c));
            const float ea = expf(a - mx), eb = expf(b - mx), ec = expf(c - mx), inv = 1.f / (ea + eb + ec); w[j] = ea * inv; w[2 + j] = eb * inv; w[4 + j] = ec * inv; }
        f32x4 v[8];
        row_load_bf16(MIXp + (size_t)m * D, v, lane, 1.f);
#pragma unroll
        for (int j = 0; j < 4; ++j) { const int col = 8 * lane + 512 * j;
            if (col >= MIX_B && col < MIX_C) { const int h6 = (col - MIX_B) >> 7; float wt = w[0];
#pragma unroll
                for (int k = 1; k < 6; ++k) wt = (h6 == k) ? w[k] : wt;
                v[2 * j] = v[2 * j] * wt; v[2 * j + 1] = v[2 * j + 1] * wt; } }
        row_store_i8(F.ws + WS_MIXI8 + (size_t)m * D, (float*)(F.ws + WS_RSC2) + m, v, lane);
    }
}
}

namespace gla {
using attn::bf16x8; using attn::f32x16;
constexpr int L_CUM = 0, L_GT = 16384, L_TOT = 18432, L_Z = 18688, L_QT = 22784, L_KT = 32000, L_ATT = 41216, L_VT = 50432, L_ST = 68864, L_O = 87296, LD = 72, LDO_ = 132;
static_assert(L_O + 64 * LDO_ * 4 <= SCR_BYTES, "gla lds");
__device__ __forceinline__ float logsig(float x) { return fminf(x, 0.f) - log1pf(expf(-fabsf(x))); }
__device__ __forceinline__ f32x16 lds_mma(const bfu* A, const bfu* Bt, int K, f32x16 acc, int lane) {
    const int r = lane & 31, hi = lane >> 5;
    for (int k0 = 0; k0 < K; k0 += 16) {
        const bf16x8 a = *(const bf16x8*)(A + r * LD + k0 + hi * 8), b = *(const bf16x8*)(Bt + r * LD + k0 + hi * 8);
        acc = __builtin_amdgcn_mfma_f32_32x32x16_bf16(a, b, acc, 0, 0, 0);
    }
    return acc;
}
__device__ __forceinline__ void compute_cum(Frame& F, int l, int row0, int h, int dir) {
    float* CUM = (float*)(F.ldsg + L_CUM); float* GT = (float*)(F.ldsg + L_GT); float* TOT = (float*)(F.ldsg + L_TOT); float* Z = (float*)(F.ldsg + L_Z);
    const bfu* P = (const bfu*)(F.ws + WS_PROJ);
    const int tid = F.tid;
    { const int t = tid >> 3, r2 = (tid & 7) * 2; const unsigned zz = *(const unsigned*)(P + (size_t)(row0 + t) * PP + (dir ? C_ZB : C_ZF) + r2);
      Z[t * 16 + r2] = __uint_as_float(zz << 16); Z[t * 16 + r2 + 1] = __uint_as_float(zz & 0xffff0000u); }
    const int k = tid & 63, tg = tid >> 6, col = h * 64 + k;
    const float* wv = (dir ? F.in[10] : F.in[8]) + (size_t)l * 16 * 256; const float bias = ((dir ? F.in[11] : F.in[9]) + l * 256)[col];
    float w[16];
#pragma unroll
    for (int r = 0; r < 16; ++r) w[r] = wv[r * 256 + col];
    WG_SYNC();
    float la[8];
#pragma unroll
    for (int i = 0; i < 8; ++i) { const float* z = Z + (8 * tg + i) * 16; float pre = bias;
#pragma unroll
        for (int r = 0; r < 16; ++r) pre += z[r] * w[r];
        la[i] = logsig(pre) * (1.f / 16.f); }
    float run = 0.f;
    if (dir == 0) {
#pragma unroll
        for (int i = 0; i < 8; ++i) { run += la[i]; la[i] = run; }
    } else {
#pragma unroll
        for (int i = 7; i >= 0; --i) { run += la[i]; la[i] = run; }
    }
    GT[tg * 64 + k] = run;
    WG_SYNC();
    float off = 0.f, tot = 0.f;
#pragma unroll
    for (int g = 0; g < 8; ++g) { const float x = GT[g * 64 + k]; tot += x; if (dir == 0 ? (g < tg) : (g > tg)) off += x; }
#pragma unroll
    for (int i = 0; i < 8; ++i) CUM[(8 * tg + i) * 64 + k] = la[i] + off;
    if (tg == 0) TOT[k] = tot;
    WG_SYNC();
}
__device__ __forceinline__ void stage_vt(Frame& F, int row0, int h) {
    const bfu* P = (const bfu*)(F.ws + WS_PROJ); bfu* VT = (bfu*)(F.ldsg + L_VT);
    const int s = F.tid >> 3, vg = (F.tid & 7) * 16;
    const bfu* src = P + (size_t)(row0 + s) * PP + C_CV + h * 128 + vg;
    const bf16x8 a = *(const bf16x8*)src, b = *(const bf16x8*)(src + 8);
#pragma unroll
    for (int j = 0; j < 8; ++j) { VT[(vg + j) * LD + s] = (bfu)a[j]; VT[(vg + 8 + j) * LD + s] = (bfu)b[j]; }
}
constexpr int N_CUM0 = 0, N_CUM1 = 16384, N_GT0 = 32768, N_GT1 = 34816, N_TOT0 = 36864, N_TOT1 = 37120, N_Z0 = 37376, N_Z1 = 41472, N_KH0 = 45568, N_KH1 = 54784, N_VT = 64000;
static_assert(N_VT + 18432 <= SCR_BYTES, "gla c1 lds");
__device__ __forceinline__ float fexp(float x) { return __builtin_amdgcn_exp2f(x * 1.4426950408889634f); }
__device__ __forceinline__ float logsig_fast(float x) { return fminf(x, 0.f) - 0.6931471805599453f * __builtin_amdgcn_logf(1.f + fexp(-fabsf(x))); }
__device__ __forceinline__ void c1_phase(Frame& F, int l) {
    const bfu* P = (const bfu*)(F.ws + WS_PROJ);
    bfu* DUT = (bfu*)(F.ws + WS_HID); float* ADEC = (float*)(F.ws + WS_ADEC);
    bfu* QKT = (bfu*)(F.ws + WS_QKT);
    float* CUM0 = (float*)(F.ldsg + N_CUM0); float* CUM1 = (float*)(F.ldsg + N_CUM1); float* GT0 = (float*)(F.ldsg + N_GT0); float* GT1 = (float*)(F.ldsg + N_GT1);
    float* TOT0 = (float*)(F.ldsg + N_TOT0); float* TOT1 = (float*)(F.ldsg + N_TOT1); float* Z0 = (float*)(F.ldsg + N_Z0); float* Z1 = (float*)(F.ldsg + N_Z1);
    bfu* KH0 = (bfu*)(F.ldsg + N_KH0); bfu* KH1 = (bfu*)(F.ldsg + N_KH1); bfu* VT = (bfu*)(F.ldsg + N_VT);
    const int tid = F.tid, lane = F.lane, wave = F.wave;
    const int k_ = tid & 63, tg = tid >> 6, s_ = tid >> 3, kg = (tid & 7) * 8, vg = (tid & 7) * 16, r2 = (tid & 7) * 2;
    for (int u = F.vcu; u < NCHUNK * 4; u += F.G) {
        const int gc = u >> 2, h = u & 3, row0 = gc * 64, col = h * 64 + k_;
        const bfu* rowp = P + (size_t)(row0 + s_) * PP;
        const unsigned zf = *(const unsigned*)(rowp + C_ZF + r2), zb = *(const unsigned*)(rowp + C_ZB + r2);
        const bf16x8 kk = *(const bf16x8*)(rowp + C_CK + h * 64 + kg), qq = *(const bf16x8*)(rowp + C_CQ + h * 64 + kg);
        const bf16x8 va = *(const bf16x8*)(rowp + C_CV + h * 128 + vg), vb = *(const bf16x8*)(rowp + C_CV + h * 128 + vg + 8);
        float wf[16], wb[16];
        { const float* pf = F.in[8] + (size_t)l * 16 * 256 + col; const float* pb = F.in[10] + (size_t)l * 16 * 256 + col;
#pragma unroll
          for (int r = 0; r < 16; ++r) { wf[r] = pf[r * 256]; wb[r] = pb[r * 256]; } }
        const float bif = (F.in[9] + l * 256)[col], bib = (F.in[11] + l * 256)[col];
        WG_SYNC();
        Z0[s_ * 16 + r2] = __uint_as_float(zf << 16); Z0[s_ * 16 + r2 + 1] = __uint_as_float(zf & 0xffff0000u);
        Z1[s_ * 16 + r2] = __uint_as_float(zb << 16); Z1[s_ * 16 + r2 + 1] = __uint_as_float(zb & 0xffff0000u);
#pragma unroll
        for (int j = 0; j < 8; ++j) { VT[(vg + j) * LD + s_] = (bfu)va[j]; VT[(vg + 8 + j) * LD + s_] = (bfu)vb[j]; }
        WG_SYNC();
        float la0[8], la1[8];
#pragma unroll
        for (int i = 0; i < 8; ++i) { const float* z0 = Z0 + (8 * tg + i) * 16; const float* z1 = Z1 + (8 * tg + i) * 16; float p0 = bif, p1 = bib;
#pragma unroll
            for (int r = 0; r < 16; ++r) { p0 += z0[r] * wf[r]; p1 += z1[r] * wb[r]; }
            la0[i] = logsig_fast(p0) * (1.f / 16.f); la1[i] = logsig_fast(p1) * (1.f / 16.f); }
        { float run = 0.f;
#pragma unroll
          for (int i = 0; i < 8; ++i) { run += la0[i]; la0[i] = run; }
          GT0[tg * 64 + k_] = run; run = 0.f;
#pragma unroll
          for (int i = 7; i >= 0; --i) { run += la1[i]; la1[i] = run; }
          GT1[tg * 64 + k_] = run; }
        WG_SYNC();
        { float off0 = 0.f, tot0 = 0.f, off1 = 0.f, tot1 = 0.f;
#pragma unroll
          for (int g = 0; g < 8; ++g) { const float x0 = GT0[g * 64 + k_], x1 = GT1[g * 64 + k_]; tot0 += x0; tot1 += x1; if (g < tg) off0 += x0; if (g > tg) off1 += x1; }
#pragma unroll
          for (int i = 0; i < 8; ++i) { CUM0[(8 * tg + i) * 64 + k_] = la0[i] + off0; CUM1[(8 * tg + i) * 64 + k_] = la1[i] + off1; }
          if (tg == 0) { TOT0[k_] = tot0; TOT1[k_] = tot1; } }
        WG_SYNC();
#pragma unroll
        for (int dir = 0; dir < 2; ++dir) { const float* CUM = dir ? CUM1 : CUM0; const float* TOT = dir ? TOT1 : TOT0; bfu* KhT = dir ? KH1 : KH0;
            float qv[8], kv[8];
#pragma unroll
            for (int j = 0; j < 8; ++j) { const float c = CUM[s_ * 64 + kg + j], kf = bf2f((bfu)kk[j]), en = fexp(-c);
                KhT[(kg + j) * LD + s_] = (bfu)f2bf(kf * en * fexp(TOT[kg + j]));
                kv[j] = kf * en; qv[j] = bf2f((bfu)qq[j]) * 0.125f * fexp(c); }
            v4u wq_, wk_; wq_.x = pk2(qv[0], qv[1]); wq_.y = pk2(qv[2], qv[3]); wq_.z = pk2(qv[4], qv[5]); wq_.w = pk2(qv[6], qv[7]);
            wk_.x = pk2(kv[0], kv[1]); wk_.y = pk2(kv[2], kv[3]); wk_.z = pk2(kv[4], kv[5]); wk_.w = pk2(kv[6], kv[7]);
            bfu* qk = QKT + ((size_t)((gc * 4 + h) * 2 + dir) * 2) * 4096 + s_ * 64 + kg;
            *(v4u*)qk = wq_; *(v4u*)(qk + 4096) = wk_; }
        WG_SYNC();
        { const int dir = wave >> 2, vt = wave & 3; const bfu* KhT = dir ? KH1 : KH0; const float* TOT = dir ? TOT1 : TOT0;
          const int unit = (gc * 4 + h) * 2 + dir; bfu* dst = DUT + (size_t)unit * 8192;
#pragma unroll
          for (int kt = 0; kt < 2; ++kt) { f32x16 acc = {};
              acc = lds_mma(VT + 32 * vt * LD, KhT + 32 * kt * LD, 64, acc, lane);
#pragma unroll
              for (int rr = 0; rr < 16; ++rr) dst[(32 * vt + attn::crow(rr, lane >> 5)) * 64 + 32 * kt + (lane & 31)] = (bfu)f2bf(acc[rr]); }
          if ((tid & 255) < 64) ADEC[unit * 64 + (tid & 255)] = fexp(TOT[tid & 255]); }
    }
    WG_SYNC();
}
__device__ __forceinline__ void c2_phase(Frame& F) {
    bfu* DUT = (bfu*)(F.ws + WS_HID); const float* ADEC = (const float*)(F.ws + WS_ADEC);
    const int NT = 17 * 8 * 1024;
    for (int idx = F.vcu * NTHR + F.tid; idx < NT; idx += F.G * NTHR) {
        const int grp = idx >> 10, e8 = idx & 1023, s = grp >> 3, h = (grp >> 1) & 3, d = grp & 1;
        const int nch = seq_len(s) / 64, gc0 = seq_start(s) / 64;
        float S[8];
#pragma unroll
        for (int c = 0; c < 8; ++c) S[c] = 0.f;
        for (int n = 0; n < nch; n += 8) {
            v4u x[8]; f32x4 a0[8], a1[8]; v4u* p[8];
#pragma unroll
            for (int q = 0; q < 8; ++q) { const int gc = d == 0 ? gc0 + n + q : gc0 + nch - 1 - (n + q); const int unit = (gc * 4 + h) * 2 + d;
                p[q] = (v4u*)(DUT + (size_t)unit * 8192) + e8; x[q] = *p[q]; const float* ap = ADEC + unit * 64 + (e8 & 7) * 8; a0[q] = *(const f32x4*)ap; a1[q] = *(const f32x4*)(ap + 4); }
#pragma unroll
            for (int q = 0; q < 8; ++q) { v4u o; o.x = pk2(S[0], S[1]); o.y = pk2(S[2], S[3]); o.z = pk2(S[4], S[5]); o.w = pk2(S[6], S[7]); *p[q] = o;
                const unsigned* xu = (const unsigned*)&x[q];
                S[0] = a0[q].x * S[0] + __uint_as_float(xu[0] << 16); S[1] = a0[q].y * S[1] + __uint_as_float(xu[0] & 0xffff0000u);
                S[2] = a0[q].z * S[2] + __uint_as_float(xu[1] << 16); S[3] = a0[q].w * S[3] + __uint_as_float(xu[1] & 0xffff0000u);
                S[4] = a1[q].x * S[4] + __uint_as_float(xu[2] << 16); S[5] = a1[q].y * S[5] + __uint_as_float(xu[2] & 0xffff0000u);
                S[6] = a1[q].z * S[6] + __uint_as_float(xu[3] << 16); S[7] = a1[q].w * S[7] + __uint_as_float(xu[3] & 0xffff0000u); }
        }
    }
}
constexpr int M_QT0 = 0, M_KT0 = 9216, M_QT1 = 18432, M_KT1 = 27648, M_ATT0 = 36864, M_ATT1 = 46080, M_VT = 55296, M_ST0 = 73728, M_ST1 = 92160, M_O = 0;
static_assert(M_ST1 + 18432 <= SCR_BYTES && 64 * LDO_ * 4 <= M_ATT0, "gla c3 lds");
__device__ __forceinline__ void c3_phase(Frame& F, int l) {
    const bfu* P = (const bfu*)(F.ws + WS_PROJ); const bfu* DUT = (const bfu*)(F.ws + WS_HID); const bfu* QKT = (const bfu*)(F.ws + WS_QKT);
    bfu* VT = (bfu*)(F.ldsg + M_VT); float* O = (float*)(F.ldsg + M_O);
    bfu* MIXp = (bfu*)(F.ws + WS_MIX); const float* ng = F.in[12] + l * 128;
    const int tid = F.tid, lane = F.lane, wave = F.wave, hi = lane >> 5;
    const int s_ = tid >> 3, kg = (tid & 7) * 8, vg = (tid & 7) * 16, sv = tid >> 2, sk0 = (tid & 3) * 16;
    v4u q0, k0, q1, k1; bf16x8 va, vb, g0, g1; v4u sa0, sa1, sb0, sb1;
#define C3_LOAD(uu) do { const int gc_ = (uu) >> 2, h_ = (uu) & 3, row0_ = gc_ * 64; \
        const bfu* qk_ = QKT + (size_t)((gc_ * 4 + h_) * 4) * 4096 + s_ * 64 + kg;                \
        q0 = *(const v4u*)qk_; k0 = *(const v4u*)(qk_ + 4096); q1 = *(const v4u*)(qk_ + 8192); k1 = *(const v4u*)(qk_ + 12288); \
        const bfu* vsrc_ = P + (size_t)(row0_ + s_) * PP + C_CV + h_ * 128 + vg; va = *(const bf16x8*)vsrc_; vb = *(const bf16x8*)(vsrc_ + 8); \
        const bfu* gp_ = P + (size_t)(row0_ + s_) * PP + C_CG + h_ * 128 + vg; g0 = *(const bf16x8*)gp_; g1 = *(const bf16x8*)(gp_ + 8); \
        const bfu* s0p_ = DUT + (size_t)((gc_ * 4 + h_) * 2) * 8192 + sv * 64 + sk0; const bfu* s1p_ = s0p_ + 8192; \
        sa0 = *(const v4u*)s0p_; sa1 = *(const v4u*)(s0p_ + 8); sb0 = *(const v4u*)s1p_; sb1 = *(const v4u*)(s1p_ + 8); } while (0)
    if (F.vcu < NCHUNK * 4) C3_LOAD(F.vcu);
    for (int u = F.vcu; u < NCHUNK * 4; u += F.G) {
        const int gc = u >> 2, h = u & 3, row0 = gc * 64;
        const bf16x8 g0c = g0, g1c = g1;
        WG_SYNC();
        *(v4u*)(F.ldsg + M_QT0 + (s_ * LD + kg) * 2) = q0; *(v4u*)(F.ldsg + M_KT0 + (s_ * LD + kg) * 2) = k0;
        *(v4u*)(F.ldsg + M_QT1 + (s_ * LD + kg) * 2) = q1; *(v4u*)(F.ldsg + M_KT1 + (s_ * LD + kg) * 2) = k1;
#pragma unroll
        for (int j = 0; j < 8; ++j) { VT[(vg + j) * LD + s_] = (bfu)va[j]; VT[(vg + 8 + j) * LD + s_] = (bfu)vb[j]; }
        *(v4u*)(F.ldsg + M_ST0 + (sv * LD + sk0) * 2) = sa0; *(v4u*)(F.ldsg + M_ST0 + (sv * LD + sk0 + 8) * 2) = sa1;
        *(v4u*)(F.ldsg + M_ST1 + (sv * LD + sk0) * 2) = sb0; *(v4u*)(F.ldsg + M_ST1 + (sv * LD + sk0 + 8) * 2) = sb1;
        if (u + F.G < NCHUNK * 4) C3_LOAD(u + F.G);
        WG_SYNC();
        {
          const int dir = wave >> 2, th = (wave >> 1) & 1, sh = wave & 1;
          const bfu* QTd = (const bfu*)(F.ldsg + (dir ? M_QT1 : M_QT0)); const bfu* KTd = (const bfu*)(F.ldsg + (dir ? M_KT1 : M_KT0)); bfu* ATTd = (bfu*)(F.ldsg + (dir ? M_ATT1 : M_ATT0));
          f32x16 a = {};
          a = lds_mma(QTd + 32 * th * LD, KTd + 32 * sh * LD, 64, a, lane);
#pragma unroll
          for (int rr = 0; rr < 16; ++rr) { const int t = 32 * th + attn::crow(rr, hi), sx = 32 * sh + (lane & 31); const bool keep = dir == 0 ? (sx <= t) : (sx >= t);
              ATTd[t * LD + sx] = (bfu)f2bf(keep ? a[rr] : 0.f); } }
        WG_SYNC();
        f32x16 oacc = {};
        { const int th = wave >> 2, vq = wave & 3;
          oacc = lds_mma((const bfu*)(F.ldsg + M_ATT0) + 32 * th * LD, VT + 32 * vq * LD, 64, oacc, lane);
          oacc = lds_mma((const bfu*)(F.ldsg + M_QT0) + 32 * th * LD, (const bfu*)(F.ldsg + M_ST0) + 32 * vq * LD, 64, oacc, lane);
          oacc = lds_mma((const bfu*)(F.ldsg + M_ATT1) + 32 * th * LD, VT + 32 * vq * LD, 64, oacc, lane);
          oacc = lds_mma((const bfu*)(F.ldsg + M_QT1) + 32 * th * LD, (const bfu*)(F.ldsg + M_ST1) + 32 * vq * LD, 64, oacc, lane); }
        WG_SYNC();
        { const int th = wave >> 2, vq = wave & 3;
#pragma unroll
          for (int rr = 0; rr < 16; ++rr) O[(32 * th + attn::crow(rr, hi)) * LDO_ + 32 * vq + (lane & 31)] = oacc[rr]; }
        WG_SYNC();
        { const int t = s_; float ov[16]; float ss = 0.f;
#pragma unroll
          for (int j = 0; j < 16; ++j) { ov[j] = O[t * LDO_ + vg + j]; ss += ov[j] * ov[j]; }
          ss += __shfl_xor(ss, 1); ss += __shfl_xor(ss, 2); ss += __shfl_xor(ss, 4);
          const float rstd = 1.f / sqrtf(ss * (1.f / 128.f) + RMS_EPS);
          float r[16];
#pragma unroll
          for (int j = 0; j < 16; ++j) { const float gt = bf2f((bfu)(j < 8 ? g0c[j] : g1c[j - 8])); const float sg = gt / (1.f + expf(-gt)); r[j] = ov[j] * rstd * ng[vg + j] * sg; }
          v4u w0, w1; w0.x = pk2(r[0], r[1]); w0.y = pk2(r[2], r[3]); w0.z = pk2(r[4], r[5]); w0.w = pk2(r[6], r[7]); w1.x = pk2(r[8], r[9]); w1.y = pk2(r[10], r[11]); w1.z = pk2(r[12], r[13]); w1.w = pk2(r[14], r[15]);
          bfu* dst = MIXp + (size_t)(row0 + t) * D + MIX_C + h * 128 + vg;
          *(v4u*)dst = w0; *(v4u*)(dst + 8) = w1; }
    }
    WG_SYNC();
}
}

__device__ __forceinline__ void ln1_router_phase(Frame& F, int l) {
    float* WL = (float*)F.ldsg;
    const float* wr = F.in[16] + (size_t)l * D * NEXP;
    WG_SYNC();
    for (int idx = F.tid; idx < D * 4; idx += NTHR) { const int col = idx >> 2, e4 = (idx & 3) * 4; const f32x4 w = *(const f32x4*)(wr + col * 16 + e4);
        const int jj = (col >> 9) * 2 + ((col >> 2) & 1), ln = (col & 511) >> 3, c = col & 3;
        float* dst = WL + (jj * 64 + ln) * 4 + c;
        dst[(e4 + 0) * D] = w.x; dst[(e4 + 1) * D] = w.y; dst[(e4 + 2) * D] = w.z; dst[(e4 + 3) * D] = w.w; }
    WG_SYNC();
    const int gw = F.vcu * NWAVES + F.wave, NGW = F.G * NWAVES, lane = F.lane;
    const float* g = F.in[14] + l * D; const float* b = F.in[15] + l * D;
    float* AFFT = (float*)(F.ws + WS_AFFT);
    const bfu* XNb = (const bfu*)(F.ws + WS_XN); const bfu* MOb = (const bfu*)(F.ws + WS_HID);
    v4u px[4], pm[4];
#pragma unroll
    for (int j = 0; j < 4; ++j) { px[j] = (v4u){0u, 0u, 0u, 0u}; pm[j] = px[j]; }
    if (gw < M) {
#pragma unroll
        for (int j = 0; j < 4; ++j) { px[j] = *(const v4u*)(XNb + (size_t)gw * D + 8 * lane + 512 * j); pm[j] = *(const v4u*)(MOb + (size_t)gw * D + 8 * lane + 512 * j); } }
    for (int m = gw; m < M; m += NGW) {
        bfu* xn = (bfu*)(F.ws + WS_XN) + (size_t)m * D;
        f32x4 v[8];
#pragma unroll
        for (int j = 0; j < 4; ++j) { const v4u x = px[j], y = pm[j];
            v[2 * j] = (f32x4){__uint_as_float(x.x << 16) * DN_ALPHA + __uint_as_float(y.x << 16), __uint_as_float(x.x & 0xffff0000u) * DN_ALPHA + __uint_as_float(y.x & 0xffff0000u),
                               __uint_as_float(x.y << 16) * DN_ALPHA + __uint_as_float(y.y << 16), __uint_as_float(x.y & 0xffff0000u) * DN_ALPHA + __uint_as_float(y.y & 0xffff0000u)};
            v[2 * j + 1] = (f32x4){__uint_as_float(x.z << 16) * DN_ALPHA + __uint_as_float(y.z << 16), __uint_as_float(x.z & 0xffff0000u) * DN_ALPHA + __uint_as_float(y.z & 0xffff0000u),
                                   __uint_as_float(x.w << 16) * DN_ALPHA + __uint_as_float(y.w << 16), __uint_as_float(x.w & 0xffff0000u) * DN_ALPHA + __uint_as_float(y.w & 0xffff0000u)}; }
        if (m + NGW < M) {
#pragma unroll
            for (int j = 0; j < 4; ++j) { px[j] = *(const v4u*)(XNb + (size_t)(m + NGW) * D + 8 * lane + 512 * j); pm[j] = *(const v4u*)(MOb + (size_t)(m + NGW) * D + 8 * lane + 512 * j); } }
        ln_norm(v, g, b, lane);
        row_store_bf16(xn, v, lane);
        row_store_i8(F.ws + WS_XNI8 + (size_t)m * D, (float*)(F.ws + WS_RSC) + m, v, lane);
        float lg[16];
#pragma unroll
        for (int e = 0; e < 16; ++e) lg[e] = 0.f;
#pragma unroll
        for (int j = 0; j < 8; ++j) {
#pragma unroll
            for (int e = 0; e < 16; ++e) { const f32x4 w = *(const f32x4*)(WL + e * D + (j * 64 + lane) * 4); lg[e] += (v[j].x * w.x + v[j].y * w.y) + (v[j].z * w.z + v[j].w * w.w); }
            asm volatile("" ::: "memory");
        }
        float r8[8], r4[4], r2[2], r1;
        { const bool up = (lane & 32) != 0;
#pragma unroll
          for (int i = 0; i < 8; ++i) { const float keep = up ? lg[i + 8] : lg[i], send = up ? lg[i] : lg[i + 8]; r8[i] = keep + __shfl_xor(send, 32); } }
        { const bool up = (lane & 16) != 0;
#pragma unroll
          for (int i = 0; i < 4; ++i) { const float keep = up ? r8[i + 4] : r8[i], send = up ? r8[i] : r8[i + 4]; r4[i] = keep + __shfl_xor(send, 16); } }
        { const bool up = (lane & 8) != 0;
#pragma unroll
          for (int i = 0; i < 2; ++i) { const float keep = up ? r4[i + 2] : r4[i], send = up ? r4[i] : r4[i + 2]; r2[i] = keep + __shfl_xor(send, 8); } }
        { const bool up = (lane & 4) != 0; const float keep = up ? r2[1] : r2[0], send = up ? r2[0] : r2[1]; r1 = keep + __shfl_xor(send, 4); }
        r1 += __shfl_xor(r1, 2); r1 += __shfl_xor(r1, 1);
        float mx = r1;
        mx = fmaxf(mx, __shfl_xor(mx, 4)); mx = fmaxf(mx, __shfl_xor(mx, 8)); mx = fmaxf(mx, __shfl_xor(mx, 16)); mx = fmaxf(mx, __shfl_xor(mx, 32));
        const float ex = expf(r1 - mx);
        float sum = ex;
        sum += __shfl_xor(sum, 4); sum += __shfl_xor(sum, 8); sum += __shfl_xor(sum, 16); sum += __shfl_xor(sum, 32);
        const int eL = ((lane >> 5) & 1) * 8 + ((lane >> 4) & 1) * 4 + ((lane >> 3) & 1) * 2 + ((lane >> 2) & 1);
        if ((lane & 3) == 0) AFFT[(size_t)eL * M + m] = ex / sum;
    }
    WG_SYNC();
}

#define VPH(i) ((i) + ((i) >> 6))
template <int NV> __device__ __forceinline__ void topk_fill(unsigned* VALS, const float* srcf, int tid) {
    const v4u* src = (const v4u*)srcf; v4u t[NV];
#pragma unroll
    for (int j = 0; j < NV; ++j) t[j] = src[j * NTHR + tid];
#pragma unroll
    for (int j = 0; j < NV; ++j) { unsigned* d_ = VALS + VPH((j * NTHR + tid) * 4); d_[0] = t[j].x; d_[1] = t[j].y; d_[2] = t[j].z; d_[3] = t[j].w; }
}
__device__ __forceinline__ void topk_phase(Frame& F) {
    unsigned* VALS = (unsigned*)F.ldsg; unsigned* HIST = (unsigned*)(F.ldsg + 135168); unsigned* SC = (unsigned*)(F.ldsg + 135168 + 8192); unsigned* BC = (unsigned*)(F.ldsg + 135168 + 8192 + 1024);
    static_assert(135168 + 8192 + 1024 + 64 <= SCR_BYTES, "top-k lds");
    const float* AFFT = (const float*)(F.ws + WS_AFFT);
    int* SLOT = (int*)(F.ws + WS_SLOT); int* IDX = (int*)(F.ws + WS_IDX); float* GATE = (float*)(F.ws + WS_GATE);
    float* XRS = (float*)(F.ws + WS_XRS); const float* RSC = (const float*)(F.ws + WS_RSC);
    const int tid = F.tid;
    for (int u = F.vcu; u < 32; u += F.G) {
        const int tr = u >> 4, e = u & 15, n = tr ? NSAMP * TS : TP, base = tr ? TP : 0, cap = n / 8, vpt = n / NTHR;
        WG_SYNC();
        if (tr) topk_fill<16>(VALS, AFFT + (size_t)e * M + base, tid); else topk_fill<4>(VALS, AFFT + (size_t)e * M + base, tid);
        unsigned prefix = 0u, remaining = (unsigned)cap;
        for (int pass = 0; pass < 3; ++pass) {
            const int shift = pass == 0 ? 21 : pass == 1 ? 10 : 0, width = pass == 2 ? 10 : 11; const unsigned mask = (1u << width) - 1u;
            HIST[tid] = 0u; HIST[tid + 512] = 0u; HIST[tid + 1024] = 0u; HIST[tid + 1536] = 0u;
            WG_SYNC();
            for (int i = tid; i < n; i += NTHR) { const unsigned k = VALS[VPH(i)]; if (pass == 0 || (k >> (shift + width)) == prefix) atomicAdd(&HIST[(k >> shift) & mask], 1u); }
            WG_SYNC();
            if (F.wave == 0) {
                const int ln = F.lane; unsigned sl = 0u;
#pragma unroll 8
                for (int q = 0; q < 32; ++q) sl += HIST[32 * ln + ((q + ln) & 31)];
                unsigned suf = sl;
#pragma unroll
                for (int o = 1; o < 64; o <<= 1) { const unsigned t = __shfl_down(suf, o); if (ln + o < 64) suf += t; }
                const unsigned above = suf - sl;
                if (above < remaining && remaining <= above + sl) { unsigned cum = above; int bsel = 0;
                    for (int q = 31; q >= 0; --q) { const unsigned h = HIST[32 * ln + q]; if (cum + h >= remaining) { bsel = q; break; } cum += h; }
                    BC[0] = (unsigned)(32 * ln + bsel); BC[1] = remaining - cum; } }
            WG_SYNC();
            prefix = (prefix << width) | BC[0]; remaining = BC[1];
            WG_SYNC();
        }
        const unsigned thr = prefix, need_eq = remaining;
        unsigned cgt = 0u, ceq = 0u;
        for (int i = 0; i < vpt; ++i) { const unsigned k = VALS[VPH(tid * vpt + i)]; cgt += k > thr; ceq += k == thr; }
        unsigned gtb, eqb;
        {
          unsigned ia = cgt, ib = ceq;
#pragma unroll
          for (int o = 1; o < 64; o <<= 1) { const unsigned ta = __shfl_up(ia, o), tb = __shfl_up(ib, o); if (F.lane >= o) { ia += ta; ib += tb; } }
          if (F.lane == 63) { SC[F.wave] = ia; SC[8 + F.wave] = ib; }
          WG_SYNC();
          unsigned oa = 0u, ob = 0u;
#pragma unroll
          for (int w = 0; w < 8; ++w) { const unsigned xa = SC[w], xb = SC[8 + w]; if (w < F.wave) { oa += xa; ob += xb; } }
          gtb = oa + ia - cgt; eqb = ob + ib - ceq;
          WG_SYNC(); }
        const int xbase = e * XE_PER_E + (tr ? 1024 : 0);
        for (int i = 0; i < vpt; ++i) { const int ix = tid * vpt + i; const unsigned k = VALS[VPH(ix)];
            const bool sel = k > thr || (k == thr && eqb < need_eq);
            const unsigned slot = gtb + (eqb < need_eq ? eqb : need_eq);
            int xr = -1;
            if (sel) { xr = xbase + (int)slot; IDX[xr] = base + ix; GATE[xr] = __uint_as_float(k); XRS[xr] = RSC[base + ix]; }
            VALS[VPH(ix)] = (unsigned)xr;
            gtb += k > thr; eqb += k == thr; }
        WG_SYNC();
        for (int i = tid; i < n; i += NTHR) SLOT[(size_t)e * M + base + i] = (int)VALS[VPH(i)];
    }
    WG_SYNC();
}
__device__ __forceinline__ void gather_phase(Frame& F) {
    const int gw = F.vcu * NWAVES + F.wave, NGW = F.G * NWAVES, lane = F.lane;
    const int* IDX = (const int*)(F.ws + WS_IDX); const bfu* XN = (const bfu*)(F.ws + WS_XN); bfu* XE = (bfu*)(F.ws + WS_PROJ);
    for (int xr = gw; xr < XE_ROWS; xr += NGW) { const int tok = IDX[xr]; const v4u* src = (const v4u*)(XN + (size_t)tok * D); v4u* dst = (v4u*)(XE + (size_t)xr * D);
        v4u a = src[lane], b = src[64 + lane], c = src[128 + lane], d = src[192 + lane]; dst[lane] = a; dst[64 + lane] = b; dst[128 + lane] = c; dst[192 + lane] = d; }
}
__device__ __forceinline__ void ln2_phase(Frame& F, int l) {
    const int gw = F.vcu * NWAVES + F.wave, NGW = F.G * NWAVES, lane = F.lane;
    const float* g = F.in[20] + l * D; const float* b = F.in[21] + l * D;
    const int* SLOT = (const int*)(F.ws + WS_SLOT); const unsigned char* YE = F.ws + WS_PROJ;
    const bool poison = (l + 1 == DEPTH) && __hip_atomic_load(F.ctl + CW_BAR + XB_TMO, RLX_AGENT) != 0u; const float qnan = __builtin_nanf("");
    const bfu* XNb = (const bfu*)(F.ws + WS_XN);
    v4u px[4]; int pxs = -1;
#pragma unroll
    for (int j = 0; j < 4; ++j) px[j] = (v4u){0u, 0u, 0u, 0u};
    if (gw < M) { pxs = lane < 16 ? SLOT[(size_t)lane * M + gw] : -1;
#pragma unroll
        for (int j = 0; j < 4; ++j) px[j] = *(const v4u*)(XNb + (size_t)gw * D + 8 * lane + 512 * j); }
    for (int m = gw; m < M; m += NGW) {
        bfu* xn = (bfu*)(F.ws + WS_XN) + (size_t)m * D;
        f32x4 v[8];
#pragma unroll
        for (int j = 0; j < 4; ++j) { const v4u x = px[j];
            v[2 * j] = (f32x4){__uint_as_float(x.x << 16) * DN_ALPHA, __uint_as_float(x.x & 0xffff0000u) * DN_ALPHA, __uint_as_float(x.y << 16) * DN_ALPHA, __uint_as_float(x.y & 0xffff0000u) * DN_ALPHA};
            v[2 * j + 1] = (f32x4){__uint_as_float(x.z << 16) * DN_ALPHA, __uint_as_float(x.z & 0xffff0000u) * DN_ALPHA, __uint_as_float(x.w << 16) * DN_ALPHA, __uint_as_float(x.w & 0xffff0000u) * DN_ALPHA}; }
        const int xs = pxs;
        if (m + NGW < M) { pxs = lane < 16 ? SLOT[(size_t)lane * M + m + NGW] : -1;
#pragma unroll
            for (int j = 0; j < 4; ++j) px[j] = *(const v4u*)(XNb + (size_t)(m + NGW) * D + 8 * lane + 512 * j); }
        unsigned long long mask = __ballot(xs >= 0);
        while (mask) {
            const int e1 = __builtin_ctzll(mask); mask &= mask - 1ull; const int xr1 = __builtin_amdgcn_readlane(xs, e1);
            if (mask) { const int e2 = __builtin_ctzll(mask); mask &= mask - 1ull; const int xr2 = __builtin_amdgcn_readlane(xs, e2);
                pg8::u32x2 a_[4], b_[4];
#pragma unroll
                for (int j = 0; j < 4; ++j) { a_[j] = *(const pg8::u32x2*)(YE + (size_t)xr1 * D + 8 * lane + 512 * j); b_[j] = *(const pg8::u32x2*)(YE + (size_t)xr2 * D + 8 * lane + 512 * j); }
#pragma unroll
                for (int j = 0; j < 4; ++j) {
                    const pg8::f32x2 a0 = __builtin_amdgcn_cvt_pk_f32_fp8(a_[j].x, false), a1 = __builtin_amdgcn_cvt_pk_f32_fp8(a_[j].x, true), a2 = __builtin_amdgcn_cvt_pk_f32_fp8(a_[j].y, false), a3 = __builtin_amdgcn_cvt_pk_f32_fp8(a_[j].y, true);
                    const pg8::f32x2 b0 = __builtin_amdgcn_cvt_pk_f32_fp8(b_[j].x, false), b1 = __builtin_amdgcn_cvt_pk_f32_fp8(b_[j].x, true), b2 = __builtin_amdgcn_cvt_pk_f32_fp8(b_[j].y, false), b3 = __builtin_amdgcn_cvt_pk_f32_fp8(b_[j].y, true);
                    const float sc = 1.f / YE_SCALE;
                    v[2 * j].x += (a0.x + b0.x) * sc; v[2 * j].y += (a0.y + b0.y) * sc; v[2 * j].z += (a1.x + b1.x) * sc; v[2 * j].w += (a1.y + b1.y) * sc;
                    v[2 * j + 1].x += (a2.x + b2.x) * sc; v[2 * j + 1].y += (a2.y + b2.y) * sc; v[2 * j + 1].z += (a3.x + b3.x) * sc; v[2 * j + 1].w += (a3.y + b3.y) * sc; }
            } else row_add_fp8(YE + (size_t)xr1 * D, v, lane, 1.f / YE_SCALE);
        }
        ln_norm(v, g, b, lane);
        if (poison) {
#pragma unroll
            for (int j = 0; j < 8; ++j) v[j] = (f32x4){qnan, qnan, qnan, qnan}; }
        if (l + 1 < DEPTH) { row_store_bf16(xn, v, lane); row_store_i8(F.ws + WS_XNI8 + (size_t)m * D, (float*)(F.ws + WS_RSC) + m, v, lane); } else row_store_f32(F.X + (size_t)m * D, v, lane);
    }
}


constexpr int NPL = 11, NPH = 1 + DEPTH * NPL;
#if defined(PROBE_CONSIST)
__device__ __forceinline__ void chk_region(Frame& F, const void* base, size_t bytes, unsigned long long* dst, unsigned long long salt) {
    const unsigned* buf = (const unsigned*)base; const size_t nwords = bytes / 4;
    unsigned long long acc = 0ull;
    for (size_t i = (size_t)F.vcu * NTHR + F.tid; i < nwords; i += (size_t)F.G * NTHR) acc += (unsigned long long)buf[i] * (2ull * i + 1ull + salt);
    for (int o = 1; o < 64; o <<= 1) acc += __shfl_xor(acc, o);
    if (F.lane == 0) atomicAdd(dst, acc);
}
__device__ __forceinline__ void probe_chk(Frame& F, int run, int ph) {
    unsigned long long* dst = (unsigned long long*)(F.ws + 512 * 1024) + run * 32 + ph;
    unsigned char* ws = F.ws; const int k = ph == 0 ? -1 : (ph - 1) % NPL;
    if (ph == 0) { chk_region(F, ws + WS_WIN, WS_XN - WS_WIN, dst, 1); chk_region(F, F.X, (size_t)M * D * 4, dst, 3); chk_region(F, ws + WS_XN, (size_t)M * D * 2, dst, 5); }
    else if (k == 0) chk_region(F, ws + WS_PROJ, (size_t)M * PP * 2, dst, 7);
    else if (k == 1) { chk_region(F, ws + WS_PROJ, (size_t)M * PP * 2, dst, 7); chk_region(F, ws + WS_HID, (size_t)NCHUNK * 8 * 8192 * 4, dst, 9); chk_region(F, ws + WS_ADEC, (size_t)NCHUNK * 8 * 64 * 4, dst, 11); }
    else if (k == 2) {
        { const unsigned* buf = (const unsigned*)(ws + WS_MIX); unsigned long long accA = 0ull, accB = 0ull;
          for (size_t i = (size_t)F.vcu * NTHR + F.tid; i < (size_t)M * D / 2; i += (size_t)F.G * NTHR) { const int cw = (int)(i % (D / 2)); const unsigned long long t = (unsigned long long)buf[i] * (2ull * i + 1ull);
              if (cw < 384) accA += t; else if (cw < 768) accB += t; }
          for (int o = 1; o < 64; o <<= 1) { accA += __shfl_xor(accA, o); accB += __shfl_xor(accB, o); }
          if (F.lane == 0) { atomicAdd(dst, accA); atomicAdd(dst + 1, accB); } }
        chk_region(F, ws + WS_HID, (size_t)NCHUNK * 8 * 8192 * 4, dst + 2, 9); chk_region(F, ws + WS_LSE, (size_t)M * 6 * 4, dst + 3, 15); }
    else if (k == 3) chk_region(F, ws + WS_MIX, (size_t)M * D * 2, dst, 13);
    else if (k == 4) chk_region(F, F.X, (size_t)M * D * 4, dst, 3);
    else if (k == 5) { chk_region(F, F.X, (size_t)M * D * 4, dst, 3); chk_region(F, ws + WS_XN, (size_t)M * D * 2, dst, 5); chk_region(F, ws + WS_AFFT, (size_t)16 * M * 4, dst, 17); }
    else if (k == 6) { chk_region(F, ws + WS_SLOT, (size_t)16 * M * 4, dst, 19); chk_region(F, ws + WS_IDX, (size_t)XE_ROWS * 4, dst, 21); chk_region(F, ws + WS_GATE, (size_t)XE_ROWS * 4, dst, 23); }
    else if (k == 7) chk_region(F, ws + WS_PROJ, (size_t)XE_ROWS * D * 2, dst, 25);
    else if (k == 8) chk_region(F, ws + WS_HID, (size_t)XE_ROWS * DFF * 2, dst, 27);
    else if (k == 9) chk_region(F, ws + WS_PROJ, (size_t)XE_ROWS * D * 2, dst, 25);
    else if (k == 10) chk_region(F, F.X, (size_t)M * D * 4, dst, 3);
}
__device__ __forceinline__ void probe_report(Frame& F, int R, int n_out) {
    const unsigned long long* chk = (const unsigned long long*)(F.ws + 512 * 1024);
    int first = 99;
    for (int r = 1; r < R; ++r) for (int p = 0; p < NPH; ++p) if (__hip_atomic_load(chk + r * 32 + p, __ATOMIC_RELAXED, __HIP_MEMORY_SCOPE_AGENT) != __hip_atomic_load(chk + p, __ATOMIC_RELAXED, __HIP_MEMORY_SCOPE_AGENT)) { if (p < first) first = p; break; }
    const float c = first == 99 ? 2.0f : 3.0f + (float)first;
    for (long i = (long)F.vcu * NTHR + F.tid; i < n_out; i += (long)F.G * NTHR) F.X[i] = c;
}
#endif
struct Args { const float* in[22]; float* out; unsigned char* ws; int ph_lo, ph_hi, run, pad; };
#define KARG_RUN() (((const Args __attribute__((address_space(4)))*)__builtin_amdgcn_kernarg_segment_ptr())->run)
__global__ void __launch_bounds__(NWAVES * 64, 2) trunk_fwd(Args args) {
    extern __shared__ __attribute__((aligned(16))) unsigned char lds[];
    Frame F;
    F.lds = (LAS unsigned char*)lds; F.ldsg = (char*)lds;
    F.MISC = (volatile LAS unsigned*)(F.lds + MISC_OFF);
    F.tid = threadIdx.x; F.lane = F.tid & 63; F.wave = __builtin_amdgcn_readfirstlane(F.tid >> 6);
#define KAS __attribute__((address_space(4)))
#define REFRESH() do { const unsigned char KAS* ka_ = (const unsigned char KAS*)__builtin_amdgcn_kernarg_segment_ptr(); asm volatile("" : "+s"(ka_)); const Args KAS* ap_ = (const Args KAS*)ka_; \
    _Pragma("unroll") for (int i_ = 0; i_ < 22; ++i_) F.in[i_] = ap_->in[i_]; F.X = ap_->out; F.ws = ap_->ws; F.ctl = (gu32*)(F.ws + WS_CTL); \
    F.tid = threadIdx.x; asm volatile("" : "+v"(F.tid)); F.lane = F.tid & 63; F.wave = __builtin_amdgcn_readfirstlane(F.tid >> 6); \
    { int bx_ = blockIdx.x, g_ = gridDim.x; asm volatile("" : "+s"(bx_), "+s"(g_)); F.G = g_; F.bx = bx_; F.vcu = (g_ % 8 == 0) ? (bx_ % 8) * (g_ / 8) + bx_ / 8 : bx_; } } while (0)
    REFRESH();
    for (int u = F.tid; u < (LDS_BYTES - LDSCTL_OFF) / 4; u += NWAVES * 64) ((LAS unsigned*)(F.lds + LDSCTL_OFF))[u] = 0u;
    __syncthreads();
#if MK_FIXED_RANGE
    const bool multi = true;
#else
    const int lo = args.ph_lo, hi = args.ph_hi;
    const bool multi = (hi - lo) > 1;
#endif
    XcdBarrier bar; bar.bar = (unsigned*)(F.ctl + CW_BAR) + args.run * XCD_BAR_WORDS; bar.x = 0; bar.st = nullptr;
    if (multi) bar = xcd_barrier_post((unsigned*)(F.ctl + CW_BAR) + args.run * XCD_BAR_WORDS, F.MISC + 8);
#ifndef TIMING_DUP
#define TIMING_DUP 0
#endif
#ifndef PHASE_MASK
#define PHASE_MASK 0xFFFFFFFFu
#endif
#define PM(b) ((PHASE_MASK >> (b)) & 1u)
#if MK_FIXED_RANGE
#define IN(k) true
#else
#define IN(k) (lo <= (k) && (k) < hi)
#endif
#if defined(PROBE_CONSIST)
#define SEAM(k) do { if (IN(k)) { xcd_barrier(bar); REFRESH(); probe_chk(F, KARG_RUN(), (k)); if (IN((k) + 1)) xcd_barrier(bar); } } while (0)
#else
#define SEAM(k) do { if (IN(k) && IN((k) + 1)) xcd_barrier(bar); } while (0)
#endif
#define XN_ ((bfu*)(F.ws + WS_XN))
#define PROJ_ ((bfu*)(F.ws + WS_PROJ))
#define MIX_ ((bfu*)(F.ws + WS_MIX))
#define HID_ ((bfu*)(F.ws + WS_HID))

    if (IN(0) && PM(0)) { REFRESH(); p0_prologue(F);
#if (TIMING_DUP & 32)
        __syncthreads(); p0_prologue(F);
#endif
    } SEAM(0);
    {
        constexpr int l = 0; constexpr int pb = 1 + l * NPL;
        if (IN(pb + 0) && PM(1)) { REFRESH();
            const bool split = (l == 0) && F.G > 2 * NCONV;
            const int GW = split ? F.G - NCONV : F.G;
            if (F.bx < GW) {
            {
              pg8::Gemm g{(const bfu*)(F.ws + WS_XNI8), (const bfu*)(F.ws + WS_WINI8 + l * WINI8_L), M, DIN_PAD, D / 2  , 0}; pg8::StaticOrder S; S.init(M, DIN_PAD, GW, F.bx);
              pg8::EpiProjI8 E{PROJ_, PP, DIN, 0, (const float*)(F.ws + WS_RSC), (const float*)(F.ws + WS_CSC) + l * DIN_PAD};
              pg8::gemm_phase<pg8::EpiProjI8, pg8::StaticOrder, true, true, false, false, true>(F.lds, g, S, E); }
            } else conv_worker(F, F.bx - GW, NCONV);
        } SEAM(pb + 0);
        if (IN(pb + 1) && PM(2)) { REFRESH(); if (PM(12)) { qk_prep(F, l); vt8_pass(F); } if (PM(13)) gla::c1_phase(F, l);
#if (TIMING_DUP & 8)
            gla::c1_phase(F, l);
#endif
            } SEAM(pb + 1);
        if (IN(pb + 2) && PM(3)) { REFRESH(); if (PM(14)) attn_a_phase(F);
#if (TIMING_DUP & 2)
            attn_a_phase(F);
#endif
            if (PM(15)) mixb::mixer_b_phase(F);
#if (TIMING_DUP & 4)
            mixb::mixer_b_phase(F);
#endif
            if (PM(16)) gla::c2_phase(F); } SEAM(pb + 2);
        if (IN(pb + 3) && PM(4)) { REFRESH(); if (PM(17)) gla::c3_phase(F, l);
#if (TIMING_DUP & 8)
            gla::c3_phase(F, l);
#endif
            } SEAM(pb + 3);
        if (IN(pb + 4) && PM(5)) { REFRESH();
            mixb::mix_row_pass(F); xcd_barrier(bar); REFRESH();
            pg8::Gemm g{(const bfu*)(F.ws + WS_MIXI8), (const bfu*)(F.ws + WS_WOUTI8 + l * WOUTI8_L), M, D, D / 2  , 0}; pg8::StaticOrder S; S.init(M, D, F.G, F.bx);
            pg8::EpiProjI8 E{HID_  , D, D, 0, (const float*)(F.ws + WS_RSC2), (const float*)(F.ws + WS_CSC2) + l * D};
            pg8::gemm_phase<pg8::EpiProjI8, pg8::StaticOrder, true, true, false, false, true>(F.lds, g, S, E);
        } SEAM(pb + 4);
        if (IN(pb + 5) && PM(6)) { REFRESH(); ln1_router_phase(F, l); } SEAM(pb + 5);
        if (IN(pb + 6) && PM(7)) { REFRESH(); topk_phase(F);
#if (TIMING_DUP & 16)
            topk_phase(F);
#endif
            if (F.G <= 32) conv_window(F, l, F.vcu, F.G); else if (F.vcu >= 32) conv_window(F, l, F.vcu - 32, F.G - 32);
            } SEAM(pb + 6);
        if (IN(pb + 8) && PM(9)) { REFRESH();
            pg8::Gemm g{(const bfu*)(F.ws + WS_XNI8)  , (const bfu*)(F.ws + WS_WGU + l * WGU_L), XE_ROWS, 2 * DFF, D / 2  , WGU_E}; pg8::StaticOrder S; S.init(XE_ROWS, 2 * DFF, F.G, F.bx, XE_PER_E / 256);
            pg8::EpiSwiGLUI8 E{F.ws + WS_HID, DFF, (const float*)(F.ws + WS_XRS), (const float*)(F.ws + WS_CSCGU) + (size_t)l * NEXP * 4096};
            pg8::gemm_phase<pg8::EpiSwiGLUI8, pg8::StaticOrder, true, true, true, false, true>(F.lds, g, S, E, (const int*)(F.ws + WS_IDX));
#if (TIMING_DUP & 1)
            __syncthreads(); pg8::gemm_phase<pg8::EpiSwiGLU8, pg8::StaticOrder, true, true, true, true>(F.lds, g, S, E, (const int*)(F.ws + WS_IDX));
#endif
        } SEAM(pb + 8);
        if (IN(pb + 9) && PM(10)) { REFRESH();
#if defined(NOP_SLED)
            asm volatile(".rept 16384\n s_nop 0\n .endr" ::: "memory");
#endif
            pg8::Gemm g{HID_  , (const bfu*)(F.ws + WS_WD + l * WD_L), XE_ROWS, D, DFF / 2  , WD_E}; pg8::StaticOrder S; S.init(XE_ROWS, D, F.G, F.bx, XE_PER_E / 256);
            pg8::EpiGate8 E{F.ws + WS_PROJ  , D, (const float*)(F.ws + WS_GATE), YE_SCALE / WD_SCALE};
            pg8::gemm_phase<pg8::EpiGate8, pg8::StaticOrder, true, true, false, true>(F.lds, g, S, E);
#if (TIMING_DUP & 1)
            __syncthreads(); pg8::gemm_phase<pg8::EpiGate8, pg8::StaticOrder, true, true, false, true>(F.lds, g, S, E);
#endif
        } SEAM(pb + 9);
        if (IN(pb + 10) && PM(11)) { REFRESH(); ln2_phase(F, l); } SEAM(pb + 10);
    }
    {
        constexpr int l = 1; constexpr int pb = 1 + l * NPL;
        if (IN(pb + 0) && PM(1)) { REFRESH();
            const bool split = (l == 0) && F.G > 2 * NCONV;
            const int GW = split ? F.G - NCONV : F.G;
            if (F.bx < GW) {
            {
              pg8::Gemm g{(const bfu*)(F.ws + WS_XNI8), (const bfu*)(F.ws + WS_WINI8 + l * WINI8_L), M, DIN_PAD, D / 2  , 0}; pg8::StaticOrder S; S.init(M, DIN_PAD, GW, F.bx);
              pg8::EpiProjI8 E{PROJ_, PP, DIN, 0, (const float*)(F.ws + WS_RSC), (const float*)(F.ws + WS_CSC) + l * DIN_PAD};
              pg8::gemm_phase<pg8::EpiProjI8, pg8::StaticOrder, true, true, false, false, true>(F.lds, g, S, E); }
            } else conv_worker(F, F.bx - GW, NCONV);
        } SEAM(pb + 0);
        if (IN(pb + 1) && PM(2)) { REFRESH(); if (PM(12)) { qk_prep(F, l); vt8_pass(F); } if (PM(13)) gla::c1_phase(F, l);
#if (TIMING_DUP & 8)
            gla::c1_phase(F, l);
#endif
            } SEAM(pb + 1);
        if (IN(pb + 2) && PM(3)) { REFRESH(); if (PM(14)) attn_a_phase(F);
#if (TIMING_DUP & 2)
            attn_a_phase(F);
#endif
            if (PM(15)) mixb::mixer_b_phase(F);
#if (TIMING_DUP & 4)
            mixb::mixer_b_phase(F);
#endif
            if (PM(16)) gla::c2_phase(F); } SEAM(pb + 2);
        if (IN(pb + 3) && PM(4)) { REFRESH(); if (PM(17)) gla::c3_phase(F, l);
#if (TIMING_DUP & 8)
            gla::c3_phase(F, l);
#endif
            } SEAM(pb + 3);
        if (IN(pb + 4) && PM(5)) { REFRESH();
            mixb::mix_row_pass(F); xcd_barrier(bar); REFRESH();
            pg8::Gemm g{(const bfu*)(F.ws + WS_MIXI8), (const bfu*)(F.ws + WS_WOUTI8 + l * WOUTI8_L), M, D, D / 2  , 0}; pg8::StaticOrder S; S.init(M, D, F.G, F.bx);
            pg8::EpiProjI8 E{HID_  , D, D, 0, (const float*)(F.ws + WS_RSC2), (const float*)(F.ws + WS_CSC2) + l * D};
            pg8::gemm_phase<pg8::EpiProjI8, pg8::StaticOrder, true, true, false, false, true>(F.lds, g, S, E);
        } SEAM(pb + 4);
        if (IN(pb + 5) && PM(6)) { REFRESH(); ln1_router_phase(F, l); } SEAM(pb + 5);
        if (IN(pb + 6) && PM(7)) { REFRESH(); topk_phase(F);
#if (TIMING_DUP & 16)
            topk_phase(F);
#endif
            if (F.G <= 32) conv_window(F, l, F.vcu, F.G); else if (F.vcu >= 32) conv_window(F, l, F.vcu - 32, F.G - 32);
            } SEAM(pb + 6);
        if (IN(pb + 8) && PM(9)) { REFRESH();
            pg8::Gemm g{(const bfu*)(F.ws + WS_XNI8)  , (const bfu*)(F.ws + WS_WGU + l * WGU_L), XE_ROWS, 2 * DFF, D / 2  , WGU_E}; pg8::StaticOrder S; S.init(XE_ROWS, 2 * DFF, F.G, F.bx, XE_PER_E / 256);
            pg8::EpiSwiGLUI8 E{F.ws + WS_HID, DFF, (const float*)(F.ws + WS_XRS), (const float*)(F.ws + WS_CSCGU) + (size_t)l * NEXP * 4096};
            pg8::gemm_phase<pg8::EpiSwiGLUI8, pg8::StaticOrder, true, true, true, false, true>(F.lds, g, S, E, (const int*)(F.ws + WS_IDX));
#if (TIMING_DUP & 1)
            __syncthreads(); pg8::gemm_phase<pg8::EpiSwiGLU8, pg8::StaticOrder, true, true, true, true>(F.lds, g, S, E, (const int*)(F.ws + WS_IDX));
#endif
        } SEAM(pb + 8);
        if (IN(pb + 9) && PM(10)) { REFRESH();
#if defined(NOP_SLED)
            asm volatile(".rept 16384\n s_nop 0\n .endr" ::: "memory");
#endif
            pg8::Gemm g{HID_  , (const bfu*)(F.ws + WS_WD + l * WD_L), XE_ROWS, D, DFF / 2  , WD_E}; pg8::StaticOrder S; S.init(XE_ROWS, D, F.G, F.bx, XE_PER_E / 256);
            pg8::EpiGate8 E{F.ws + WS_PROJ  , D, (const float*)(F.ws + WS_GATE), YE_SCALE / WD_SCALE};
            pg8::gemm_phase<pg8::EpiGate8, pg8::StaticOrder, true, true, false, true>(F.lds, g, S, E);
#if (TIMING_DUP & 1)
            __syncthreads(); pg8::gemm_phase<pg8::EpiGate8, pg8::StaticOrder, true, true, false, true>(F.lds, g, S, E);
#endif
        } SEAM(pb + 9);
        if (IN(pb + 10) && PM(11)) { REFRESH(); ln2_phase(F, l); } SEAM(pb + 10);
    }
#undef IN
#undef SEAM
}


#if defined(PROBE_CONSIST)
__global__ void __launch_bounds__(256) chk_report(const unsigned long long* chk, int R, int nph, float* out, int n_out) {
    int first = 99;
    for (int r = 1; r < R; ++r) for (int p = 0; p < nph; ++p) if (chk[r * 32 + p] != chk[p]) { if (p < first) first = p; break; }
    const float c = first == 99 ? 2.0f : 3.0f + (float)first;
    for (long i = (long)blockIdx.x * 256 + threadIdx.x; i < n_out; i += (long)gridDim.x * 256) out[i] = c;
}
#endif
#ifndef MK_ONE_LAUNCH
#define MK_ONE_LAUNCH 1
#endif
extern "C" void kernel_launch(void* const* d_in, const int* in_sizes, int n_in, void* d_out, int out_size, void* d_ws, size_t ws_size, hipStream_t stream) {
    static int grid = 0;
    if (grid == 0) {
        if (n_in != 22 || out_size != M * D || ws_size < WS_END) { fprintf(stderr, "kernel_launch: shape mismatch (n_in %d out %d ws %zu, need ws >= %zu); nothing launched\n", n_in, out_size, ws_size, (size_t)WS_END); grid = -1; return; }
        int dev = 0, cus = 0, per_cu = 0;
        if (hipGetDevice(&dev) != hipSuccess || hipDeviceGetAttribute(&cus, hipDeviceAttributeMultiprocessorCount, dev) != hipSuccess) { grid = -1; return; }
        if (hipFuncSetAttribute((const void*)trunk_fwd, hipFuncAttributeMaxDynamicSharedMemorySize, LDS_BYTES) != hipSuccess) { fprintf(stderr, "kernel_launch: hipFuncSetAttribute failed\n"); grid = -1; return; }
        if (hipOccupancyMaxActiveBlocksPerMultiprocessor(&per_cu, (const void*)trunk_fwd, NWAVES * 64, LDS_BYTES) != hipSuccess || per_cu < 1)
            fprintf(stderr, "kernel_launch: note: occupancy query reports %d workgroups per CU\n", per_cu);
        (void)hipGetLastError();
        grid = cus;
    }
    if (grid < 0) return;
#if defined(PROBE_POISON)
    (void)hipMemsetAsync((char*)d_ws + 2 * MiB, 0xAA, WS_END - 2 * MiB, stream); (void)hipMemsetAsync(d_out, 0xAA, (size_t)M * D * 4, stream);
#endif
    if (hipMemsetAsync((char*)d_ws + WS_CTL, 0, CTL_ZERO_BYTES, stream) != hipSuccess) return;
    Args a{};
    for (int i = 0; i < 22; ++i) a.in[i] = (const float*)d_in[i];
    a.out = (float*)d_out; a.ws = (unsigned char*)d_ws;
#ifndef CUT_MASK
#define CUT_MASK 0u
#endif
#if defined(PROBE_CONSIST)
    for (int r = 0; r < PROBE_CONSIST; ++r) { a.ph_lo = 0; a.ph_hi = NPH; a.run = r; hipLaunchKernelGGL(trunk_fwd, dim3(grid), dim3(NWAVES * 64), LDS_BYTES, stream, a); }
    hipLaunchKernelGGL(chk_report, dim3(1024), dim3(256), 0, stream, (const unsigned long long*)((char*)d_ws + 512 * 1024), (int)PROBE_CONSIST, NPH, (float*)d_out, out_size);
#else
    { int lo = 0;
      for (int ph = 0; ph < NPH; ++ph) {
          const bool cut = (ph == NPH - 1) || ((CUT_MASK >> ph) & 1u) || !MK_ONE_LAUNCH;
          if (cut) { a.ph_lo = lo; a.ph_hi = ph + 1; if (lo != 0 && ph + 1 - lo > 1) (void)hipMemsetAsync((char*)d_ws + WS_CTL, 0, CTL_ZERO_BYTES, stream); hipLaunchKernelGGL(trunk_fwd, dim3(grid), dim3(NWAVES * 64), LDS_BYTES, stream, a); lo = ph + 1; }
      } }

#endif
    const hipError_t le = hipPeekAtLastError();
    if (le != hipSuccess) fprintf(stderr, "kernel_launch: launch failed: %s\n", hipGetErrorName(le));
}
```

```cpp
#include <hip/hip_runtime.h>
#include <hip/hip_bf16.h>
#include <cstdio>
#include <cstdint>
#include <cmath>

constexpr int D = 2048, TP = 8192, NSAMP = 16, TS = 2048, M = TP + NSAMP * TS  , DEPTH = 2;
constexpr int DIN = 5152, DIN_PAD = 5376, PP = 5152  ;
constexpr int C_AQ = 0, C_AK = 768, C_AV = 1024, C_BQ = 1280, C_BK = 2048, C_BV = 2816, C_CQ = 3584, C_CK = 3840, C_CV = 4096, C_CG = 4608, C_ZF = 5120, C_ZB = 5136;
constexpr int MIX_B = 768, MIX_C = 1536;
constexpr int NEXP = 16, XE_PER_E = 5120  , XE_ROWS = NEXP * XE_PER_E, DFF = 2048;
constexpr float LN_EPS = 1e-5f, RMS_EPS = 1e-6f, DN_ALPHA = 1.41421356237309515f  ;
constexpr int NCHUNK = M / 64;
__host__ __device__ __forceinline__ int seq_start(int s) { return s == 0 ? 0 : TP + (s - 1) * TS; }
__host__ __device__ __forceinline__ int seq_len(int s) { return s == 0 ? TP : TS; }
namespace pg8 {
#define PG8_LAS __attribute__((address_space(3)))
typedef unsigned short bf16_t;
typedef short bf16x8 __attribute__((ext_vector_type(8)));
typedef float f32x4 __attribute__((ext_vector_type(4)));
typedef unsigned u32x4 __attribute__((ext_vector_type(4)));
constexpr int BM = 256, BK = 64, HALF = 128, HTB = HALF * BK * 2  , STAGE_BYTES = 8 * HTB, NXCD = 8, WGM = 8;

__host__ __device__ __forceinline__ int lds_byte(int r, int c) { const int st = (r >> 4) * 2 + (c >> 5), rr = r & 15, cc = c & 31, ob = rr * 64 + cc * 2; return st * 1024 + (ob ^ (((ob >> 9) & 1) << 5)); }
__host__ __device__ __forceinline__ void stage_rc(int b, int& R, int& C) { const int st = b / 1024, sb = b % 1024, swz = sb ^ (((sb >> 9) & 1) << 5); R = (st >> 1) * 16 + swz / 64; C = (st & 1) * 32 + (swz % 64) / 2; }
__host__ __device__ __forceinline__ int perm32(int rho) { const int n = rho >> 4, i = rho & 15; return 8 * (i >> 2) + 4 * n + (i & 3); }
typedef int i32x4_t __attribute__((ext_vector_type(4)));
typedef float f32x2 __attribute__((ext_vector_type(2)));
typedef int i32x8_t __attribute__((ext_vector_type(8)));
struct Unit { int pm, pn, e; };
struct Gemm { const bf16_t* A; const bf16_t* Bt; int M, N, K; size_t bstride; };

struct StaticOrder {
    int nM, nN, nwg, G, c, tpe; int same = 0;
    __host__ __device__ void init(int M, int N, int G_, int c_, int tpe_ = 0) { nM = M / BM; nN = N / BM; nwg = nM * nN; G = G_; c = c_; tpe = tpe_; }
    __host__ __device__ bool next(int i, Unit& u) const {
        const long L = same ? (i < same ? (long)c : (long)nwg) : (long)i * G + c; if (L >= nwg) return false;
        int wgid = (int)L; { const int q = nwg / NXCD, r = nwg % NXCD, xcd = wgid % NXCD, off = wgid / NXCD; wgid = (xcd < r ? xcd * (q + 1) : r * (q + 1) + (xcd - r) * q) + off; }
        const int nig = WGM * nN, gid = wgid / nig, fm = gid * WGM, gsz = (nM - fm) < WGM ? (nM - fm) : WGM;
        u.pm = fm + ((wgid % nig) % gsz); u.pn = (wgid % nig) / gsz; u.e = tpe ? u.pm / tpe : 0; return true;
    }
    __device__ __forceinline__ void a_ready(const Unit&) const {}
    __device__ __forceinline__ void done(const Unit&) const {}
};
__device__ __forceinline__ unsigned cvt_pk_bf16(float lo, float hi) { unsigned r; asm volatile("v_cvt_pk_bf16_f32 %0, %1, %2" : "=v"(r) : "v"(lo), "v"(hi)); return r; }

struct EpiProj {
    static constexpr bool PERM = true, AFTER_DRAIN = false;
    bf16_t* O; int ldc; int nvalid;
    __device__ __forceinline__ void operator()(const f32x4 (&acc)[2][2][4][2], const Unit& u, int wr, int wc, int fr, int fq) const {
        const int row0 = u.pm * BM + wr * 64 + fr, col0 = u.pn * BM + wc * 32 + 8 * fq;
#pragma unroll
        for (int ai = 0; ai < 2; ++ai)
#pragma unroll
            for (int m = 0; m < 4; ++m) { bf16_t* rowp = O + (size_t)(row0 + ai * HALF + m * 16) * ldc + col0;
#pragma unroll
                for (int bj = 0; bj < 2; ++bj) { if (col0 + bj * HALF < nvalid) { const f32x4 v0 = acc[ai][bj][m][0], v1 = acc[ai][bj][m][1];
                    u32x4 w; w.x = cvt_pk_bf16(v0[0], v0[1]); w.y = cvt_pk_bf16(v0[2], v0[3]); w.z = cvt_pk_bf16(v1[0], v1[1]); w.w = cvt_pk_bf16(v1[2], v1[3]);
                    *(u32x4*)(rowp + bj * HALF) = w; } } }
    }
};
struct EpiResid {
    static constexpr bool PERM = false, AFTER_DRAIN = false;
    float* X; int ldc; float alpha;
    __device__ __forceinline__ void operator()(const f32x4 (&acc)[2][2][4][2], const Unit& u, int wr, int wc, int fr, int fq) const {
        const int row0 = u.pm * BM + wr * 64 + fr, col0 = u.pn * BM + wc * 32 + 4 * fq;
#pragma unroll
        for (int ai = 0; ai < 2; ++ai)
#pragma unroll
            for (int m = 0; m < 4; ++m) { float* rowp = X + (size_t)(row0 + ai * HALF + m * 16) * ldc + col0;
#pragma unroll
                for (int bj = 0; bj < 2; ++bj)
#pragma unroll
                    for (int n = 0; n < 2; ++n) { f32x4* p = (f32x4*)(rowp + bj * HALF + n * 16); const f32x4 x = *p; *p = x * alpha + acc[ai][bj][m][n]; } }
    }
};
__device__ __forceinline__ float silu_f(float g) { return g * __builtin_amdgcn_rcpf(1.0f + __builtin_amdgcn_exp2f(-1.4426950408889634f * g)); }
struct EpiSwiGLU {
    static constexpr bool PERM = true, AFTER_DRAIN = false;
    bf16_t* H; int ldc;
    __device__ __forceinline__ void operator()(const f32x4 (&acc)[2][2][4][2], const Unit& u, int wr, int wc, int fr, int fq) const {
        const int row0 = u.pm * BM + wr * 64 + fr, col0 = u.pn * HALF + wc * 32 + 8 * fq;
#pragma unroll
        for (int ai = 0; ai < 2; ++ai)
#pragma unroll
            for (int m = 0; m < 4; ++m) { bf16_t* rowp = H + (size_t)(row0 + ai * HALF + m * 16) * ldc + col0;
                const f32x4 g0 = acc[ai][0][m][0], g1 = acc[ai][0][m][1], u0 = acc[ai][1][m][0], u1 = acc[ai][1][m][1];
                float h[8];
#pragma unroll
                for (int i = 0; i < 4; ++i) { h[i] = silu_f(g0[i]) * u0[i]; h[4 + i] = silu_f(g1[i]) * u1[i]; }
                u32x4 w; w.x = cvt_pk_bf16(h[0], h[1]); w.y = cvt_pk_bf16(h[2], h[3]); w.z = cvt_pk_bf16(h[4], h[5]); w.w = cvt_pk_bf16(h[6], h[7]);
                *(u32x4*)rowp = w; }
    }
};
struct EpiGate {
    static constexpr bool PERM = true, AFTER_DRAIN = false;
    bf16_t* O; int ldc; const float* gate;
    __device__ __forceinline__ void operator()(const f32x4 (&acc)[2][2][4][2], const Unit& u, int wr, int wc, int fr, int fq) const {
        const int row0 = u.pm * BM + wr * 64 + fr, col0 = u.pn * BM + wc * 32 + 8 * fq;
#pragma unroll
        for (int ai = 0; ai < 2; ++ai)
#pragma unroll
            for (int m = 0; m < 4; ++m) { const int row = row0 + ai * HALF + m * 16; const float gt = gate[row]; bf16_t* rowp = O + (size_t)row * ldc + col0;
#pragma unroll
                for (int bj = 0; bj < 2; ++bj) { const f32x4 v0 = acc[ai][bj][m][0] * gt, v1 = acc[ai][bj][m][1] * gt;
                    u32x4 w; w.x = cvt_pk_bf16(v0[0], v0[1]); w.y = cvt_pk_bf16(v0[2], v0[3]); w.z = cvt_pk_bf16(v1[0], v1[1]); w.w = cvt_pk_bf16(v1[2], v1[3]);
                    *(u32x4*)(rowp + bj * HALF) = w; } }
    }
};

__device__ __forceinline__ unsigned cvt4_fp8(float a, float b, float c, float d) { unsigned w = 0u; w = __builtin_amdgcn_cvt_pk_fp8_f32(a, b, w, false); w = __builtin_amdgcn_cvt_pk_fp8_f32(c, d, w, true); return w; }
typedef unsigned u32x2 __attribute__((ext_vector_type(2)));
struct EpiSwiGLU8 {
    static constexpr bool PERM = true, AFTER_DRAIN = false;
    unsigned char* H; int ldc; float inv_ws;
    __device__ __forceinline__ void operator()(const f32x4 (&acc)[2][2][4][2], const Unit& u, int wr, int wc, int fr, int fq) const {
        const int row0 = u.pm * BM + wr * 64 + fr, col0 = u.pn * HALF + wc * 32 + 8 * fq;
#pragma unroll
        for (int ai = 0; ai < 2; ++ai)
#pragma unroll
            for (int m = 0; m < 4; ++m) { unsigned char* rowp = H + (size_t)(row0 + ai * HALF + m * 16) * ldc + col0;
                const f32x4 g0 = acc[ai][0][m][0] * inv_ws, g1 = acc[ai][0][m][1] * inv_ws, u0 = acc[ai][1][m][0] * inv_ws, u1 = acc[ai][1][m][1] * inv_ws;
                float h[8];
#pragma unroll
                for (int i = 0; i < 4; ++i) { h[i] = silu_f(g0[i]) * u0[i]; h[4 + i] = silu_f(g1[i]) * u1[i]; }
                u32x2 w; w.x = cvt4_fp8(h[0], h[1], h[2], h[3]); w.y = cvt4_fp8(h[4], h[5], h[6], h[7]);
                *(u32x2*)rowp = w; }
    }
};
struct EpiGate8 {
    static constexpr bool PERM = true, AFTER_DRAIN = false;
    unsigned char* O; int ldc; const float* gate; float inv_ws;
    bool nul = false;
    __device__ __forceinline__ void operator()(const f32x4 (&acc)[2][2][4][2], const Unit& u, int wr, int wc, int fr, int fq) const {
        if (nul) return;
        const int row0 = u.pm * BM + wr * 64 + fr, col0 = u.pn * BM + wc * 32 + 8 * fq;
#pragma unroll
        for (int ai = 0; ai < 2; ++ai)
#pragma unroll
            for (int m = 0; m < 4; ++m) { const int row = row0 + ai * HALF + m * 16; const float gt = gate[row] * inv_ws; unsigned char* rowp = O + (size_t)row * ldc + col0;
#pragma unroll
                for (int bj = 0; bj < 2; ++bj) { const f32x4 v0 = acc[ai][bj][m][0] * gt, v1 = acc[ai][bj][m][1] * gt;
                    u32x2 w; w.x = cvt4_fp8(v0[0], v0[1], v0[2], v0[3]); w.y = cvt4_fp8(v1[0], v1[1], v1[2], v1[3]);
                    *(u32x2*)(rowp + bj * HALF) = w; } }
    }
};
struct EpiProjS {
    static constexpr bool PERM = true, AFTER_DRAIN = false;
    bf16_t* O; int ldc; int nvalid; int colbase; float scale;
    __device__ __forceinline__ void operator()(const f32x4 (&acc)[2][2][4][2], const Unit& u, int wr, int wc, int fr, int fq) const {
        const int row0 = u.pm * BM + wr * 64 + fr, col0 = colbase + u.pn * BM + wc * 32 + 8 * fq;
#pragma unroll
        for (int ai = 0; ai < 2; ++ai)
#pragma unroll
            for (int m = 0; m < 4; ++m) { bf16_t* rowp = O + (size_t)(row0 + ai * HALF + m * 16) * ldc + col0;
#pragma unroll
                for (int bj = 0; bj < 2; ++bj) { if (col0 + bj * HALF < nvalid) { const f32x4 v0 = acc[ai][bj][m][0] * scale, v1 = acc[ai][bj][m][1] * scale;
                    u32x4 w; w.x = cvt_pk_bf16(v0[0], v0[1]); w.y = cvt_pk_bf16(v0[2], v0[3]); w.z = cvt_pk_bf16(v1[0], v1[1]); w.w = cvt_pk_bf16(v1[2], v1[3]);
                    *(u32x4*)(rowp + bj * HALF) = w; } } }
    }
};

struct EpiProjI8 {
    static constexpr bool PERM = true, AFTER_DRAIN = false;
    bf16_t* O; int ldc; int nvalid; int colbase; const float* rowscale; const float* colscale;
    __device__ __forceinline__ void operator()(const f32x4 (&acc)[2][2][4][2], const Unit& u, int wr, int wc, int fr, int fq) const {
        const int row0 = u.pm * BM + wr * 64 + fr, tcol0 = u.pn * BM + wc * 32 + 8 * fq, col0 = colbase + tcol0;
        f32x4 cs[2][2];
#pragma unroll
        for (int bj = 0; bj < 2; ++bj) { cs[bj][0] = *(const f32x4*)(colscale + tcol0 + bj * HALF); cs[bj][1] = *(const f32x4*)(colscale + tcol0 + bj * HALF + 4); }
#pragma unroll
        for (int ai = 0; ai < 2; ++ai)
#pragma unroll
            for (int m = 0; m < 4; ++m) { const int row = row0 + ai * HALF + m * 16; const float rs = rowscale[row]; bf16_t* rowp = O + (size_t)row * ldc + col0;
#pragma unroll
                for (int bj = 0; bj < 2; ++bj) { if (col0 + bj * HALF < nvalid) {
                    const i32x4_t a0 = __builtin_bit_cast(i32x4_t, acc[ai][bj][m][0]), a1 = __builtin_bit_cast(i32x4_t, acc[ai][bj][m][1]);
                    const f32x4 v0 = (f32x4){(float)a0[0], (float)a0[1], (float)a0[2], (float)a0[3]} * cs[bj][0] * rs, v1 = (f32x4){(float)a1[0], (float)a1[1], (float)a1[2], (float)a1[3]} * cs[bj][1] * rs;
                    u32x4 w; w.x = cvt_pk_bf16(v0[0], v0[1]); w.y = cvt_pk_bf16(v0[2], v0[3]); w.z = cvt_pk_bf16(v1[0], v1[1]); w.w = cvt_pk_bf16(v1[2], v1[3]);
                    *(u32x4*)(rowp + bj * HALF) = w; } } }
    }
};

struct EpiSwiGLUI8 {
    static constexpr bool PERM = true, AFTER_DRAIN = false;
    unsigned char* H; int ldc; const float* rowscale; const float* colscale;
    __device__ __forceinline__ void operator()(const f32x4 (&acc)[2][2][4][2], const Unit& u, int wr, int wc, int fr, int fq) const {
        const int row0 = u.pm * BM + wr * 64 + fr, tcol0 = u.pn * BM + wc * 32 + 8 * fq, col0 = u.pn * HALF + wc * 32 + 8 * fq;
        const float* cs = colscale + (size_t)u.e * 4096 + tcol0;
        const f32x4 cg0 = *(const f32x4*)cs, cg1 = *(const f32x4*)(cs + 4), cu0 = *(const f32x4*)(cs + HALF), cu1 = *(const f32x4*)(cs + HALF + 4);
#pragma unroll
        for (int ai = 0; ai < 2; ++ai)
#pragma unroll
            for (int m = 0; m < 4; ++m) { const int row = row0 + ai * HALF + m * 16; const float rs = rowscale[row]; unsigned char* rowp = H + (size_t)row * ldc + col0;
                const i32x4_t ig0 = __builtin_bit_cast(i32x4_t, acc[ai][0][m][0]), ig1 = __builtin_bit_cast(i32x4_t, acc[ai][0][m][1]), iu0 = __builtin_bit_cast(i32x4_t, acc[ai][1][m][0]), iu1 = __builtin_bit_cast(i32x4_t, acc[ai][1][m][1]);
                const f32x4 g0 = (f32x4){(float)ig0[0], (float)ig0[1], (float)ig0[2], (float)ig0[3]} * cg0 * rs, g1 = (f32x4){(float)ig1[0], (float)ig1[1], (float)ig1[2], (float)ig1[3]} * cg1 * rs;
                const f32x4 u0 = (f32x4){(float)iu0[0], (float)iu0[1], (float)iu0[2], (float)iu0[3]} * cu0 * rs, u1 = (f32x4){(float)iu1[0], (float)iu1[1], (float)iu1[2], (float)iu1[3]} * cu1 * rs;
                float h[8];
#pragma unroll
                for (int i = 0; i < 4; ++i) { h[i] = silu_f(g0[i]) * u0[i]; h[4 + i] = silu_f(g1[i]) * u1[i]; }
                u32x2 w; w.x = cvt4_fp8(h[0], h[1], h[2], h[3]); w.y = cvt4_fp8(h[4], h[5], h[6], h[7]);
                *(u32x2*)rowp = w; }
    }
};
template <class Epi, class Sched, bool ALIGN_EPI = false, bool SP2 = false, bool GATHER = false, bool FP8 = false, bool I8 = false>
__device__ __forceinline__ void gemm_phase(PG8_LAS unsigned char* lds, const Gemm g, const Sched& S, const Epi& E, const int* gidx = nullptr) {
    static_assert((!GATHER && !FP8) || SP2, "gathered A rows / fp8 operands: SP2 loop only");
    int tid_ = threadIdx.x; asm volatile("" : "+v"(tid_));
    const int tid = tid_, wid = __builtin_amdgcn_readfirstlane(tid >> 6), lane = tid & 63, wr = wid >> 2, wc = wid & 3, fr = lane & 15, fq = lane >> 4;
    const int K = g.K, nt = K / BK;
    unsigned voffA[2], voffB[2];
#pragma unroll
    for (int i = 0; i < 2; ++i) { int R, C; stage_rc(tid * 16 + i * 8192, R, C); const int Rb = Epi::PERM ? ((R & ~31) + perm32(R & 31)) : R;
        voffA[i] = (unsigned)(R * K + C) * 2u; voffB[i] = (unsigned)(Rb * K + C) * 2u; }
    PG8_LAS unsigned* gofs = (PG8_LAS unsigned*)(lds + STAGE_BYTES) + tid;
#define PG8_GVO(u, slot) do { _Pragma("unroll") for (int _i = 0; _i < 2; ++_i) { int R_, C_; stage_rc(tid * 16 + _i * 8192, R_, C_); \
        gofs[(((slot) * 2 + 0) * 2 + _i) * 512] = (unsigned)gidx[(u).pm * BM + R_] * (unsigned)(K * 2) + (unsigned)(C_ * 2); \
        gofs[(((slot) * 2 + 1) * 2 + _i) * 512] = (unsigned)gidx[(u).pm * BM + HALF + R_] * (unsigned)(K * 2) + (unsigned)(C_ * 2); } } while (0)
#define PG8_STAGE_A(bufoff, base, hh, slot) do { if constexpr (GATHER) { unsigned o_[2]; o_[0] = gofs[(((slot) * 2 + (hh)) * 2 + 0) * 512]; o_[1] = gofs[(((slot) * 2 + (hh)) * 2 + 1) * 512]; PG8_STAGE(bufoff, base, o_); } \
        else PG8_STAGE(bufoff, (base) + (hh) * hstep, voffA); } while (0)
    const size_t kstep = (size_t)(BK * 2);
    const size_t hstep = (size_t)HALF * K * 2;
    const size_t tstep = 2 * hstep;
    const unsigned ldsw = (unsigned)wid * 1024u;
    const int aoff = lds_byte(wr * 64 + fr, fq * 8), boff = lds_byte(wc * 32 + fr, fq * 8);
#define PG8_SA(b, h) (((b) * 2 + (h)) * HTB)
#define PG8_SB(b, h) ((4 + (b) * 2 + (h)) * HTB)
#define PG8_STAGE(bufoff, gbase, voff) do { _Pragma("unroll") for (int _i = 0; _i < 2; ++_i) \
        __builtin_amdgcn_global_load_lds((const unsigned*)((const char*)(gbase) + (voff)[_i]), (PG8_LAS unsigned*)(lds + (bufoff) + ldsw + _i * 8192), 16, 0, 0); } while (0)
#define PG8_LDA(dst, b, h) do { _Pragma("unroll") for (int m = 0; m < 4; ++m) _Pragma("unroll") for (int k = 0; k < 2; ++k) dst[m][k] = *(const PG8_LAS bf16x8*)(lds + PG8_SA(b, h) + aoff + m * 2048 + k * 1024); } while (0)
#define PG8_LDB(dst, b, h) do { _Pragma("unroll") for (int n = 0; n < 2; ++n) _Pragma("unroll") for (int k = 0; k < 2; ++k) dst[n][k] = *(const PG8_LAS bf16x8*)(lds + PG8_SB(b, h) + boff + n * 2048 + k * 1024); } while (0)
#define PG8_LDA8(dst, b, h) do { _Pragma("unroll") for (int m = 0; m < 4; ++m) dst[m] = __builtin_shufflevector(*(const PG8_LAS i32x4_t*)(lds + PG8_SA(b, h) + aoff + m * 2048), *(const PG8_LAS i32x4_t*)(lds + PG8_SA(b, h) + aoff + m * 2048 + 1024), 0, 1, 2, 3, 4, 5, 6, 7); } while (0)
#define PG8_LDB8(dst, b, h) do { _Pragma("unroll") for (int n = 0; n < 2; ++n) dst[n] = __builtin_shufflevector(*(const PG8_LAS i32x4_t*)(lds + PG8_SB(b, h) + boff + n * 2048), *(const PG8_LAS i32x4_t*)(lds + PG8_SB(b, h) + boff + n * 2048 + 1024), 0, 1, 2, 3, 4, 5, 6, 7); } while (0)
#define PG8_MMA8(ai, bj, A8, Bx8) do { _Pragma("unroll") for (int m = 0; m < 4; ++m) _Pragma("unroll") for (int n = 0; n < 2; ++n) \
        acc[ai][bj][m][n] = __builtin_amdgcn_mfma_scale_f32_16x16x128_f8f6f4(Bx8[n], A8[m], acc[ai][bj][m][n], 0, 0, 0, 0x7F7F7F7F, 0, 0x7F7F7F7F); __builtin_amdgcn_s_setprio(0); } while (0)
#define PG8_MMA(ai, bj, At, Bt) do { __builtin_amdgcn_s_setprio(1); _Pragma("unroll") for (int m = 0; m < 4; ++m) _Pragma("unroll") for (int n = 0; n < 2; ++n) _Pragma("unroll") for (int k = 0; k < 2; ++k) \
        { if constexpr (I8) acc[ai][bj][m][n] = __builtin_bit_cast(f32x4, __builtin_amdgcn_mfma_i32_16x16x64_i8(__builtin_bit_cast(i32x4_t, Bt[n][k]), __builtin_bit_cast(i32x4_t, At[m][k]), __builtin_bit_cast(i32x4_t, acc[ai][bj][m][n]), 0, 0, 0)); \
          else acc[ai][bj][m][n] = __builtin_amdgcn_mfma_f32_16x16x32_bf16(Bt[n][k], At[m][k], acc[ai][bj][m][n], 0, 0, 0); } __builtin_amdgcn_s_setprio(0); } while (0)
#define PG8_WAIT_V(n) asm volatile("s_waitcnt vmcnt(" #n ")" ::: "memory")
#define PG8_WAIT_L(n) asm volatile("s_waitcnt lgkmcnt(" #n ")" ::: "memory")
#define PG8_BAR __builtin_amdgcn_s_barrier()
#define PG8_SCHED __builtin_amdgcn_sched_barrier(0)
    Unit cur, nxt; int ui = 0;
    if (!S.next(0, cur)) return;
    f32x4 acc[2][2][4][2];
#pragma unroll
    for (int a = 0; a < 2; ++a)
#pragma unroll
        for (int b = 0; b < 2; ++b)
#pragma unroll
            for (int m = 0; m < 4; ++m)
#pragma unroll
                for (int n = 0; n < 2; ++n) acc[a][b][m][n] = (f32x4){0.f, 0.f, 0.f, 0.f};
    bf16x8 At[4][2], B0[2][2], B1[2][2];
    i32x8_t At8[4], B08[2], B18[2];
    const char* cA = GATHER ? (const char*)g.A : (const char*)g.A + (size_t)cur.pm * tstep; if constexpr (GATHER) PG8_GVO(cur, 0);
    const char* cB = (const char*)g.Bt + (size_t)cur.e * g.bstride + (size_t)cur.pn * tstep;
    S.a_ready(cur);
    if constexpr (SP2) {
        PG8_STAGE(PG8_SB(0, 0), cB, voffB); PG8_STAGE(PG8_SB(0, 1), cB + hstep, voffB); PG8_STAGE_A(PG8_SA(0, 0), cA, 0, 0); PG8_STAGE_A(PG8_SA(0, 1), cA, 1, 0);
        if (wr == 1) PG8_BAR;
        PG8_WAIT_V(2); PG8_BAR;
        PG8_STAGE(PG8_SB(1, 0), cB + kstep, voffB); PG8_STAGE_A(PG8_SA(1, 0), cA + kstep, 0, 0); PG8_STAGE(PG8_SB(1, 1), cB + hstep + kstep, voffB);
        PG8_WAIT_V(6); PG8_BAR;
    } else {
        PG8_STAGE(PG8_SB(0, 0), cB, voffB); PG8_STAGE(PG8_SA(0, 0), cA, voffA); PG8_STAGE(PG8_SB(0, 1), cB + hstep, voffB); PG8_STAGE(PG8_SA(0, 1), cA + hstep, voffA);
        if (wr == 1) PG8_BAR;
        PG8_WAIT_V(4); PG8_BAR;
        PG8_STAGE(PG8_SB(1, 0), cB + kstep, voffB); PG8_STAGE(PG8_SA(1, 0), cA + kstep, voffA); PG8_STAGE(PG8_SB(1, 1), cB + hstep + kstep, voffB);
        PG8_WAIT_V(6); PG8_BAR;
    }
    for (;;) {
        const bool has_next = S.next(ui + 1, nxt);
        const char* nA = GATHER ? cA : (has_next ? (const char*)g.A + (size_t)nxt.pm * tstep : cA);
        const int cslot = ui & 1, nslot = has_next ? (cslot ^ 1) : cslot;
        if constexpr (GATHER) { if (has_next) PG8_GVO(nxt, nslot); } const char* nB = has_next ? (const char*)g.Bt + (size_t)nxt.e * g.bstride + (size_t)nxt.pn * tstep : cB;
        for (int t = 0; t < nt; t += 2) {
            const bool last = (t == nt - 2);
            const char* a1 = cA + (size_t)(t + 1) * kstep;
            const char* a2 = last ? nA : cA + (size_t)(t + 2) * kstep; const char* b2 = last ? nB : cB + (size_t)(t + 2) * kstep;
            const char* a3 = a2 + kstep; const char* b3 = b2 + kstep;
            if (last && has_next) S.a_ready(nxt);
            const int xslot = last ? nslot : cslot;
            if constexpr (SP2) {
            if constexpr (FP8) { PG8_LDB8(B08, 0, 0); PG8_LDB8(B18, 0, 1); PG8_SCHED; PG8_LDA8(At8, 0, 0); } else { PG8_LDB(B0, 0, 0); PG8_LDB(B1, 0, 1); PG8_SCHED; PG8_LDA(At, 0, 0); } PG8_STAGE_A(PG8_SA(1, 1), a1, 1, cslot);
            PG8_WAIT_V(8); PG8_WAIT_L(0); PG8_BAR; if constexpr (FP8) { PG8_MMA8(0, 0, At8, B08); PG8_MMA8(0, 1, At8, B18); } else { PG8_MMA(0, 0, At, B0); PG8_MMA(0, 1, At, B1); } PG8_BAR; PG8_SCHED;
            if constexpr (FP8) PG8_LDA8(At8, 0, 1); else PG8_LDA(At, 0, 1); PG8_STAGE(PG8_SB(0, 0), b2, voffB); PG8_STAGE(PG8_SB(0, 1), b2 + hstep, voffB); PG8_STAGE_A(PG8_SA(0, 0), a2, 0, xslot);
            PG8_WAIT_V(8); PG8_WAIT_L(0); PG8_BAR; if constexpr (FP8) { PG8_MMA8(1, 0, At8, B08); PG8_MMA8(1, 1, At8, B18); } else { PG8_MMA(1, 0, At, B0); PG8_MMA(1, 1, At, B1); } PG8_BAR; PG8_SCHED;
            if constexpr (FP8) { PG8_LDB8(B08, 1, 0); PG8_LDB8(B18, 1, 1); PG8_SCHED; PG8_LDA8(At8, 1, 0); } else { PG8_LDB(B0, 1, 0); PG8_LDB(B1, 1, 1); PG8_SCHED; PG8_LDA(At, 1, 0); } PG8_STAGE_A(PG8_SA(0, 1), a2, 1, xslot);
            PG8_WAIT_V(8); PG8_WAIT_L(0); PG8_BAR; if constexpr (FP8) { PG8_MMA8(0, 0, At8, B08); PG8_MMA8(0, 1, At8, B18); } else { PG8_MMA(0, 0, At, B0); PG8_MMA(0, 1, At, B1); } PG8_BAR; PG8_SCHED;
            if constexpr (FP8) PG8_LDA8(At8, 1, 1); else PG8_LDA(At, 1, 1); PG8_STAGE(PG8_SB(1, 0), b3, voffB); PG8_STAGE(PG8_SB(1, 1), b3 + hstep, voffB); PG8_STAGE_A(PG8_SA(1, 0), a3, 0, xslot);
            PG8_WAIT_V(8); PG8_WAIT_L(0); PG8_BAR; if constexpr (FP8) { PG8_MMA8(1, 0, At8, B08); PG8_MMA8(1, 1, At8, B18); } else { PG8_MMA(1, 0, At, B0); PG8_MMA(1, 1, At, B1); } PG8_BAR; PG8_SCHED;
            } else {
            PG8_LDB(B0, 0, 0); PG8_SCHED; PG8_LDA(At, 0, 0); PG8_STAGE(PG8_SA(1, 1), a1 + hstep, voffA);
            PG8_WAIT_L(8); PG8_BAR; PG8_WAIT_L(0); PG8_MMA(0, 0, At, B0); PG8_BAR; PG8_SCHED;
            PG8_LDB(B1, 0, 1); PG8_STAGE(PG8_SB(0, 0), b2, voffB);
            PG8_BAR; PG8_WAIT_L(0); PG8_MMA(0, 1, At, B1); PG8_BAR;
            PG8_LDA(At, 0, 1); PG8_STAGE(PG8_SA(0, 0), a2, voffA);
            PG8_BAR; PG8_WAIT_L(0); PG8_MMA(1, 0, At, B0); PG8_BAR; PG8_SCHED;
            PG8_STAGE(PG8_SB(0, 1), b2 + hstep, voffB);
            PG8_WAIT_V(6); PG8_BAR; PG8_MMA(1, 1, At, B1); PG8_BAR;
            PG8_LDB(B0, 1, 0); PG8_SCHED; PG8_LDA(At, 1, 0); PG8_STAGE(PG8_SA(0, 1), a2 + hstep, voffA);
            PG8_WAIT_L(8); PG8_BAR; PG8_WAIT_L(0); PG8_MMA(0, 0, At, B0); PG8_BAR; PG8_SCHED;
            PG8_LDB(B1, 1, 1); PG8_STAGE(PG8_SB(1, 0), b3, voffB);
            PG8_BAR; PG8_WAIT_L(0); PG8_MMA(0, 1, At, B1); PG8_BAR;
            PG8_LDA(At, 1, 1); PG8_STAGE(PG8_SA(1, 0), a3, voffA);
            PG8_BAR; PG8_WAIT_L(0); PG8_MMA(1, 0, At, B0); PG8_BAR; PG8_SCHED;
            PG8_STAGE(PG8_SB(1, 1), b3 + hstep, voffB);
            PG8_WAIT_V(6); PG8_BAR; PG8_MMA(1, 1, At, B1); PG8_BAR;
            }
        }
        if constexpr (ALIGN_EPI) { if (wr == 0) PG8_BAR; }
        if constexpr (!Epi::AFTER_DRAIN) { E(acc, cur, wr, wc, fr, fq); S.done(cur); }
        if (!has_next) break;
#pragma unroll
        for (int a = 0; a < 2; ++a)
#pragma unroll
            for (int b = 0; b < 2; ++b)
#pragma unroll
                for (int m = 0; m < 4; ++m)
#pragma unroll
                    for (int n = 0; n < 2; ++n) acc[a][b][m][n] = (f32x4){0.f, 0.f, 0.f, 0.f};
        cur = nxt; cA = nA; cB = nB; ++ui;
        if constexpr (ALIGN_EPI) { if (wr == 1) PG8_BAR; }
    }
    PG8_WAIT_V(0);
    if constexpr (!ALIGN_EPI) { if (wr == 0) PG8_BAR; }
    PG8_BAR;
    if constexpr (Epi::AFTER_DRAIN) { E.fused(acc, cur, wr, wc, fr, fq, lds, wid, lane); S.done(cur); }
#undef PG8_SA
#undef PG8_GVO
#undef PG8_STAGE_A
#undef PG8_SB
#undef PG8_STAGE
#undef PG8_LDA
#undef PG8_LDB
#undef PG8_MMA
#undef PG8_LDA8
#undef PG8_LDB8
#undef PG8_MMA8
#undef PG8_WAIT_V
#undef PG8_WAIT_L
#undef PG8_BAR
#undef PG8_SCHED
}
}
namespace attn {
using bf16 = __hip_bfloat16;
constexpr int   D = 128, NW = 8, QBLK = 32, KVBLK = 64;
constexpr float SCALE = 0.088388347648318440f;
constexpr float THR = 8.f;
constexpr int SDEPTH = 1;
constexpr int LDQ = PP, LDK = PP, LDO = ::D;
constexpr size_t SHM_V = KVBLK * D * 2, SHM_K = KVBLK * D * 2, SHM_ATTN = 2 * SHM_V + 2 * SHM_K + NW * 64 * 4;
using bf16x8 = __attribute__((ext_vector_type(8))) short;
using s16x4  = __attribute__((ext_vector_type(4))) short;
using f32x16 = __attribute__((ext_vector_type(16))) float;
using f32x8  = __attribute__((ext_vector_type(8))) float;
using u32x4  = __attribute__((ext_vector_type(4))) unsigned;
#define KSWZ(row, colB) ((row) * 256 + ((colB) ^ (((row) & 7) << 4)))
#define SBAR() __builtin_amdgcn_sched_barrier(0)
__device__ __forceinline__ int crow(int r, int hi) { return (r & 3) + 8 * (r >> 2) + 4 * hi; }
__device__ __forceinline__ unsigned cvtpk(float lo, float hi) {
  unsigned r; asm volatile("v_cvt_pk_bf16_f32 %0, %1, %2" : "=v"(r) : "v"(lo), "v"(hi)); return r;
}
template <typename TIn> struct Stage;
template <> struct Stage<bf16>  { using T = bf16x8;
  __device__ static __forceinline__ T ld8(const bf16* p) { return *reinterpret_cast<const bf16x8*>(p); }
  __device__ static __forceinline__ bf16x8 tobf(T x) { return x; } };
template <> struct Stage<float> { using T = f32x8;
  __device__ static __forceinline__ T ld8(const float* p) { return *reinterpret_cast<const f32x8*>(p); }
  __device__ static __forceinline__ bf16x8 tobf(T x) {
    u32x4 w = {cvtpk(x[0], x[1]), cvtpk(x[2], x[3]), cvtpk(x[4], x[5]), cvtpk(x[6], x[7])}; return *reinterpret_cast<bf16x8*>(&w); } };

__device__ __forceinline__ void partialSM(f32x16& p0, f32x16& p1, float& m_reg, float& mn, float& alpha) {
  constexpr float C = SCALE * 1.4426950408889634f;
  float pmax = p0[0]; for (int r = 1; r < 16; ++r) pmax = fmaxf(pmax, p0[r]); for (int r = 0; r < 16; ++r) pmax = fmaxf(pmax, p1[r]);
  { auto rr = __builtin_amdgcn_permlane32_swap(__float_as_uint(pmax), __float_as_uint(pmax), false, false);
    pmax = fmaxf(__uint_as_float(rr[0]), __uint_as_float(rr[1])); }
  if (__builtin_expect(__all(pmax - m_reg <= THR / SCALE), 1)) { mn = m_reg; alpha = 1.f; }
  else { mn = fmaxf(m_reg, pmax); alpha = __builtin_amdgcn_exp2f((m_reg - mn) * C); m_reg = mn; }
  float mnC = -mn * C;
  for (int r = 0; r < 16; ++r) p0[r] = fmaf(p0[r], C, mnC); for (int r = 0; r < 16; ++r) p1[r] = fmaf(p1[r], C, mnC);
  for (int r = 0; r < 16; ++r) p0[r] = __builtin_amdgcn_exp2f(p0[r]);
}
__device__ __forceinline__ void finishSM(f32x16& p0, f32x16& p1, float alpha, float& l_reg, bf16x8& pa0, bf16x8& pa1, bf16x8& pa2, bf16x8& pa3) {
  for (int r = 0; r < 16; ++r) p1[r] = __builtin_amdgcn_exp2f(p1[r]);
  float ps = 0; for (int r = 0; r < 16; ++r) ps += p0[r]; for (int r = 0; r < 16; ++r) ps += p1[r];
  { auto rr = __builtin_amdgcn_permlane32_swap(__float_as_uint(ps), __float_as_uint(ps), false, false);
    ps = __uint_as_float(rr[0]) + __uint_as_float(rr[1]); }
  l_reg = l_reg * alpha + ps;
#define PK4(P, BASE, OUT) do { unsigned a0 = cvtpk(P[BASE + 0], P[BASE + 1]), a1 = cvtpk(P[BASE + 2], P[BASE + 3]);   \
    unsigned b0 = cvtpk(P[BASE + 4], P[BASE + 5]), b1 = cvtpk(P[BASE + 6], P[BASE + 7]);                              \
    auto r0 = __builtin_amdgcn_permlane32_swap(a0, b0, false, false); auto r1 = __builtin_amdgcn_permlane32_swap(a1, b1, false, false); \
    u32x4 w = {r0[0], r1[0], r0[1], r1[1]}; OUT = *reinterpret_cast<bf16x8*>(&w); } while (0)
  PK4(p0, 0, pa0); PK4(p0, 8, pa1); PK4(p1, 0, pa2); PK4(p1, 8, pa3);
#undef PK4
}
__device__ __forceinline__ void qkt(f32x16& p0, f32x16& p1, const bf16* Ks, const bf16x8* qr, int r32, int hi) {
  p0 = f32x16{}; p1 = f32x16{};
  for (int d0 = 0; d0 < 8; ++d0) { int cb = (d0 * 16 + hi * 8) * 2;
    bf16x8 b0 = *reinterpret_cast<const bf16x8*>((const char*)Ks + KSWZ(r32, cb));
    bf16x8 b1 = *reinterpret_cast<const bf16x8*>((const char*)Ks + KSWZ(32 + r32, cb));
    p0 = __builtin_amdgcn_mfma_f32_32x32x16_bf16(b0, qr[d0], p0, 0, 0, 0);
    p1 = __builtin_amdgcn_mfma_f32_32x32x16_bf16(b1, qr[d0], p1, 0, 0, 0); }
}
__device__ __forceinline__ int v_st(int k, int c) { const int kk = (k & ~0xC) | ((k & 4) << 1) | ((k & 8) >> 1); return ((kk >> 3) * 4 + (c >> 5)) * 512 + ((kk & 7) * 32 + (c & 31)) * 2; }
__device__ __forceinline__ int v_rd_base(int lane) { return ((lane & 3) << 3) | (((lane >> 2) & 3) << 6) | (((lane >> 4) & 1) << 5) | (((lane >> 5) & 1) << 8); }
constexpr int v_rd_off(int d0, int ks, int half) { return d0 * 512 + ks * 4096 + half * 2048; }
template <int OFF> __device__ __forceinline__ s16x4 tr_read(int vb) {
  s16x4 r; asm volatile("ds_read_b64_tr_b16 %0, %1 offset:%2" : "=&v"(r) : "v"(vb), "i"(OFF) : "memory"); return r;
}
template <int D0> __device__ __forceinline__ void pv_one(f32x16& od, int vb, bf16x8 pa0, bf16x8 pa1, bf16x8 pa2, bf16x8 pa3) {
  const s16x4 l0 = tr_read<v_rd_off(D0, 0, 0)>(vb), h0 = tr_read<v_rd_off(D0, 0, 1)>(vb), l1 = tr_read<v_rd_off(D0, 1, 0)>(vb), h1 = tr_read<v_rd_off(D0, 1, 1)>(vb);
  const s16x4 l2 = tr_read<v_rd_off(D0, 2, 0)>(vb), h2 = tr_read<v_rd_off(D0, 2, 1)>(vb), l3 = tr_read<v_rd_off(D0, 3, 0)>(vb), h3 = tr_read<v_rd_off(D0, 3, 1)>(vb);
  asm volatile("s_waitcnt lgkmcnt(0)" ::: "memory"); SBAR();
#define PK(L, H) (bf16x8){L[0], L[1], L[2], L[3], H[0], H[1], H[2], H[3]}
  od = __builtin_amdgcn_mfma_f32_32x32x16_bf16(pa0, PK(l0, h0), od, 0, 0, 0);
  od = __builtin_amdgcn_mfma_f32_32x32x16_bf16(pa1, PK(l1, h1), od, 0, 0, 0);
  od = __builtin_amdgcn_mfma_f32_32x32x16_bf16(pa2, PK(l2, h2), od, 0, 0, 0);
  od = __builtin_amdgcn_mfma_f32_32x32x16_bf16(pa3, PK(l3, h3), od, 0, 0, 0);
#undef PK
}
__device__ __forceinline__ void pv_d0(f32x16* o, int vb, bf16x8 pa0, bf16x8 pa1, bf16x8 pa2, bf16x8 pa3) {
  pv_one<0>(o[0], vb, pa0, pa1, pa2, pa3); pv_one<1>(o[1], vb, pa0, pa1, pa2, pa3); pv_one<2>(o[2], vb, pa0, pa1, pa2, pa3); pv_one<3>(o[3], vb, pa0, pa1, pa2, pa3);
}

using i32x8 = __attribute__((ext_vector_type(8))) int;
using i32x4 = __attribute__((ext_vector_type(4))) int;
constexpr int LDK8 = 256;
#define K8SWZ(row, colB) ((row) * 128 + ((colB) ^ ((((row) >> 1) & 7) << 4)))
__device__ __forceinline__ void qkt8(f32x16& p0, f32x16& p1, const bf16* Ks, const i32x8* qr, int r32, int hi) {
  p0 = f32x16{}; p1 = f32x16{};
#pragma unroll
  for (int d0 = 0; d0 < 2; ++d0) { const int cb = d0 * 64 + hi * 32;
    const i32x4 a0 = *reinterpret_cast<const i32x4*>((const char*)Ks + K8SWZ(r32, cb)), a1 = *reinterpret_cast<const i32x4*>((const char*)Ks + K8SWZ(r32, cb + 16));
    const i32x4 b0 = *reinterpret_cast<const i32x4*>((const char*)Ks + K8SWZ(32 + r32, cb)), b1 = *reinterpret_cast<const i32x4*>((const char*)Ks + K8SWZ(32 + r32, cb + 16));
    const i32x8 A0 = __builtin_shufflevector(a0, a1, 0, 1, 2, 3, 4, 5, 6, 7), A1 = __builtin_shufflevector(b0, b1, 0, 1, 2, 3, 4, 5, 6, 7);
    p0 = __builtin_amdgcn_mfma_scale_f32_32x32x64_f8f6f4(A0, qr[d0], p0, 0, 0, 0, 0x7F7F7F7F, 0, 0x7F7F7F7F);
    p1 = __builtin_amdgcn_mfma_scale_f32_32x32x64_f8f6f4(A1, qr[d0], p1, 0, 0, 0, 0x7F7F7F7F, 0, 0x7F7F7F7F); }
}
__device__ __forceinline__ void attn_dense_body(const bf16* __restrict__ Qb, const bf16* __restrict__ Kh, const bf16* __restrict__ Vh,
                                                bf16* __restrict__ Ob, int seq, char* lds) {
  using TQ = bf16; using St = Stage<bf16>; using SQ = Stage<TQ>;
  int tid_ = threadIdx.x; asm volatile("" : "+v"(tid_));
  const int tid = tid_, wid = tid >> 6, lane = tid & 63, r32 = lane & 31, hi = lane >> 5;
  bf16* V_lds = (bf16*)lds; bf16* K_lds = (bf16*)(lds + 2 * SHM_V);
  float* ws = (float*)(lds + 2 * SHM_V + 2 * SHM_K) + wid * 64; float* li_l = ws; float* al_l = ws + 32;
  float m_reg = -1e30f, l_reg = 0; f32x16 o[4] = {}; bf16x8 qr[8];
  const TQ* Qw = Qb + (long)(wid * QBLK + r32) * LDQ + hi * 8;
#pragma unroll
  for (int d0 = 0; d0 < 8; ++d0) qr[d0] = SQ::tobf(SQ::ld8(Qw + d0 * 16));
  const int sr = tid >> 4, sc = (tid & 15) * 8, vst0 = v_st(sr, sc), vst1 = v_st(32 + sr, sc);
  const int vb0 = (int)(uintptr_t)V_lds + v_rd_base(lane);
  struct { typename St::T vs0, vs1, ks0, ks1; } sr_[SDEPTH];
#define SLOAD(i, k0) do { sr_[i].vs0 = St::ld8(&Vh[(long)((k0) + sr) * LDK + sc]); sr_[i].vs1 = St::ld8(&Vh[(long)((k0) + 32 + sr) * LDK + sc]); \
    sr_[i].ks0 = St::ld8(&Kh[(long)((k0) + sr) * LDK + sc]); sr_[i].ks1 = St::ld8(&Kh[(long)((k0) + 32 + sr) * LDK + sc]); } while (0)
#define SWRITE(b, i) do { *(bf16x8*)((char*)V_lds + (b) * SHM_V + vst0) = St::tobf(sr_[i].vs0);          \
    *(bf16x8*)((char*)V_lds + (b) * SHM_V + vst1) = St::tobf(sr_[i].vs1); int kc = sc * 2;               \
    *(bf16x8*)((char*)K_lds + (b) * SHM_K + KSWZ(sr, kc)) = St::tobf(sr_[i].ks0);                       \
    *(bf16x8*)((char*)K_lds + (b) * SHM_K + KSWZ(32 + sr, kc)) = St::tobf(sr_[i].ks1); } while (0)
#define SWAIT() do { if constexpr (SDEPTH == 2) asm volatile("s_waitcnt vmcnt(4)" ::: "memory"); else asm volatile("s_waitcnt vmcnt(0)" ::: "memory"); } while (0)
#define RESC(a) do { if (__any((a) < 1.f)) { if (hi == 0) al_l[r32] = (a); asm volatile("s_waitcnt lgkmcnt(0)" ::: "memory"); \
    for (int d = 0; d < 4; ++d) for (int r = 0; r < 16; ++r) o[d][r] *= al_l[crow(r, hi)]; } } while (0)
  f32x16 pA0, pA1, pB0, pB1; float mnA, mnB, alA, alB; bf16x8 pa0, pa1, pa2, pa3; const int NT = seq / KVBLK;
  constexpr int SE = 0, SO = SDEPTH - 1;
  SLOAD(SE, 0); asm volatile("s_waitcnt vmcnt(0)" ::: "memory"); SWRITE(0, SE); __syncthreads();
  qkt(pA0, pA1, K_lds, qr, r32, hi); partialSM(pA0, pA1, m_reg, mnA, alA);
  SLOAD(SO, KVBLK); if constexpr (SDEPTH == 2) { if (2 < NT) SLOAD(SE, 2 * KVBLK); }
  SWAIT(); SWRITE(1, SO); __syncthreads();
  for (int j = 1; j + 1 < NT; j += 2) {
    SBAR(); qkt(pB0, pB1, (bf16*)((char*)K_lds + SHM_K), qr, r32, hi);
    finishSM(pA0, pA1, alA, l_reg, pa0, pa1, pa2, pa3); SBAR();
    SLOAD(SO, (j + SDEPTH) * KVBLK); SBAR();
    pv_d0(o, vb0, pa0, pa1, pa2, pa3); partialSM(pB0, pB1, m_reg, mnB, alB);
    __syncthreads(); SWAIT(); SWRITE(0, SE);
    RESC(alB); __syncthreads();
    SBAR(); qkt(pA0, pA1, K_lds, qr, r32, hi);
    finishSM(pB0, pB1, alB, l_reg, pa0, pa1, pa2, pa3); SBAR();
    if (SDEPTH == 1 || j + 3 < NT) SLOAD(SE, (j + 1 + SDEPTH) * KVBLK); SBAR();
    pv_d0(o, vb0 + (int)SHM_V, pa0, pa1, pa2, pa3); partialSM(pA0, pA1, m_reg, mnA, alA);
    __syncthreads(); SWAIT(); SWRITE(1, SO);
    RESC(alA); __syncthreads();
  }
  SBAR(); qkt(pB0, pB1, (bf16*)((char*)K_lds + SHM_K), qr, r32, hi);
  finishSM(pA0, pA1, alA, l_reg, pa0, pa1, pa2, pa3); SBAR();
  pv_d0(o, vb0, pa0, pa1, pa2, pa3); partialSM(pB0, pB1, m_reg, mnB, alB);
  __syncthreads(); RESC(alB);
  finishSM(pB0, pB1, alB, l_reg, pa0, pa1, pa2, pa3); SBAR();
  pv_d0(o, vb0 + (int)SHM_V, pa0, pa1, pa2, pa3);
  if (hi == 0) li_l[r32] = l_reg; asm volatile("s_waitcnt lgkmcnt(0)" ::: "memory");
  float rli[16];
#pragma unroll
  for (int r = 0; r < 16; ++r) rli[r] = __builtin_amdgcn_rcpf(li_l[crow(r, hi)]);
  bf16* Ow = Ob + (long)(wid * QBLK) * LDO;
#pragma unroll
  for (int r = 0; r < 16; ++r) { int orow = crow(r, hi);
    for (int d0 = 0; d0 < 4; ++d0) Ow[(long)orow * LDO + d0 * 32 + r32] = __float2bfloat16(o[d0][r] * rli[r]); }
  __syncthreads();
#undef SLOAD
#undef SWRITE
#undef SWAIT
#undef RESC
}

__device__ __forceinline__ void attn_dense_body8(const bf16* __restrict__ Qb, const unsigned char* __restrict__ K8h, const bf16* __restrict__ Vh,
                                                 bf16* __restrict__ Ob, int seq, char* lds) {
  using TQ = bf16; using St = Stage<bf16>; using SQ = Stage<TQ>;
  int tid_ = threadIdx.x; asm volatile("" : "+v"(tid_));
  const int tid = tid_, wid = tid >> 6, lane = tid & 63, r32 = lane & 31, hi = lane >> 5;
  bf16* V_lds = (bf16*)lds; bf16* K_lds = (bf16*)(lds + 2 * SHM_V);
  float* ws = (float*)(lds + 2 * SHM_V + 2 * SHM_K) + wid * 64; float* li_l = ws; float* al_l = ws + 32;
  float m_reg = -1e30f, l_reg = 0; f32x16 o[4] = {}; i32x8 qr[2];
  const TQ* Qw = Qb + (long)(wid * QBLK + r32) * LDQ + hi * 32;
#pragma unroll
  for (int d0 = 0; d0 < 2; ++d0) {
#pragma unroll
    for (int c = 0; c < 4; ++c) { const bf16x8 x = *reinterpret_cast<const bf16x8*>(Qw + d0 * 64 + c * 8); const unsigned* xu = reinterpret_cast<const unsigned*>(&x);
      unsigned w0 = 0u, w1 = 0u;
      w0 = __builtin_amdgcn_cvt_pk_fp8_f32(__uint_as_float(xu[0] << 16), __uint_as_float(xu[0] & 0xffff0000u), w0, false); w0 = __builtin_amdgcn_cvt_pk_fp8_f32(__uint_as_float(xu[1] << 16), __uint_as_float(xu[1] & 0xffff0000u), w0, true);
      w1 = __builtin_amdgcn_cvt_pk_fp8_f32(__uint_as_float(xu[2] << 16), __uint_as_float(xu[2] & 0xffff0000u), w1, false); w1 = __builtin_amdgcn_cvt_pk_fp8_f32(__uint_as_float(xu[3] << 16), __uint_as_float(xu[3] & 0xffff0000u), w1, true);
      qr[d0][2 * c] = (int)w0; qr[d0][2 * c + 1] = (int)w1; } }
  const int sr = tid >> 4, sc = (tid & 15) * 8, vst0 = v_st(sr, sc), vst1 = v_st(32 + sr, sc);
  const int vb0 = (int)(uintptr_t)V_lds + v_rd_base(lane);
  const int kr8 = tid >> 3, kc8 = (tid & 7) * 16;
  struct { typename St::T vs0, vs1; i32x4 k8; } sr_[SDEPTH];
#define SLOAD(i, k0) do { sr_[i].vs0 = St::ld8(&Vh[(long)((k0) + sr) * LDK + sc]); sr_[i].vs1 = St::ld8(&Vh[(long)((k0) + 32 + sr) * LDK + sc]); \
    sr_[i].k8 = *reinterpret_cast<const i32x4*>(K8h + (long)((k0) + kr8) * LDK8 + kc8); } while (0)
#define SWRITE(b, i) do { *(bf16x8*)((char*)V_lds + (b) * SHM_V + vst0) = St::tobf(sr_[i].vs0);          \
    *(bf16x8*)((char*)V_lds + (b) * SHM_V + vst1) = St::tobf(sr_[i].vs1);                                \
    *(i32x4*)((char*)K_lds + (b) * SHM_K + K8SWZ(kr8, kc8)) = sr_[i].k8; } while (0)
#define SWAIT() do { if constexpr (SDEPTH == 2) asm volatile("s_waitcnt vmcnt(4)" ::: "memory"); else asm volatile("s_waitcnt vmcnt(0)" ::: "memory"); } while (0)
#define RESC(a) do { if (__any((a) < 1.f)) { if (hi == 0) al_l[r32] = (a); asm volatile("s_waitcnt lgkmcnt(0)" ::: "memory"); \
    for (int d = 0; d < 4; ++d) for (int r = 0; r < 16; ++r) o[d][r] *= al_l[crow(r, hi)]; } } while (0)
  f32x16 pA0, pA1, pB0, pB1; float mnA, mnB, alA, alB; bf16x8 pa0, pa1, pa2, pa3; const int NT = seq / KVBLK;
  constexpr int SE = 0, SO = SDEPTH - 1;
  SLOAD(SE, 0); asm volatile("s_waitcnt vmcnt(0)" ::: "memory"); SWRITE(0, SE); __syncthreads();
  qkt8(pA0, pA1, K_lds, qr, r32, hi); partialSM(pA0, pA1, m_reg, mnA, alA);
  SLOAD(SO, KVBLK); if constexpr (SDEPTH == 2) { if (2 < NT) SLOAD(SE, 2 * KVBLK); }
  SWAIT(); SWRITE(1, SO); __syncthreads();
  for (int j = 1; j + 1 < NT; j += 2) {
    SBAR(); qkt8(pB0, pB1, (bf16*)((char*)K_lds + SHM_K), qr, r32, hi);
    finishSM(pA0, pA1, alA, l_reg, pa0, pa1, pa2, pa3); SBAR();
    SLOAD(SO, (j + SDEPTH) * KVBLK); SBAR();
    pv_d0(o, vb0, pa0, pa1, pa2, pa3); partialSM(pB0, pB1, m_reg, mnB, alB);
    __syncthreads(); SWAIT(); SWRITE(0, SE);
    RESC(alB); __syncthreads();
    SBAR(); qkt8(pA0, pA1, K_lds, qr, r32, hi);
    finishSM(pB0, pB1, alB, l_reg, pa0, pa1, pa2, pa3); SBAR();
    if (SDEPTH == 1 || j + 3 < NT) SLOAD(SE, (j + 1 + SDEPTH) * KVBLK); SBAR();
    pv_d0(o, vb0 + (int)SHM_V, pa0, pa1, pa2, pa3); partialSM(pA0, pA1, m_reg, mnA, alA);
    __syncthreads(); SWAIT(); SWRITE(1, SO);
    RESC(alA); __syncthreads();
  }
  SBAR(); qkt8(pB0, pB1, (bf16*)((char*)K_lds + SHM_K), qr, r32, hi);
  finishSM(pA0, pA1, alA, l_reg, pa0, pa1, pa2, pa3); SBAR();
  pv_d0(o, vb0, pa0, pa1, pa2, pa3); partialSM(pB0, pB1, m_reg, mnB, alB);
  __syncthreads(); RESC(alB);
  finishSM(pB0, pB1, alB, l_reg, pa0, pa1, pa2, pa3); SBAR();
  pv_d0(o, vb0 + (int)SHM_V, pa0, pa1, pa2, pa3);
  if (hi == 0) li_l[r32] = l_reg; asm volatile("s_waitcnt lgkmcnt(0)" ::: "memory");
  float rli[16];
#pragma unroll
  for (int r = 0; r < 16; ++r) rli[r] = __builtin_amdgcn_rcpf(li_l[crow(r, hi)]);
  bf16* Ow = Ob + (long)(wid * QBLK) * LDO;
#pragma unroll
  for (int r = 0; r < 16; ++r) { int orow = crow(r, hi);
    for (int d0 = 0; d0 < 4; ++d0) Ow[(long)orow * LDO + d0 * 32 + r32] = __float2bfloat16(o[d0][r] * rli[r]); }
  __syncthreads();
#undef SLOAD
#undef SWRITE
#undef SWAIT
#undef RESC
}

#define V8SWZ(row, colB) ((row) * 64 + ((colB) ^ ((((row) >> 2) & 3) << 4)))
__device__ __forceinline__ unsigned pk4_fp8(float a, float b, float c, float d) { unsigned w = 0u; w = __builtin_amdgcn_cvt_pk_fp8_f32(a, b, w, false); w = __builtin_amdgcn_cvt_pk_fp8_f32(c, d, w, true); return w; }
constexpr float PB8 = 6.f, THR8 = 2.f;
typedef float f32x2v __attribute__((ext_vector_type(2)));
__device__ __forceinline__ void partialSM8(f32x16& p0, f32x16& p1, float& m_reg, float& mn, float& alpha) {
  constexpr float C = SCALE * 1.4426950408889634f;
  float pmax = p0[0]; for (int r = 1; r < 16; ++r) pmax = fmaxf(pmax, p0[r]); for (int r = 0; r < 16; ++r) pmax = fmaxf(pmax, p1[r]);
  { auto rr = __builtin_amdgcn_permlane32_swap(__float_as_uint(pmax), __float_as_uint(pmax), false, false);
    pmax = fmaxf(__uint_as_float(rr[0]), __uint_as_float(rr[1])); }
  if (__builtin_expect(__all(pmax - m_reg <= THR8 / C), 1)) { mn = m_reg; alpha = 1.f; }
  else { mn = fmaxf(m_reg, pmax); alpha = __builtin_amdgcn_exp2f((m_reg - mn) * C); m_reg = mn; }
  const float mnC = PB8 - mn * C; const f32x2v C2 = {C, C}, M2 = {mnC, mnC};
#pragma unroll
  for (int r = 0; r < 16; r += 2) { const f32x2v a = __builtin_elementwise_fma((f32x2v){p0[r], p0[r + 1]}, C2, M2), b = __builtin_elementwise_fma((f32x2v){p1[r], p1[r + 1]}, C2, M2);
    p0[r] = a.x; p0[r + 1] = a.y; p1[r] = b.x; p1[r + 1] = b.y; }
  for (int r = 0; r < 16; ++r) p0[r] = __builtin_amdgcn_exp2f(p0[r]);
}
__device__ __forceinline__ unsigned pk4_fp8n(float a, float b, float c, float d) {
  unsigned w = __float_as_uint(a); w = __builtin_amdgcn_cvt_pk_fp8_f32(a, b, w, false); w = __builtin_amdgcn_cvt_pk_fp8_f32(c, d, w, true); return w; }
__device__ __forceinline__ void finishSM8(f32x16& p0, f32x16& p1, float alpha, float& l_reg, i32x8& P8) {
  for (int r = 0; r < 16; ++r) p1[r] = __builtin_amdgcn_exp2f(p1[r]);
  f32x2v s2 = {p0[0], p0[1]};
#pragma unroll
  for (int r = 2; r < 16; r += 2) s2 += (f32x2v){p0[r], p0[r + 1]};
#pragma unroll
  for (int r = 0; r < 16; r += 2) s2 += (f32x2v){p1[r], p1[r + 1]};
  float ps = s2.x + s2.y;
  { auto rr = __builtin_amdgcn_permlane32_swap(__float_as_uint(ps), __float_as_uint(ps), false, false);
    ps = __uint_as_float(rr[0]) + __uint_as_float(rr[1]); }
  l_reg = l_reg * alpha + ps;
#pragma unroll
  for (int k = 0; k < 4; ++k) { P8[k] = (int)pk4_fp8n(p0[4 * k], p0[4 * k + 1], p0[4 * k + 2], p0[4 * k + 3]); P8[4 + k] = (int)pk4_fp8n(p1[4 * k], p1[4 * k + 1], p1[4 * k + 2], p1[4 * k + 3]); }
}
__device__ __forceinline__ void pv8_load(i32x8* va, const char* Vs, int r32, int hi) {
#pragma unroll
  for (int db = 0; db < 4; ++db) {
    const i32x4 a0 = *reinterpret_cast<const i32x4*>(Vs + V8SWZ(32 * db + r32, 32 * hi)), a1 = *reinterpret_cast<const i32x4*>(Vs + V8SWZ(32 * db + r32, 32 * hi + 16));
    va[db] = __builtin_shufflevector(a0, a1, 0, 1, 2, 3, 4, 5, 6, 7); }
}
__device__ __forceinline__ void pv8_mma(f32x16* o, const i32x8* va, const i32x8& P8) {
#pragma unroll
  for (int db = 0; db < 4; ++db) o[db] = __builtin_amdgcn_mfma_scale_f32_32x32x64_f8f6f4(va[db], P8, o[db], 0, 0, 0, 0x7F7F7F7F, 0, 0x7F7F7F7F);
}
#define PIN16(p) do { _Pragma("unroll") for (int r_ = 0; r_ < 16; ++r_) asm volatile("" : "+v"((p)[r_])); } while (0)
#define PV_SCHED() do { __builtin_amdgcn_sched_group_barrier(0x002, 20, 0); __builtin_amdgcn_sched_group_barrier(0x008, 1, 0); __builtin_amdgcn_sched_group_barrier(0x002, 20, 0); __builtin_amdgcn_sched_group_barrier(0x008, 1, 0); \
    __builtin_amdgcn_sched_group_barrier(0x002, 20, 0); __builtin_amdgcn_sched_group_barrier(0x008, 1, 0); __builtin_amdgcn_sched_group_barrier(0x002, 6, 0); __builtin_amdgcn_sched_group_barrier(0x008, 1, 0); } while (0)
#define QK_SCHED16() do { __builtin_amdgcn_sched_group_barrier(0x100, 16, 0); __builtin_amdgcn_sched_group_barrier(0x002, 14, 0); __builtin_amdgcn_sched_group_barrier(0x008, 1, 0); __builtin_amdgcn_sched_group_barrier(0x002, 14, 0); \
    __builtin_amdgcn_sched_group_barrier(0x008, 1, 0); __builtin_amdgcn_sched_group_barrier(0x002, 14, 0); __builtin_amdgcn_sched_group_barrier(0x008, 1, 0); __builtin_amdgcn_sched_group_barrier(0x002, 14, 0); __builtin_amdgcn_sched_group_barrier(0x008, 1, 0); } while (0)
#define QK_SCHED() do { __builtin_amdgcn_sched_group_barrier(0x100, 8, 0); __builtin_amdgcn_sched_group_barrier(0x002, 14, 0); __builtin_amdgcn_sched_group_barrier(0x008, 1, 0); __builtin_amdgcn_sched_group_barrier(0x002, 14, 0); \
    __builtin_amdgcn_sched_group_barrier(0x008, 1, 0); __builtin_amdgcn_sched_group_barrier(0x002, 14, 0); __builtin_amdgcn_sched_group_barrier(0x008, 1, 0); __builtin_amdgcn_sched_group_barrier(0x002, 14, 0); __builtin_amdgcn_sched_group_barrier(0x008, 1, 0); } while (0)
__device__ __forceinline__ void attn_dense_body88(const bf16* __restrict__ Qb, const unsigned char* __restrict__ K8h, const unsigned char* __restrict__ VT8h,
                                                  bf16* __restrict__ Ob, int seq, char* lds) {
  using TQ = bf16;
  int tid_ = threadIdx.x; asm volatile("" : "+v"(tid_));
  const int tid = tid_, wid = tid >> 6, lane = tid & 63, r32 = lane & 31, hi = lane >> 5;
  char* V_lds = lds; bf16* K_lds = (bf16*)(lds + 2 * SHM_V);
  float m_reg = -1e30f, l_reg = 0; f32x16 o[4] = {}; i32x8 qr[2];
  const TQ* Qw = Qb + (long)(wid * QBLK + r32) * LDQ + hi * 32;
#pragma unroll
  for (int d0 = 0; d0 < 2; ++d0) {
#pragma unroll
    for (int c = 0; c < 4; ++c) { const bf16x8 x = *reinterpret_cast<const bf16x8*>(Qw + d0 * 64 + c * 8); const unsigned* xu = reinterpret_cast<const unsigned*>(&x);
      qr[d0][2 * c] = (int)pk4_fp8(__uint_as_float(xu[0] << 16), __uint_as_float(xu[0] & 0xffff0000u), __uint_as_float(xu[1] << 16), __uint_as_float(xu[1] & 0xffff0000u));
      qr[d0][2 * c + 1] = (int)pk4_fp8(__uint_as_float(xu[2] << 16), __uint_as_float(xu[2] & 0xffff0000u), __uint_as_float(xu[3] << 16), __uint_as_float(xu[3] & 0xffff0000u)); } }
  const int kr8 = tid >> 3, kc8 = (tid & 7) * 16;
  constexpr int SD8 = 1;
  struct { i32x4 v8, k8; } sr_[SD8];
#define SLOAD(i, k0) do { sr_[i].v8 = *reinterpret_cast<const i32x4*>(VT8h + (long)((k0) >> 6) * 8192 + tid * 16); \
    sr_[i].k8 = *reinterpret_cast<const i32x4*>(K8h + (long)((k0) + kr8) * LDK8 + kc8); } while (0)
#define SWRITE(b, i) do { *(i32x4*)(V_lds + (b) * SHM_V + V8SWZ(tid >> 2, (tid & 3) * 16)) = sr_[i].v8; \
    *(i32x4*)((char*)K_lds + (b) * SHM_K + K8SWZ(kr8, kc8)) = sr_[i].k8; } while (0)
#define SWAIT(more) do { if (SD8 == 2 && (more)) asm volatile("s_waitcnt vmcnt(2)" ::: "memory"); else asm volatile("s_waitcnt vmcnt(0)" ::: "memory"); } while (0)
#define RESC(a) do { if (__any((a) < 1.f)) { for (int d = 0; d < 4; ++d) for (int r = 0; r < 16; ++r) o[d][r] *= (a); } } while (0)
  f32x16 pA0, pA1, pB0, pB1; float mnA, mnB, alA, alB; i32x8 P8; i32x8 va[4]; const int NT = seq / KVBLK;
  constexpr int SE = 0, SO = SD8 - 1;
  SLOAD(SE, 0); asm volatile("s_waitcnt vmcnt(0)" ::: "memory"); SWRITE(0, SE); __syncthreads();
  qkt8(pA0, pA1, K_lds, qr, r32, hi); partialSM8(pA0, pA1, m_reg, mnA, alA);
  SLOAD(SO, KVBLK); if constexpr (SD8 == 2) { if (2 < NT) SLOAD(SE, 2 * KVBLK); }
  SWAIT(2 < NT); SWRITE(1, SO); __syncthreads();
  for (int j = 1; j + 1 < NT; j += 2) {
    SBAR(); qkt8(pB0, pB1, (bf16*)((char*)K_lds + SHM_K), qr, r32, hi);
    finishSM8(pA0, pA1, alA, l_reg, P8); QK_SCHED(); SBAR();
    SLOAD(SO, (j + SD8) * KVBLK); pv8_load(va, V_lds, r32, hi); SBAR();
    pv8_mma(o, va, P8); partialSM8(pB0, pB1, m_reg, mnB, alB); PIN16(pB0); PIN16(pB1); PV_SCHED(); SBAR();
    __syncthreads(); SWAIT(true); SWRITE(0, SE);
    RESC(alB); __syncthreads();
    SBAR(); qkt8(pA0, pA1, K_lds, qr, r32, hi);
    finishSM8(pB0, pB1, alB, l_reg, P8); QK_SCHED(); SBAR();
    if (SD8 == 1 || j + 3 < NT) SLOAD(SE, (j + 1 + SD8) * KVBLK); pv8_load(va, V_lds + SHM_V, r32, hi); SBAR();
    pv8_mma(o, va, P8); partialSM8(pA0, pA1, m_reg, mnA, alA); PIN16(pA0); PIN16(pA1); PV_SCHED(); SBAR();
    __syncthreads(); SWAIT(j + 3 < NT); SWRITE(1, SO);
    RESC(alA); __syncthreads();
  }
  SBAR(); qkt8(pB0, pB1, (bf16*)((char*)K_lds + SHM_K), qr, r32, hi);
  finishSM8(pA0, pA1, alA, l_reg, P8); QK_SCHED(); SBAR();
  pv8_load(va, V_lds, r32, hi); SBAR(); pv8_mma(o, va, P8); partialSM8(pB0, pB1, m_reg, mnB, alB); PIN16(pB0); PIN16(pB1); PV_SCHED(); SBAR();
  __syncthreads(); RESC(alB);
  finishSM8(pB0, pB1, alB, l_reg, P8); SBAR();
  pv8_load(va, V_lds + SHM_V, r32, hi); pv8_mma(o, va, P8);
  const float rl = __builtin_amdgcn_rcpf(l_reg);
  bf16* Ow = Ob + (long)(wid * QBLK + r32) * LDO;
#pragma unroll
  for (int db = 0; db < 4; ++db)
#pragma unroll
    for (int g = 0; g < 4; ++g) { const unsigned lo = cvtpk(o[db][4 * g] * rl, o[db][4 * g + 1] * rl), hw = cvtpk(o[db][4 * g + 2] * rl, o[db][4 * g + 3] * rl);
      *reinterpret_cast<unsigned long long*>(Ow + 32 * db + 8 * g + 4 * hi) = (unsigned long long)lo | ((unsigned long long)hw << 32); }
  __syncthreads();
#undef SLOAD
#undef SWRITE
#undef SWAIT
#undef RESC
}

__device__ __forceinline__ void attn_dense_body88p(const bf16* __restrict__ Qb, const unsigned char* __restrict__ K8h, const unsigned char* __restrict__ VT8h,
                                                  bf16* __restrict__ Ob, int seq, char* lds) {
  using TQ = bf16;
  int tid_ = threadIdx.x; asm volatile("" : "+v"(tid_));
  const int tid = tid_, wid = tid >> 6, lane = tid & 63, r32 = lane & 31, hi = lane >> 5;
  char* V_lds = lds; bf16* K_lds = (bf16*)(lds + 2 * SHM_V);
  float m_reg = -1e30f, l_reg = 0; f32x16 o[4] = {}; i32x8 qr[2];
  const TQ* Qw = Qb + (long)(wid * QBLK + r32) * LDQ + hi * 32;
#pragma unroll
  for (int d0 = 0; d0 < 2; ++d0) {
#pragma unroll
    for (int c = 0; c < 4; ++c) { const bf16x8 x = *reinterpret_cast<const bf16x8*>(Qw + d0 * 64 + c * 8); const unsigned* xu = reinterpret_cast<const unsigned*>(&x);
      qr[d0][2 * c] = (int)pk4_fp8(__uint_as_float(xu[0] << 16), __uint_as_float(xu[0] & 0xffff0000u), __uint_as_float(xu[1] << 16), __uint_as_float(xu[1] & 0xffff0000u));
      qr[d0][2 * c + 1] = (int)pk4_fp8(__uint_as_float(xu[2] << 16), __uint_as_float(xu[2] & 0xffff0000u), __uint_as_float(xu[3] << 16), __uint_as_float(xu[3] & 0xffff0000u)); } }
  const int kr8 = tid >> 3, kc8 = (tid & 7) * 16;
  struct { i32x4 v8[2], k8[2]; } sr_;
#define SLOADP(pr) do { _Pragma("unroll") for (int s_ = 0; s_ < 2; ++s_) { const long tl_ = 2 * (long)(pr) + s_; \
    sr_.v8[s_] = *reinterpret_cast<const i32x4*>(VT8h + tl_ * 8192 + tid * 16); sr_.k8[s_] = *reinterpret_cast<const i32x4*>(K8h + (tl_ * 64 + kr8) * LDK8 + kc8); } } while (0)
#define SWRITEP(b) do { _Pragma("unroll") for (int s_ = 0; s_ < 2; ++s_) { *(i32x4*)(V_lds + (b) * SHM_V + s_ * 8192 + V8SWZ(tid >> 2, (tid & 3) * 16)) = sr_.v8[s_]; \
    *(i32x4*)((char*)K_lds + (b) * SHM_K + s_ * 8192 + K8SWZ(kr8, kc8)) = sr_.k8[s_]; } } while (0)
#define RESC(a) do { if (__any((a) < 1.f)) { for (int d = 0; d < 4; ++d) for (int r = 0; r < 16; ++r) o[d][r] *= (a); } } while (0)
#define KT(b, s) ((const bf16*)((const char*)K_lds + (b) * SHM_K + (s) * 8192))
#define VT(b, s) (V_lds + (b) * SHM_V + (s) * 8192)
#define STEP(pN0, pN1, mnN, alN, pC0, pC1, alC, KP, VP) do { \
    SBAR(); qkt8(pN0, pN1, KP, qr, r32, hi); finishSM8(pC0, pC1, alC, l_reg, P8); QK_SCHED(); SBAR(); \
    pv8_load(va, VP, r32, hi); SBAR(); \
    pv8_mma(o, va, P8); partialSM8(pN0, pN1, m_reg, mnN, alN); PIN16(pN0); PIN16(pN1); PV_SCHED(); SBAR(); \
    RESC(alN); } while (0)
  f32x16 pA0, pA1, pB0, pB1; float mnA, mnB, alA, alB; i32x8 P8; i32x8 va[4]; const int NT = seq / KVBLK, NP = NT >> 1, NI = NT >> 2;
  SLOADP(0); asm volatile("s_waitcnt vmcnt(0)" ::: "memory"); SWRITEP(0); SLOADP(1); __syncthreads();
  qkt8(pA0, pA1, KT(0, 0), qr, r32, hi); partialSM8(pA0, pA1, m_reg, mnA, alA);
  SWRITEP(1); if (2 < NP) SLOADP(2);
  for (int i = 0; i + 1 < NI; ++i) {
    STEP(pB0, pB1, mnB, alB, pA0, pA1, alA, KT(0, 1), VT(0, 0));
    __syncthreads();
    STEP(pA0, pA1, mnA, alA, pB0, pB1, alB, KT(1, 0), VT(0, 1));
    __syncthreads();
    SWRITEP(0); SLOADP(2 * i + 3);
    STEP(pB0, pB1, mnB, alB, pA0, pA1, alA, KT(1, 1), VT(1, 0));
    __syncthreads();
    STEP(pA0, pA1, mnA, alA, pB0, pB1, alB, KT(0, 0), VT(1, 1));
    __syncthreads();
    SWRITEP(1); if (2 * i + 4 < NP) SLOADP(2 * i + 4);
  }
  STEP(pB0, pB1, mnB, alB, pA0, pA1, alA, KT(0, 1), VT(0, 0));
  __syncthreads();
  STEP(pA0, pA1, mnA, alA, pB0, pB1, alB, KT(1, 0), VT(0, 1));
  STEP(pB0, pB1, mnB, alB, pA0, pA1, alA, KT(1, 1), VT(1, 0));
  finishSM8(pB0, pB1, alB, l_reg, P8); SBAR();
  pv8_load(va, VT(1, 1), r32, hi); pv8_mma(o, va, P8);
  const float rl = __builtin_amdgcn_rcpf(l_reg);
  bf16* Ow = Ob + (long)(wid * QBLK + r32) * LDO;
#pragma unroll
  for (int db = 0; db < 4; ++db)
#pragma unroll
    for (int g = 0; g < 4; ++g) { const unsigned lo = cvtpk(o[db][4 * g] * rl, o[db][4 * g + 1] * rl), hw = cvtpk(o[db][4 * g + 2] * rl, o[db][4 * g + 3] * rl);
      *reinterpret_cast<unsigned long long*>(Ow + 32 * db + 8 * g + 4 * hi) = (unsigned long long)lo | ((unsigned long long)hw << 32); }
  __syncthreads();
#undef SLOADP
#undef SWRITEP
#undef RESC
#undef KT
#undef VT
#undef STEP
}

__device__ __forceinline__ void attn_dense_body88q(const bf16* __restrict__ Qb, const unsigned char* __restrict__ K8h, const unsigned char* __restrict__ VT8h,
                                                  bf16* __restrict__ Ob, int seq, char* lds) {
  using TQ = bf16;
  int tid_ = threadIdx.x; asm volatile("" : "+v"(tid_));
  const int tid = tid_, wid = tid >> 6, lane = tid & 63, r32 = lane & 31, hi = lane >> 5;
  char* V_lds = lds; bf16* K_lds = (bf16*)(lds + 2 * SHM_V);
  float m_reg = -1e30f, l_reg = 0; f32x16 o[4] = {}; i32x8 qr[2];
  const TQ* Qw = Qb + (long)(wid * QBLK + r32) * LDQ + hi * 32;
#pragma unroll
  for (int d0 = 0; d0 < 2; ++d0) {
#pragma unroll
    for (int c = 0; c < 4; ++c) { const bf16x8 x = *reinterpret_cast<const bf16x8*>(Qw + d0 * 64 + c * 8); const unsigned* xu = reinterpret_cast<const unsigned*>(&x);
      qr[d0][2 * c] = (int)pk4_fp8(__uint_as_float(xu[0] << 16), __uint_as_float(xu[0] & 0xffff0000u), __uint_as_float(xu[1] << 16), __uint_as_float(xu[1] & 0xffff0000u));
      qr[d0][2 * c + 1] = (int)pk4_fp8(__uint_as_float(xu[2] << 16), __uint_as_float(xu[2] & 0xffff0000u), __uint_as_float(xu[3] << 16), __uint_as_float(xu[3] & 0xffff0000u)); } }
  const int kr8 = tid >> 3, kc8 = (tid & 7) * 16;
  typedef __attribute__((address_space(3))) char aldsc; typedef __attribute__((address_space(3))) i32x4 aldsc_i4;
#define LDS_BASE(expr) ({ unsigned u_ = (unsigned)(uintptr_t)(aldsc*)(expr); asm volatile("" : "+v"(u_)); (aldsc*)(uintptr_t)u_; })
  aldsc* const kb00 = LDS_BASE(lds + 65536 + K8SWZ(r32, hi * 32)),      * const kb01 = LDS_BASE(lds + 65536 + K8SWZ(r32, hi * 32 + 16));
  aldsc* const kb10 = LDS_BASE(lds + 65536 + K8SWZ(r32, 64 + hi * 32)), * const kb11 = LDS_BASE(lds + 65536 + K8SWZ(r32, 64 + hi * 32 + 16));
  aldsc* const vb0 = LDS_BASE(lds + V8SWZ(r32, 32 * hi)), * const vb1 = LDS_BASE(lds + V8SWZ(r32, 32 * hi + 16));
  aldsc* const kw = LDS_BASE(lds + 65536 + K8SWZ(kr8, kc8)), * const vw = LDS_BASE(lds + V8SWZ(tid >> 2, (tid & 3) * 16));
#define LD4(p) (*(const aldsc_i4*)(p))
#define CAT8(x, y) __builtin_shufflevector(x, y, 0, 1, 2, 3, 4, 5, 6, 7)
#define QKT8Q(p0, p1, ko) do { p0 = f32x16{}; p1 = f32x16{}; \
    { const i32x8 A0 = CAT8(LD4(kb00 + (ko)), LD4(kb01 + (ko))), A1 = CAT8(LD4(kb00 + (ko) + 4096), LD4(kb01 + (ko) + 4096)); \
      p0 = __builtin_amdgcn_mfma_scale_f32_32x32x64_f8f6f4(A0, qr[0], p0, 0, 0, 0, 0x7F7F7F7F, 0, 0x7F7F7F7F); p1 = __builtin_amdgcn_mfma_scale_f32_32x32x64_f8f6f4(A1, qr[0], p1, 0, 0, 0, 0x7F7F7F7F, 0, 0x7F7F7F7F); } \
    { const i32x8 A0 = CAT8(LD4(kb10 + (ko)), LD4(kb11 + (ko))), A1 = CAT8(LD4(kb10 + (ko) + 4096), LD4(kb11 + (ko) + 4096)); \
      p0 = __builtin_amdgcn_mfma_scale_f32_32x32x64_f8f6f4(A0, qr[1], p0, 0, 0, 0, 0x7F7F7F7F, 0, 0x7F7F7F7F); p1 = __builtin_amdgcn_mfma_scale_f32_32x32x64_f8f6f4(A1, qr[1], p1, 0, 0, 0, 0x7F7F7F7F, 0, 0x7F7F7F7F); } } while (0)
#define PV8LQ(vo) do { _Pragma("unroll") for (int db_ = 0; db_ < 4; ++db_) va[db_] = CAT8(LD4(vb0 + (vo) + 2048 * db_), LD4(vb1 + (vo) + 2048 * db_)); } while (0)
  struct { i32x4 v8[2], k8[2]; } sr_;
#define SLOADH(qd, h) do { _Pragma("unroll") for (int s_ = 0; s_ < 2; ++s_) { const long tl_ = 4 * (long)(qd) + 2 * (h) + s_; \
    sr_.v8[s_] = *reinterpret_cast<const i32x4*>(VT8h + tl_ * 8192 + tid * 16); sr_.k8[s_] = *reinterpret_cast<const i32x4*>(K8h + (tl_ * 64 + kr8) * LDK8 + kc8); } } while (0)
#define SWRITEH(b, h) do { _Pragma("unroll") for (int s_ = 0; s_ < 2; ++s_) { *(aldsc_i4*)(vw + (b) * 32768 + (2 * (h) + s_) * 8192) = sr_.v8[s_]; \
    *(aldsc_i4*)(kw + (b) * 32768 + (2 * (h) + s_) * 8192) = sr_.k8[s_]; } } while (0)
#define RESC(a) do { if (__any((a) < 1.f)) { for (int d = 0; d < 4; ++d) for (int r = 0; r < 16; ++r) o[d][r] *= (a); } } while (0)
#define KT(b, s) ((b) * 32768 + (s) * 8192)
#define VT(b, s) ((b) * 32768 + (s) * 8192)
#define STEP(pN0, pN1, mnN, alN, pC0, pC1, alC, KP, VP) do { \
    SBAR(); QKT8Q(pN0, pN1, KP); finishSM8(pC0, pC1, alC, l_reg, P8); QK_SCHED(); SBAR(); \
    PV8LQ(VP); SBAR(); \
    pv8_mma(o, va, P8); partialSM8(pN0, pN1, m_reg, mnN, alN); PIN16(pN0); PIN16(pN1); PV_SCHED(); SBAR(); \
    RESC(alN); } while (0)
#define STEP_E(KP, VP) STEP(pB0, pB1, mnB, alB, pA0, pA1, alA, KP, VP)
#define STEP_O(KP, VP) STEP(pA0, pA1, mnA, alA, pB0, pB1, alB, KP, VP)
  static_assert(65536 + 2 * 32768 <= 147456, "attention quad buffers");
  f32x16 pA0, pA1, pB0, pB1; float mnA, mnB, alA, alB; i32x8 P8; i32x8 va[4]; const int NT = seq / KVBLK, NQ = NT >> 2, NI = NT >> 3;
  SLOADH(0, 0); asm volatile("s_waitcnt vmcnt(0)" ::: "memory"); SWRITEH(0, 0); SLOADH(0, 1); SWRITEH(0, 1); SLOADH(1, 0); __syncthreads();
  QKT8Q(pA0, pA1, KT(0, 0)); partialSM8(pA0, pA1, m_reg, mnA, alA);
  SWRITEH(1, 0); SLOADH(1, 1);
  for (int i = 0; i + 1 < NI; ++i) {
    STEP_E(KT(0, 1), VT(0, 0)); STEP_O(KT(0, 2), VT(0, 1));
    SWRITEH(1, 1); SLOADH(2 * i + 2, 0);
    STEP_E(KT(0, 3), VT(0, 2));
    __syncthreads();
    STEP_O(KT(1, 0), VT(0, 3));
    __syncthreads();
    SWRITEH(0, 0); SLOADH(2 * i + 2, 1);
    STEP_E(KT(1, 1), VT(1, 0)); STEP_O(KT(1, 2), VT(1, 1));
    SWRITEH(0, 1); SLOADH(2 * i + 3, 0);
    STEP_E(KT(1, 3), VT(1, 2));
    __syncthreads();
    STEP_O(KT(0, 0), VT(1, 3));
    __syncthreads();
    SWRITEH(1, 0); SLOADH(2 * i + 3, 1);
  }
  STEP_E(KT(0, 1), VT(0, 0)); STEP_O(KT(0, 2), VT(0, 1));
  SWRITEH(1, 1);
  STEP_E(KT(0, 3), VT(0, 2));
  __syncthreads();
  STEP_O(KT(1, 0), VT(0, 3));
  STEP_E(KT(1, 1), VT(1, 0)); STEP_O(KT(1, 2), VT(1, 1)); STEP_E(KT(1, 3), VT(1, 2));
  finishSM8(pB0, pB1, alB, l_reg, P8); SBAR();
  PV8LQ(VT(1, 3)); pv8_mma(o, va, P8);
  const float rl = __builtin_amdgcn_rcpf(l_reg);
  bf16* Ow = Ob + (long)(wid * QBLK + r32) * LDO;
#pragma unroll
  for (int db = 0; db < 4; ++db)
#pragma unroll
    for (int g = 0; g < 4; ++g) { const unsigned lo = cvtpk(o[db][4 * g] * rl, o[db][4 * g + 1] * rl), hw = cvtpk(o[db][4 * g + 2] * rl, o[db][4 * g + 3] * rl);
      *reinterpret_cast<unsigned long long*>(Ow + 32 * db + 8 * g + 4 * hi) = (unsigned long long)lo | ((unsigned long long)hw << 32); }
  __syncthreads();
#undef SLOADH
#undef SWRITEH
#undef LDS_BASE
#undef LD4
#undef CAT8
#undef QKT8Q
#undef PV8LQ
#undef RESC
#undef KT
#undef VT
#undef STEP
#undef STEP_E
#undef STEP_O
}

__device__ __forceinline__ void attn_dense_body88r(const bf16* __restrict__ Qb, const unsigned char* __restrict__ K8h, const unsigned char* __restrict__ VT8h,
                                                  bf16* __restrict__ Ob, int seq, char* lds) {
  using TQ = bf16;
  int tid_ = threadIdx.x; asm volatile("" : "+v"(tid_));
  const int tid = tid_, wid = tid >> 6, lane = tid & 63, r32 = lane & 31, hi = lane >> 5;
  char* V_lds = lds; bf16* K_lds = (bf16*)(lds + 2 * SHM_V);
  float m_reg = -1e30f, l_reg = 0; f32x16 o[4] = {}; i32x8 qr[2];
  const TQ* Qw = Qb + (long)(wid * QBLK + r32) * LDQ + hi * 32;
#pragma unroll
  for (int d0 = 0; d0 < 2; ++d0) {
#pragma unroll
    for (int c = 0; c < 4; ++c) { const bf16x8 x = *reinterpret_cast<const bf16x8*>(Qw + d0 * 64 + c * 8); const unsigned* xu = reinterpret_cast<const unsigned*>(&x);
      qr[d0][2 * c] = (int)pk4_fp8(__uint_as_float(xu[0] << 16), __uint_as_float(xu[0] & 0xffff0000u), __uint_as_float(xu[1] << 16), __uint_as_float(xu[1] & 0xffff0000u));
      qr[d0][2 * c + 1] = (int)pk4_fp8(__uint_as_float(xu[2] << 16), __uint_as_float(xu[2] & 0xffff0000u), __uint_as_float(xu[3] << 16), __uint_as_float(xu[3] & 0xffff0000u)); } }
  const int kr8 = tid >> 3, kc8 = (tid & 7) * 16;
  typedef __attribute__((address_space(3))) char aldsc; typedef __attribute__((address_space(3))) i32x4 aldsc_i4;
#define LDS_BASE(expr) ({ unsigned u_ = (unsigned)(uintptr_t)(aldsc*)(expr); asm volatile("" : "+v"(u_)); (aldsc*)(uintptr_t)u_; })
  aldsc* const kb00 = LDS_BASE(lds + 65536 + K8SWZ(r32, hi * 32)),      * const kb01 = LDS_BASE(lds + 65536 + K8SWZ(r32, hi * 32 + 16));
  aldsc* const kb10 = LDS_BASE(lds + 65536 + K8SWZ(r32, 64 + hi * 32)), * const kb11 = LDS_BASE(lds + 65536 + K8SWZ(r32, 64 + hi * 32 + 16));
  aldsc* const vb0 = LDS_BASE(lds + V8SWZ(r32, 32 * hi)), * const vb1 = LDS_BASE(lds + V8SWZ(r32, 32 * hi + 16));
  aldsc* const kw = LDS_BASE(lds + 65536 + K8SWZ(kr8, kc8)), * const vw = LDS_BASE(lds + V8SWZ(tid >> 2, (tid & 3) * 16));
#define LD4(p) (*(const aldsc_i4*)(p))
#define CAT8(x, y) __builtin_shufflevector(x, y, 0, 1, 2, 3, 4, 5, 6, 7)
#define QKT8Q(p0, p1, ko) do { p0 = f32x16{}; p1 = f32x16{}; \
    { const i32x8 A0 = CAT8(LD4(kb00 + (ko)), LD4(kb01 + (ko))), A1 = CAT8(LD4(kb00 + (ko) + 4096), LD4(kb01 + (ko) + 4096)); \
      p0 = __builtin_amdgcn_mfma_scale_f32_32x32x64_f8f6f4(A0, qr[0], p0, 0, 0, 0, 0x7F7F7F7F, 0, 0x7F7F7F7F); p1 = __builtin_amdgcn_mfma_scale_f32_32x32x64_f8f6f4(A1, qr[0], p1, 0, 0, 0, 0x7F7F7F7F, 0, 0x7F7F7F7F); } \
    { const i32x8 A0 = CAT8(LD4(kb10 + (ko)), LD4(kb11 + (ko))), A1 = CAT8(LD4(kb10 + (ko) + 4096), LD4(kb11 + (ko) + 4096)); \
      p0 = __builtin_amdgcn_mfma_scale_f32_32x32x64_f8f6f4(A0, qr[1], p0, 0, 0, 0, 0x7F7F7F7F, 0, 0x7F7F7F7F); p1 = __builtin_amdgcn_mfma_scale_f32_32x32x64_f8f6f4(A1, qr[1], p1, 0, 0, 0, 0x7F7F7F7F, 0, 0x7F7F7F7F); } } while (0)
#define PV8LQ(vo) do { _Pragma("unroll") for (int db_ = 0; db_ < 4; ++db_) va[db_] = CAT8(LD4(vb0 + (vo) + 2048 * db_), LD4(vb1 + (vo) + 2048 * db_)); } while (0)
  struct { i32x4 v8[2], k8[2]; } sr_;
#define SLOADH(qd, h) do { _Pragma("unroll") for (int s_ = 0; s_ < 2; ++s_) { const long tl_ = 4 * (long)(qd) + 2 * (h) + s_, tv_ = tl_ > 0 ? tl_ - 1 : 0; \
    sr_.v8[s_] = *reinterpret_cast<const i32x4*>(VT8h + tv_ * 8192 + tid * 16); sr_.k8[s_] = *reinterpret_cast<const i32x4*>(K8h + (tl_ * 64 + kr8) * LDK8 + kc8); } } while (0)
#define SWRITEH(b, h) do { _Pragma("unroll") for (int s_ = 0; s_ < 2; ++s_) { *(aldsc_i4*)(vw + (b) * 32768 + (2 * (h) + s_) * 8192) = sr_.v8[s_]; \
    *(aldsc_i4*)(kw + (b) * 32768 + (2 * (h) + s_) * 8192) = sr_.k8[s_]; } } while (0)
#define RESC(a) do { if (__any((a) < 1.f)) { for (int d = 0; d < 4; ++d) for (int r = 0; r < 16; ++r) o[d][r] *= (a); } } while (0)
#define KT(b, s) ((b) * 32768 + (s) * 8192)
#define VT(b, s) ((b) * 32768 + (s) * 8192)
#define STEP(pN0, pN1, mnN, alN, pC0, pC1, alC, KP, VP) do { \
    SBAR(); QKT8Q(pN0, pN1, KP); finishSM8(pC0, pC1, alC, l_reg, P8); QK_SCHED(); SBAR(); \
    PV8LQ(VP); SBAR(); \
    pv8_mma(o, va, P8); partialSM8(pN0, pN1, m_reg, mnN, alN); PIN16(pN0); PIN16(pN1); PV_SCHED(); SBAR(); \
    RESC(alN); } while (0)
#define STEP_E(KP, VP) STEP(pB0, pB1, mnB, alB, pA0, pA1, alA, KP, VP)
#define STEP_O(KP, VP) STEP(pA0, pA1, mnA, alA, pB0, pB1, alB, KP, VP)
  static_assert(65536 + 2 * 32768 <= 147456, "attention quad buffers");
  f32x16 pA0, pA1, pB0, pB1; float mnA, mnB, alA, alB; i32x8 P8; i32x8 va[4]; const int NT = seq / KVBLK, NQ = NT >> 2, NI = NT >> 3;
  SLOADH(0, 0); asm volatile("s_waitcnt vmcnt(0)" ::: "memory"); SWRITEH(0, 0); SLOADH(0, 1); SWRITEH(0, 1); SLOADH(1, 0); __syncthreads();
  QKT8Q(pA0, pA1, KT(0, 0)); partialSM8(pA0, pA1, m_reg, mnA, alA);
  SWRITEH(1, 0); SLOADH(1, 1);
  for (int i = 0; i + 1 < NI; ++i) {
    STEP_E(KT(0, 1), VT(0, 1));
    SWRITEH(1, 1); SLOADH(2 * i + 2, 0);
    STEP_O(KT(0, 2), VT(0, 2)); STEP_E(KT(0, 3), VT(0, 3));
    __syncthreads();
    SWRITEH(0, 0); SLOADH(2 * i + 2, 1);
    STEP_O(KT(1, 0), VT(1, 0)); STEP_E(KT(1, 1), VT(1, 1));
    SWRITEH(0, 1); SLOADH(2 * i + 3, 0);
    STEP_O(KT(1, 2), VT(1, 2)); STEP_E(KT(1, 3), VT(1, 3));
    __syncthreads();
    SWRITEH(1, 0); SLOADH(2 * i + 3, 1);
    STEP_O(KT(0, 0), VT(0, 0));
  }
  STEP_E(KT(0, 1), VT(0, 1));
  SWRITEH(1, 1); SLOADH(NQ, 0);
  STEP_O(KT(0, 2), VT(0, 2)); STEP_E(KT(0, 3), VT(0, 3));
  __syncthreads();
  SWRITEH(0, 0);
  STEP_O(KT(1, 0), VT(1, 0)); STEP_E(KT(1, 1), VT(1, 1)); STEP_O(KT(1, 2), VT(1, 2)); STEP_E(KT(1, 3), VT(1, 3));
  __syncthreads();
  finishSM8(pB0, pB1, alB, l_reg, P8); SBAR();
  PV8LQ(VT(0, 0)); pv8_mma(o, va, P8);
  const float rl = __builtin_amdgcn_rcpf(l_reg);
  bf16* Ow = Ob + (long)(wid * QBLK + r32) * LDO;
#pragma unroll
  for (int db = 0; db < 4; ++db)
#pragma unroll
    for (int g = 0; g < 4; ++g) { const unsigned lo = cvtpk(o[db][4 * g] * rl, o[db][4 * g + 1] * rl), hw = cvtpk(o[db][4 * g + 2] * rl, o[db][4 * g + 3] * rl);
      *reinterpret_cast<unsigned long long*>(Ow + 32 * db + 8 * g + 4 * hi) = (unsigned long long)lo | ((unsigned long long)hw << 32); }
  __syncthreads();
#undef SLOADH
#undef SWRITEH
#undef LDS_BASE
#undef LD4
#undef CAT8
#undef QKT8Q
#undef PV8LQ
#undef RESC
#undef KT
#undef VT
#undef STEP
#undef STEP_E
#undef STEP_O
}

}
#define GAS __attribute__((address_space(1)))
#define LAS __attribute__((address_space(3)))
typedef unsigned short bfu;
typedef unsigned v4u __attribute__((ext_vector_type(4)));
typedef float f32x4 __attribute__((ext_vector_type(4)));
typedef short bf16x8 __attribute__((ext_vector_type(8)));
typedef GAS unsigned gu32;
typedef GAS unsigned long long gu64;
#define RLX_AGENT __ATOMIC_RELAXED, __HIP_MEMORY_SCOPE_AGENT
#define LDS_WAIT() asm volatile("s_waitcnt lgkmcnt(0)" ::: "memory")
#define VM_WAIT() asm volatile("s_waitcnt vmcnt(0)" ::: "memory")
__device__ __forceinline__ unsigned long long rt() { return __builtin_amdgcn_s_memrealtime(); }
__device__ __forceinline__ unsigned f2bf(float f) { unsigned u = __builtin_bit_cast(unsigned, f); return (u + 0x7fffu + ((u >> 16) & 1u)) >> 16; }
__device__ __forceinline__ unsigned pk2(float lo, float hi) { return f2bf(lo) | (f2bf(hi) << 16); }

#define XB_TMO      128
#define XB_XCNT(j)  (256  + 64 * (j))
#define XB_XSUB(j)  (1280 + 64 * (j))
#define XB_XGEN(j)  (2304 + 64 * (j))
#define XB_TOP      3328
#define XB_TOPGEN   3392
#define XCD_BAR_WORDS 3456
#define XB_SPIN_CAP (1u << 18)

__device__ __forceinline__ unsigned xb_ld(unsigned* p)              { return __hip_atomic_load(p, __ATOMIC_RELAXED, __HIP_MEMORY_SCOPE_AGENT); }
__device__ __forceinline__ unsigned xb_add(unsigned* p, unsigned v) { return __hip_atomic_fetch_add(p, v, __ATOMIC_RELAXED, __HIP_MEMORY_SCOPE_AGENT); }
__device__ __forceinline__ unsigned xb_xcc_id() { return (unsigned)__builtin_amdgcn_s_getreg((3 << 11) | 20) & 0xFu; }
#define XB_SPIN(cond, bar) do { unsigned _sp = 0; while (cond) { __builtin_amdgcn_s_sleep(1); \
    if ((++_sp & 255u) == 0u) { if (xb_ld(&(bar)[XB_TMO])) break; if (_sp > XB_SPIN_CAP) { atomicAdd(&(bar)[XB_TMO], 1u); break; } } } } while (0)

struct XcdBarrier {
    unsigned* bar; unsigned x;
    volatile LAS unsigned* st;
};

__device__ __forceinline__ XcdBarrier xcd_barrier_post(unsigned* bar, volatile LAS unsigned* st) {
    XcdBarrier b; b.bar = bar; b.x = xb_xcc_id(); b.st = st;
    if (threadIdx.x == 0) (void)xb_add(&bar[XB_XCNT(b.x)], 1u);
    return b;
}
__device__ __forceinline__ void xcd_barrier_complete(unsigned* bar, unsigned x, unsigned& nloc, unsigned& nx) {
    const unsigned G = gridDim.x * gridDim.y * gridDim.z;
    unsigned sum, cnt, mine, sp = 0u;
    for (;;) {
        sum = 0u; cnt = 0u; mine = 0u;
#pragma unroll
        for (unsigned j = 0; j < 16; ++j) { const unsigned c = xb_ld(&bar[XB_XCNT(j)]); sum += c; cnt += (c > 0u) ? 1u : 0u; mine = (j == x) ? c : mine; }
        if (sum == G) break;
        __builtin_amdgcn_s_sleep(1);
        if ((++sp & 255u) == 0u) { if (xb_ld(&bar[XB_TMO])) break; if (sp > XB_SPIN_CAP) { atomicAdd(&bar[XB_TMO], 1u); break; } }
    }
    nloc = mine > 0u ? mine : 1u; nx = cnt > 0u ? cnt : 1u;
}

__device__ __forceinline__ void xcd_barrier(const XcdBarrier& b) {
    asm volatile("s_waitcnt vmcnt(0)" ::: "memory");
    __syncthreads();
    if (threadIdx.x == 0) {
        unsigned* bar = b.bar;
        __builtin_amdgcn_s_waitcnt(0);
        unsigned nloc = b.st[0], nx = b.st[1];
        if (nloc == 0u) { xcd_barrier_complete(bar, b.x, nloc, nx); b.st[0] = nloc; b.st[1] = nx; }
#if defined(BAR_ALL_RELEASE)
        __builtin_amdgcn_fence(__ATOMIC_RELEASE, "agent"); asm volatile("s_waitcnt vmcnt(0)" ::: "memory");
#endif
        const unsigned old = xb_add(&bar[XB_XSUB(b.x)], 1u);
        const unsigned gen = old / nloc;
        if (old + 1u == (gen + 1u) * nloc) {
            __builtin_amdgcn_fence(__ATOMIC_RELEASE, "agent");
            asm volatile("s_waitcnt vmcnt(0)" ::: "memory");
            const unsigned og = xb_add(&bar[XB_TOP], 1u);
            const unsigned tg = og / nx;
            if (og + 1u == (tg + 1u) * nx) xb_add(&bar[XB_TOPGEN], 1u);
            else XB_SPIN(xb_ld(&bar[XB_TOPGEN]) == tg, bar);
            __builtin_amdgcn_fence(__ATOMIC_ACQUIRE, "agent");
            xb_add(&bar[XB_XGEN(b.x)], 1u);
            asm volatile("s_waitcnt vmcnt(0)" ::: "memory");
        } else {
            XB_SPIN(xb_ld(&bar[XB_XGEN(b.x)]) == gen, bar);
            __builtin_amdgcn_fence(__ATOMIC_ACQUIRE, "agent");
            asm volatile("s_waitcnt vmcnt(0)" ::: "memory");
        }
    }
    __syncthreads();
}
constexpr size_t MiB = 1u << 20;
constexpr size_t WS_CTL = 0, CTL_ZERO_BYTES = 1 * MiB;
constexpr size_t WS_WIN = 2 * MiB,  WIN_L = 21 * MiB;
constexpr size_t WS_WOUT = 44 * MiB, WOUT_L = 8 * MiB;
constexpr size_t WS_WGU = 60 * MiB, WGU_E = 8 * MiB, WGU_L = 16 * WGU_E;
constexpr size_t WS_WD = 316 * MiB, WD_E = 4 * MiB, WD_L = 16 * WD_E;
constexpr size_t WS_XN8 = 444 * MiB;
constexpr size_t WS_WIN8 = 524 * MiB, WIN8_L = 7 * MiB;
constexpr size_t WS_XNI8 = 540 * MiB;
constexpr size_t WS_WINI8 = 444 * MiB, WINI8_L = 11 * MiB;
constexpr size_t WS_MIXI8 = 632 * MiB;
constexpr size_t WS_WOUTI8 = 712 * MiB, WOUTI8_L = 4 * MiB;
constexpr size_t WS_K8 = 468 * MiB;
constexpr size_t WS_VT8 = 480 * MiB;
constexpr int NCOLI = 1792;
constexpr int NCOL8 = 3584;
constexpr float WGU_SCALE = 32.f, WD_SCALE = 64.f, WIN_SCALE = 32.f, YE_SCALE = 16.f;
constexpr size_t WS_XN = 828 * MiB;
constexpr size_t WS_PROJ = 988 * MiB;
constexpr size_t WS_MIX = 1392 * MiB;
constexpr size_t WS_HID = 1552 * MiB;
constexpr size_t WS_QKT = WS_HID + 160 * MiB;
constexpr size_t WS_MISC = 1872 * MiB;
constexpr size_t WS_LSE = WS_MISC, WS_AFFT = WS_MISC + 1 * MiB, WS_SLOT = WS_MISC + 4 * MiB, WS_IDX = WS_MISC + 7 * MiB, WS_GATE = WS_MISC + 7 * MiB + 512 * 1024, WS_ADEC = WS_MISC + 8 * MiB;
constexpr size_t WS_RSC = WS_MISC + 10 * MiB, WS_CSC = WS_MISC + 11 * MiB;
constexpr size_t WS_CSCGU = WS_MISC + 9 * MiB + 256 * 1024, WS_XRS = WS_MISC + 10 * MiB + 256 * 1024;
constexpr size_t WS_RSC2 = WS_MISC + 10 * MiB + 640 * 1024, WS_CSC2 = WS_MISC + 11 * MiB + 512 * 1024;
constexpr size_t WS_END = 1884 * MiB;
static_assert(WS_WIN + 2 * WIN_L <= WS_WOUT && WS_WOUT + 2 * WOUT_L <= WS_WGU && WS_WGU + 2 * WGU_L <= WS_WD && WS_WD + 2 * WD_L <= WS_WINI8 && WS_WINI8 + 2 * WINI8_L <= WS_K8 && WS_K8 + (size_t)M * 256 <= WS_VT8 && WS_VT8 + (size_t)2 * NCHUNK * 8192 <= WS_XNI8 && WS_XNI8 + (size_t)M * D <= WS_MIXI8 && WS_MIXI8 + (size_t)M * D <= WS_WOUTI8 && WS_WOUTI8 + 2 * WOUTI8_L <= WS_XN, "ws map (weights)");
static_assert(WS_XN + (size_t)M * D * 2 <= WS_PROJ && WS_PROJ + (size_t)M * PP * 2 <= WS_MIX && WS_PROJ + (size_t)XE_ROWS * D * 2 <= WS_MIX && WS_MIX + (size_t)M * D * 2 <= WS_HID, "ws map (activations)");
static_assert(WS_HID + (size_t)XE_ROWS * DFF <= WS_MISC && WS_HID + (size_t)NCHUNK * 8 * 8192 * 4 <= WS_MISC, "ws map (hid)");
static_assert((size_t)M * 6 * 4 <= 1 * MiB && (size_t)16 * M * 4 <= 3 * MiB && (size_t)XE_ROWS * 4 <= 512 * 1024 && (size_t)NCHUNK * 8 * 64 * 4 <= 2 * MiB, "ws map (misc)");
constexpr int CW_BAR = 4096;

#ifndef MK_ONE_LAUNCH
#define MK_ONE_LAUNCH 1
#endif
#ifndef CUT_MASK
#define CUT_MASK 0u
#endif
#define MK_FIXED_RANGE (MK_ONE_LAUNCH && CUT_MASK == 0u)
constexpr int SCR_BYTES = 147456;
constexpr int LDSCTL_OFF = SCR_BYTES, MISC_OFF = LDSCTL_OFF + 320;
constexpr int LDS_BYTES = 155648;
constexpr int NWAVES = 8, NTHR = 512;

struct Frame {
    LAS unsigned char* lds; char* ldsg;
    volatile LAS unsigned* MISC;
    gu32* ctl;
    int tid, lane, wave, vcu, G, bx;
    const float* in[22];
    float* X;
    unsigned char* ws;
};
__device__ __forceinline__ float wave_sum(float v) {
#pragma unroll
    for (int o = 1; o < 64; o <<= 1) v += __shfl_xor(v, o);
    return v;
}
__device__ __forceinline__ float wave_max(float v) {
#pragma unroll
    for (int o = 1; o < 64; o <<= 1) v = fmaxf(v, __shfl_xor(v, o));
    return v;
}
__device__ __forceinline__ float bf2f(unsigned short b) { return __uint_as_float((unsigned)b << 16); }
__device__ __forceinline__ void WG_SYNC() { __syncthreads(); }

__device__ __forceinline__ void ln_norm(f32x4 (&v)[8], const float* g, const float* b, int lane) {
    float s = 0.f;
#pragma unroll
    for (int j = 0; j < 8; ++j) s += (v[j].x + v[j].y) + (v[j].z + v[j].w);
    const float mean = wave_sum(s) * (1.f / D); float s2 = 0.f;
#pragma unroll
    for (int j = 0; j < 8; ++j) { v[j] = v[j] - mean; s2 += (v[j].x * v[j].x + v[j].y * v[j].y) + (v[j].z * v[j].z + v[j].w * v[j].w); }
    const float rstd = 1.f / sqrtf(wave_sum(s2) * (1.f / D) + LN_EPS);
#pragma unroll
    for (int j = 0; j < 8; ++j) { const int o = 8 * lane + 512 * (j >> 1) + 4 * (j & 1); const f32x4 gg = *(const f32x4*)(g + o), bb = *(const f32x4*)(b + o); v[j] = v[j] * rstd * gg + bb; }
}
__device__ __forceinline__ void row_load_f32(const float* row, f32x4 (&v)[8], int lane) {
#pragma unroll
    for (int j = 0; j < 8; ++j) v[j] = *(const f32x4*)(row + 8 * lane + 512 * (j >> 1) + 4 * (j & 1));
}
__device__ __forceinline__ void row_store_f32(float* row, const f32x4 (&v)[8], int lane) {
#pragma unroll
    for (int j = 0; j < 8; ++j) *(f32x4*)(row + 8 * lane + 512 * (j >> 1) + 4 * (j & 1)) = v[j];
}
__device__ __forceinline__ void row_store_bf16(bfu* row, const f32x4 (&v)[8], int lane) {
#pragma unroll
    for (int j = 0; j < 4; ++j) { v4u w; w.x = pk2(v[2 * j].x, v[2 * j].y); w.y = pk2(v[2 * j].z, v[2 * j].w); w.z = pk2(v[2 * j + 1].x, v[2 * j + 1].y); w.w = pk2(v[2 * j + 1].z, v[2 * j + 1].w);
        *(v4u*)(row + 8 * lane + 512 * j) = w; }
}
__device__ __forceinline__ void row_store_fp8(unsigned char* row, const f32x4 (&v)[8], int lane) {
#pragma unroll
    for (int j = 0; j < 4; ++j) { pg8::u32x2 w; w.x = pg8::cvt4_fp8(v[2 * j].x, v[2 * j].y, v[2 * j].z, v[2 * j].w); w.y = pg8::cvt4_fp8(v[2 * j + 1].x, v[2 * j + 1].y, v[2 * j + 1].z, v[2 * j + 1].w);
        *(pg8::u32x2*)(row + 8 * lane + 512 * j) = w; }
}
__device__ __forceinline__ void row_add_fp8(const unsigned char* row, f32x4 (&v)[8], int lane, float scale) {
#pragma unroll
    for (int j = 0; j < 4; ++j) { const pg8::u32x2 w = *(const pg8::u32x2*)(row + 8 * lane + 512 * j);
        const pg8::f32x2 a = __builtin_amdgcn_cvt_pk_f32_fp8(w.x, false), b = __builtin_amdgcn_cvt_pk_f32_fp8(w.x, true), c = __builtin_amdgcn_cvt_pk_f32_fp8(w.y, false), d = __builtin_amdgcn_cvt_pk_f32_fp8(w.y, true);
        v[2 * j].x += a.x * scale; v[2 * j].y += a.y * scale; v[2 * j].z += b.x * scale; v[2 * j].w += b.y * scale;
        v[2 * j + 1].x += c.x * scale; v[2 * j + 1].y += c.y * scale; v[2 * j + 1].z += d.x * scale; v[2 * j + 1].w += d.y * scale; }
}
__device__ __forceinline__ void row_store_i8(unsigned char* row, float* rsc_row, const f32x4 (&v)[8], int lane) {
    float mx = 0.f;
#pragma unroll
    for (int j = 0; j < 8; ++j) mx = fmaxf(mx, fmaxf(fmaxf(fabsf(v[j].x), fabsf(v[j].y)), fmaxf(fabsf(v[j].z), fabsf(v[j].w))));
    mx = wave_max(mx); mx = fmaxf(mx, 1e-20f);
    const float inv = 127.f / mx;
    if (lane == 0) *rsc_row = mx * (1.f / 127.f);
#pragma unroll
    for (int j = 0; j < 4; ++j) { pg8::u32x2 w;
        { const int a = __float2int_rn(v[2 * j].x * inv), b = __float2int_rn(v[2 * j].y * inv), c = __float2int_rn(v[2 * j].z * inv), d = __float2int_rn(v[2 * j].w * inv);
          w.x = (unsigned)(a & 255) | ((unsigned)(b & 255) << 8) | ((unsigned)(c & 255) << 16) | ((unsigned)(d & 255) << 24); }
        { const int a = __float2int_rn(v[2 * j + 1].x * inv), b = __float2int_rn(v[2 * j + 1].y * inv), c = __float2int_rn(v[2 * j + 1].z * inv), d = __float2int_rn(v[2 * j + 1].w * inv);
          w.y = (unsigned)(a & 255) | ((unsigned)(b & 255) << 8) | ((unsigned)(c & 255) << 16) | ((unsigned)(d & 255) << 24); }
        *(pg8::u32x2*)(row + 8 * lane + 512 * j) = w; }
}
__device__ __forceinline__ void row_load_bf16(const bfu* row, f32x4 (&v)[8], int lane, float scale) {
#pragma unroll
    for (int j = 0; j < 4; ++j) { const v4u w = *(const v4u*)(row + 8 * lane + 512 * j);
        v[2 * j] = (f32x4){__uint_as_float(w.x << 16) * scale, __uint_as_float(w.x & 0xffff0000u) * scale, __uint_as_float(w.y << 16) * scale, __uint_as_float(w.y & 0xffff0000u) * scale};
        v[2 * j + 1] = (f32x4){__uint_as_float(w.z << 16) * scale, __uint_as_float(w.z & 0xffff0000u) * scale, __uint_as_float(w.w << 16) * scale, __uint_as_float(w.w & 0xffff0000u) * scale}; }
}
__device__ __forceinline__ void row_add_bf16(const bfu* row, f32x4 (&v)[8], int lane) {
#pragma unroll
    for (int j = 0; j < 4; ++j) { const v4u w = *(const v4u*)(row + 8 * lane + 512 * j);
        v[2 * j].x += __uint_as_float(w.x << 16); v[2 * j].y += __uint_as_float(w.x & 0xffff0000u); v[2 * j].z += __uint_as_float(w.y << 16); v[2 * j].w += __uint_as_float(w.y & 0xffff0000u);
        v[2 * j + 1].x += __uint_as_float(w.z << 16); v[2 * j + 1].y += __uint_as_float(w.z & 0xffff0000u); v[2 * j + 1].z += __uint_as_float(w.w << 16); v[2 * j + 1].w += __uint_as_float(w.w & 0xffff0000u); }
}

__device__ __forceinline__ void p0_transpose_item(const float* W, int K, int N, bfu* WT, int k0, int n0, int dst_row0, LAS float* scr, int lane) {
#pragma unroll 8
    for (int i = 0; i < 32; ++i) { const int kk = 2 * i + (lane >> 5); scr[kk * 33 + (lane & 31)] = W[(size_t)(k0 + kk) * N + n0 + (lane & 31)]; }
    LDS_WAIT(); asm volatile("" ::: "memory");
    const int c = lane & 7;
#pragma unroll
    for (int j = 0; j < 4; ++j) { const int n = (lane >> 3) + 8 * j; const LAS float* s = scr + (8 * c) * 33 + n;
        v4u o; o.x = pk2(s[0 * 33], s[1 * 33]); o.y = pk2(s[2 * 33], s[3 * 33]); o.z = pk2(s[4 * 33], s[5 * 33]); o.w = pk2(s[6 * 33], s[7 * 33]);
        *(GAS v4u*)(WT + (size_t)(dst_row0 + n) * K + k0 + 8 * c) = o; }
    LDS_WAIT(); asm volatile("" ::: "memory");
}
__device__ __forceinline__ void p0_transpose_item_fp8(const float* W, int K, int N, unsigned char* WT, int k0, int n0, int dst_row0, float wscale, LAS float* scr, int lane) {
#pragma unroll 8
    for (int i = 0; i < 32; ++i) { const int kk = 2 * i + (lane >> 5); scr[kk * 33 + (lane & 31)] = W[(size_t)(k0 + kk) * N + n0 + (lane & 31)]; }
    LDS_WAIT(); asm volatile("" ::: "memory");
#pragma unroll
    for (int j = 0; j < 2; ++j) { const int c = lane + 64 * j, n = c >> 2, kq = (c & 3) * 16; const LAS float* sp = scr + kq * 33 + n;
        v4u o;
        { unsigned w = 0u; w = __builtin_amdgcn_cvt_pk_fp8_f32(sp[0 * 33] * wscale, sp[1 * 33] * wscale, w, false); w = __builtin_amdgcn_cvt_pk_fp8_f32(sp[2 * 33] * wscale, sp[3 * 33] * wscale, w, true); o.x = w; }
        { unsigned w = 0u; w = __builtin_amdgcn_cvt_pk_fp8_f32(sp[4 * 33] * wscale, sp[5 * 33] * wscale, w, false); w = __builtin_amdgcn_cvt_pk_fp8_f32(sp[6 * 33] * wscale, sp[7 * 33] * wscale, w, true); o.y = w; }
        { unsigned w = 0u; w = __builtin_amdgcn_cvt_pk_fp8_f32(sp[8 * 33] * wscale, sp[9 * 33] * wscale, w, false); w = __builtin_amdgcn_cvt_pk_fp8_f32(sp[10 * 33] * wscale, sp[11 * 33] * wscale, w, true); o.z = w; }
        { unsigned w = 0u; w = __builtin_amdgcn_cvt_pk_fp8_f32(sp[12 * 33] * wscale, sp[13 * 33] * wscale, w, false); w = __builtin_amdgcn_cvt_pk_fp8_f32(sp[14 * 33] * wscale, sp[15 * 33] * wscale, w, true); o.w = w; }
        *(GAS v4u*)(WT + (size_t)(dst_row0 + n) * K + k0 + kq) = o; }
    LDS_WAIT(); asm volatile("" ::: "memory");
}
constexpr int CONV_E_ITEMS = 3 * NEXP * 2048;
constexpr int CONV_QW = 14336;
__device__ __forceinline__ void conv_expert_item(Frame& F, int l, int idx, LAS float* scr) {
    const int which = idx / (NEXP * 2048); int r = idx % (NEXP * 2048);
    const int e = r / 2048; r %= 2048; const int kb = r / 64, nb = r % 64, n0 = 32 * nb;
    const size_t woff = ((size_t)l * NEXP + e) * (size_t)D * DFF;
    if (which == 0)      p0_transpose_item_fp8(F.in[17] + woff, D, DFF, F.ws + WS_WGU + l * WGU_L + e * WGU_E, 64 * kb, n0, (n0 >> 7) * 256 + (n0 & 127), WGU_SCALE, scr, F.lane);
    else if (which == 1) p0_transpose_item_fp8(F.in[18] + woff, D, DFF, F.ws + WS_WGU + l * WGU_L + e * WGU_E, 64 * kb, n0, (n0 >> 7) * 256 + 128 + (n0 & 127), WGU_SCALE, scr, F.lane);
    else                 p0_transpose_item_fp8(F.in[19] + woff, DFF, D, F.ws + WS_WD + l * WD_L + e * WD_E, 64 * kb, n0, n0, WD_SCALE, scr, F.lane);
}
__device__ __forceinline__ void conv_i8_block(Frame& F, const float* W, int ldw, int n0, bool valid, unsigned char* WT, int drow0, float* csc) {
    float* red = (float*)(F.ldsg + 8 * 16384);
    const int tid = F.tid, lane = F.lane, wave = F.wave;
    if (!valid) {
        for (int i = tid; i < 32 * D / 16; i += NTHR) *(GAS v4u*)(WT + (size_t)drow0 * D + (size_t)i * 16) = (v4u){0u, 0u, 0u, 0u};
        if (tid < 32) csc[tid] = 0.f;
        return; }
    f32x4 t[4][8];
#pragma unroll
    for (int j = 0; j < 4; ++j)
#pragma unroll
        for (int i = 0; i < 8; ++i) t[j][i] = __builtin_nontemporal_load((const f32x4*)(W + (size_t)(64 * (wave + 8 * j) + (lane >> 3) + 8 * i) * ldw + n0 + (lane & 7) * 4));
    f32x4 mx = {0.f, 0.f, 0.f, 0.f};
#pragma unroll
    for (int j = 0; j < 4; ++j)
#pragma unroll
        for (int i = 0; i < 8; ++i) { mx.x = fmaxf(mx.x, fabsf(t[j][i].x)); mx.y = fmaxf(mx.y, fabsf(t[j][i].y)); mx.z = fmaxf(mx.z, fabsf(t[j][i].z)); mx.w = fmaxf(mx.w, fabsf(t[j][i].w)); }
#pragma unroll
    for (int o = 8; o < 64; o <<= 1) { mx.x = fmaxf(mx.x, __shfl_xor(mx.x, o)); mx.y = fmaxf(mx.y, __shfl_xor(mx.y, o)); mx.z = fmaxf(mx.z, __shfl_xor(mx.z, o)); mx.w = fmaxf(mx.w, __shfl_xor(mx.w, o)); }
    WG_SYNC();
    if (lane < 8) { float* r_ = red + wave * 32 + lane * 4; r_[0] = mx.x; r_[1] = mx.y; r_[2] = mx.z; r_[3] = mx.w; }
    WG_SYNC();
    if (tid < 32) { float m = 1e-30f;
#pragma unroll
        for (int q = 0; q < 8; ++q) m = fmaxf(m, red[q * 32 + tid]);
        csc[tid] = m * (1.f / 127.f); red[256 + tid] = 127.f / m; }
    WG_SYNC();
    LAS float* scr = (LAS float*)(F.lds + wave * 16384);
#pragma unroll
    for (int j = 0; j < 4; ++j) { const int k0 = 64 * (wave + 8 * j);
#pragma unroll
        for (int i = 0; i < 8; ++i) { LAS float* d_ = scr + ((lane >> 3) + 8 * i) * 33 + (lane & 7) * 4; d_[0] = t[j][i].x; d_[1] = t[j][i].y; d_[2] = t[j][i].z; d_[3] = t[j][i].w; }
        LDS_WAIT(); asm volatile("" ::: "memory");
#pragma unroll
        for (int jj = 0; jj < 2; ++jj) { const int c = lane + 64 * jj, n = c >> 2, kqq = (c & 3) * 16; const LAS float* sp = scr + kqq * 33 + n; const float inv = red[256 + n];
            v4u o; unsigned* ou = (unsigned*)&o;
#pragma unroll
            for (int g = 0; g < 4; ++g) { const int a = __float2int_rn(sp[(4 * g) * 33] * inv), b = __float2int_rn(sp[(4 * g + 1) * 33] * inv), cc = __float2int_rn(sp[(4 * g + 2) * 33] * inv), d = __float2int_rn(sp[(4 * g + 3) * 33] * inv);
                ou[g] = (unsigned)(a & 255) | ((unsigned)(b & 255) << 8) | ((unsigned)(cc & 255) << 16) | ((unsigned)(d & 255) << 24); }
            *(GAS v4u*)(WT + (size_t)(drow0 + n) * D + k0 + kqq) = o; }
        LDS_WAIT(); asm volatile("" ::: "memory");
    }
}
struct ConvSrc { const float* W; unsigned char* WT; int K, N, k0, n0, drow; float sc; };
__device__ __forceinline__ ConvSrc conv_decode(Frame& F, int l, int idx) {
    const int which = idx / (NEXP * 2048); int r = idx % (NEXP * 2048);
    const int e = r / 2048; r %= 2048; const int kb = r / 64, nb = r % 64, n0 = 32 * nb;
    const size_t woff = ((size_t)l * NEXP + e) * (size_t)D * DFF;
    ConvSrc c; c.K = which == 2 ? DFF : D; c.N = which == 2 ? D : DFF; c.k0 = 64 * kb; c.n0 = n0;
    const float* wg_ = F.in[17]; const float* wu_ = F.in[18]; const float* wd_ = F.in[19];
    asm volatile("" : "+s"(wg_), "+s"(wu_), "+s"(wd_));
    c.W = (which == 0 ? wg_ : which == 1 ? wu_ : wd_) + woff;
    c.WT = which == 2 ? F.ws + WS_WD + l * WD_L + e * WD_E : F.ws + WS_WGU + l * WGU_L + e * WGU_E;
    c.drow = which == 2 ? n0 : (n0 >> 7) * 256 + (which == 1 ? 128 : 0) + (n0 & 127); c.sc = which == 2 ? WD_SCALE : WGU_SCALE;
    return c;
}
__device__ __forceinline__ void conv_load(const ConvSrc& c, f32x4 (&t)[8], int lane) {
#pragma unroll
    for (int i = 0; i < 8; ++i) t[i] = __builtin_nontemporal_load((const f32x4*)(c.W + (size_t)(c.k0 + (lane >> 3) + 8 * i) * c.N + c.n0 + (lane & 7) * 4));
}
__device__ __forceinline__ void conv_finish(const ConvSrc& c, const f32x4 (&t)[8], LAS float* scr, int lane) {
#pragma unroll
    for (int i = 0; i < 8; ++i) { LAS float* d_ = scr + ((lane >> 3) + 8 * i) * 33 + (lane & 7) * 4; d_[0] = t[i].x; d_[1] = t[i].y; d_[2] = t[i].z; d_[3] = t[i].w; }
    LDS_WAIT(); asm volatile("" ::: "memory");
#pragma unroll
    for (int j = 0; j < 2; ++j) { const int cc = lane + 64 * j, n = cc >> 2, kq = (cc & 3) * 16; const LAS float* sp = scr + kq * 33 + n; const float ws_ = c.sc;
        v4u o;
        { unsigned w = 0u; w = __builtin_amdgcn_cvt_pk_fp8_f32(sp[0 * 33] * ws_, sp[1 * 33] * ws_, w, false); w = __builtin_amdgcn_cvt_pk_fp8_f32(sp[2 * 33] * ws_, sp[3 * 33] * ws_, w, true); o.x = w; }
        { unsigned w = 0u; w = __builtin_amdgcn_cvt_pk_fp8_f32(sp[4 * 33] * ws_, sp[5 * 33] * ws_, w, false); w = __builtin_amdgcn_cvt_pk_fp8_f32(sp[6 * 33] * ws_, sp[7 * 33] * ws_, w, true); o.y = w; }
        { unsigned w = 0u; w = __builtin_amdgcn_cvt_pk_fp8_f32(sp[8 * 33] * ws_, sp[9 * 33] * ws_, w, false); w = __builtin_amdgcn_cvt_pk_fp8_f32(sp[10 * 33] * ws_, sp[11 * 33] * ws_, w, true); o.z = w; }
        { unsigned w = 0u; w = __builtin_amdgcn_cvt_pk_fp8_f32(sp[12 * 33] * ws_, sp[13 * 33] * ws_, w, false); w = __builtin_amdgcn_cvt_pk_fp8_f32(sp[14 * 33] * ws_, sp[15 * 33] * ws_, w, true); o.w = w; }
        *(GAS v4u*)(c.WT + (size_t)(c.drow + n) * c.K + c.k0 + kq) = o; }
    LDS_WAIT(); asm volatile("" ::: "memory");
}
__device__ __forceinline__ void conv_gu_block(Frame& F, int b) {
    const int l = b >> 11, e = (b >> 7) & 15, which = (b >> 6) & 1, nbk = b & 63, n0 = 32 * nbk;
    const size_t woff = ((size_t)l * NEXP + e) * (size_t)D * DFF;
    const float* wg_ = F.in[17]; const float* wu_ = F.in[18];
    asm volatile("" : "+s"(wg_), "+s"(wu_));
    const int drow0 = (n0 >> 7) * 256 + (which ? 128 : 0) + (n0 & 127);
    conv_i8_block(F, (which ? wu_ : wg_) + woff, DFF, n0, true, F.ws + WS_WGU + l * WGU_L + e * WGU_E, drow0, (float*)(F.ws + WS_CSCGU) + ((size_t)l * NEXP + e) * 4096 + drow0);
}
constexpr int CONV_GU_BLOCKS = DEPTH * NEXP * 128;
constexpr int WIN_BLOCKS = 896;
constexpr int DOWN_ITEMS = NEXP * 2048;
constexpr int NCONV = 96;
constexpr int CONV_TOTAL = 2 * DOWN_ITEMS;
__device__ __forceinline__ void conv_window(Frame& F, int w, int rank, int nrank) {
    LAS float* scr = (LAS float*)(F.lds + F.wave * 16384);
    (void)scr;
    for (int bk = w * WIN_BLOCKS + rank; bk < (w + 1) * WIN_BLOCKS; bk += nrank) conv_gu_block(F, CONV_GU_BLOCKS / 2 + bk);
}
__device__ __forceinline__ void conv_worker(Frame& F, int rank, int nrank) {
    constexpr int NB_W = CONV_GU_BLOCKS / 2 + (CONV_GU_BLOCKS / 2 - 2 * WIN_BLOCKS);
    for (int i = rank; i < NB_W; i += nrank) conv_gu_block(F, i < CONV_GU_BLOCKS / 2 ? i : i + 2 * WIN_BLOCKS);
    LAS float* scr = (LAS float*)(F.lds + F.wave * 16384);
    const int stride = nrank * NWAVES; int it = rank * NWAVES + F.wave;
    if (it >= CONV_TOTAL) return;
#define CONV_DEC(ix) conv_decode(F, (ix) < DOWN_ITEMS ? 0 : 1, 2 * NEXP * 2048 + ((ix) < DOWN_ITEMS ? (ix) : (ix) - DOWN_ITEMS))
    ConvSrc c = CONV_DEC(it);
    f32x4 t[8]; conv_load(c, t, F.lane);
    for (;;) {
        const int nx = it + stride; const bool more = nx < CONV_TOTAL; const int ny = more ? nx : it;
        const ConvSrc cn = CONV_DEC(ny);
        f32x4 tn[8]; conv_load(cn, tn, F.lane);
        conv_finish(c, t, scr, F.lane);
        if (!more) break;
        c = cn; it = nx;
#pragma unroll
        for (int i = 0; i < 8; ++i) t[i] = tn[i];
    }
#undef CONV_DEC
}
__device__ __forceinline__ void p0_prologue(Frame& F) {
    { constexpr int NB_IN = DIN_PAD / 32, NB_OUT = D / 32, NB_L = NB_IN + NB_OUT;
      for (int it = F.vcu; it < DEPTH * NB_L; it += F.G) { const int l = it / NB_L, r = it % NB_L;
          const bool isin = r < NB_IN; const int nb = isin ? r : r - NB_IN, n0 = 32 * nb;
          const float* win_ = F.in[5]; const float* wout_ = F.in[13]; asm volatile("" : "+s"(win_), "+s"(wout_));
          conv_i8_block(F, isin ? win_ + (size_t)l * D * DIN : wout_ + (size_t)l * D * D, isin ? DIN : D, n0, isin ? n0 < DIN : true,
                        isin ? F.ws + WS_WINI8 + l * WINI8_L : F.ws + WS_WOUTI8 + l * WOUTI8_L, 32 * nb, isin ? (float*)(F.ws + WS_CSC) + l * DIN_PAD + 32 * nb : (float*)(F.ws + WS_CSC2) + l * D + 32 * nb); } }
    LAS float* scr = (LAS float*)(F.lds + F.wave * 16384);
    const int gw = F.vcu * NWAVES + F.wave, NGW = F.G * NWAVES;
    constexpr int I_IN = 32 * (DIN / 32), I_OUT = 32 * 64;
    constexpr int E1_FIRST = 2 * CONV_QW;
    const bool conv_later = F.G > 2 * NCONV;
    if (!conv_later) { for (int bk = F.vcu; bk < CONV_GU_BLOCKS; bk += F.G) conv_gu_block(F, bk); }
    const int PER_L0 = I_IN + I_OUT + (conv_later ? 0 : DOWN_ITEMS), PER_L1 = I_IN + I_OUT + (conv_later ? 0 : DOWN_ITEMS), NITEMS = PER_L0 + PER_L1;
    for (int it = gw; it < NITEMS; it += NGW) {
        const int l = it < PER_L0 ? 0 : 1; int r = it - l * PER_L0;
        if (r < I_IN) continue;
        r -= I_IN;
        if (r < I_OUT) continue;
        r -= I_OUT;
        conv_expert_item(F, l, 2 * NEXP * 2048 + r, scr);
    }
    { const int gt = F.vcu * NTHR + F.tid, NGT = F.G * NTHR; constexpr int PADV = (DIN_PAD - DIN) * D * 2 / 16;
      for (int i = gt; i < DEPTH * PADV; i += NGT) { const int l = i / PADV, j = i % PADV; *(GAS v4u*)(F.ws + WS_WIN + l * WIN_L + (size_t)DIN * D * 2 + (size_t)j * 16) = (v4u){0u, 0u, 0u, 0u}; } }
    f32x4 pv[8];
#pragma unroll
    for (int j = 0; j < 8; ++j) pv[j] = (f32x4){0.f, 0.f, 0.f, 0.f};
    if (gw < M) row_load_f32(gw < TP ? F.in[0] + (size_t)gw * D : F.in[1] + (size_t)(gw - TP) * D, pv, F.lane);
    for (int m = gw; m < M; m += NGW) {
        f32x4 v[8];
#pragma unroll
        for (int j = 0; j < 8; ++j) v[j] = pv[j];
        if (m + NGW < M) { const int mn = m + NGW; row_load_f32(mn < TP ? F.in[0] + (size_t)mn * D : F.in[1] + (size_t)(mn - TP) * D, pv, F.lane); }
        ln_norm(v, F.in[2], F.in[3], F.lane);
        row_store_bf16((bfu*)(F.ws + WS_XN) + (size_t)m * D, v, F.lane);
        row_store_i8(F.ws + WS_XNI8 + (size_t)m * D, (float*)(F.ws + WS_RSC) + m, v, F.lane);
    }
}

__device__ __forceinline__ void qk_prep(Frame& F, int l) {
    const int gw = F.vcu * NWAVES + F.wave, NGW = F.G * NWAVES, lane = F.lane;
    const int hh = lane >> 3, sub = lane & 7, half = sub >> 2, a1 = 64 * half + 8 * (sub & 3);
    const float* gn = (hh < 6 ? F.in[6] : F.in[7]) + l * 128;
    float g1[8], g2[8], inv[8];
#pragma unroll
    for (int c = 0; c < 8; ++c) { g1[c] = gn[a1 + c]; g2[c] = gn[a1 + 32 + c]; inv[c] = exp2f(-(float)(2 * (8 * (sub & 3) + c)) * (13.287712379549449f / 64.f)) * 0.15915494309189535f; }
    bfu* P = (bfu*)(F.ws + WS_PROJ);
    const int coff = (hh < 6 ? C_AQ + hh * 128 : C_AK + (hh - 6) * 128) + a1;
    v4u w1 = {0u, 0u, 0u, 0u}, w2 = {0u, 0u, 0u, 0u};
    if (gw < M) { const bfu* p = P + (size_t)gw * PP + coff; w1 = *(const v4u*)p; w2 = *(const v4u*)(p + 32); }
    for (int m = gw; m < M; m += NGW) {
        const v4u c1 = w1, c2 = w2;
        if (m + NGW < M) { const bfu* p = P + (size_t)(m + NGW) * PP + coff; w1 = *(const v4u*)p; w2 = *(const v4u*)(p + 32); }
        const int t = m < TP ? m : (m - TP) % TS;
        const float pos = (float)(half == 0 ? (t >> 6) : (t & 63));
        float x1[8], x2[8]; float ss = 0.f;
        const unsigned* u1 = (const unsigned*)&c1; const unsigned* u2 = (const unsigned*)&c2;
#pragma unroll
        for (int k = 0; k < 4; ++k) { x1[2 * k] = __uint_as_float(u1[k] << 16); x1[2 * k + 1] = __uint_as_float(u1[k] & 0xffff0000u); x2[2 * k] = __uint_as_float(u2[k] << 16); x2[2 * k + 1] = __uint_as_float(u2[k] & 0xffff0000u); }
#pragma unroll
        for (int c = 0; c < 8; ++c) ss += x1[c] * x1[c] + x2[c] * x2[c];
        ss += __shfl_xor(ss, 1); ss += __shfl_xor(ss, 2); ss += __shfl_xor(ss, 4);
        const float rstd = 1.f / sqrtf(ss * (1.f / 128.f) + RMS_EPS);
        float o1[8], o2[8];
#pragma unroll
        for (int c = 0; c < 8; ++c) { const float rev = pos * inv[c]; const float cs = __builtin_amdgcn_cosf(rev), sn = __builtin_amdgcn_sinf(rev);
            const float n1 = x1[c] * rstd * g1[c], n2 = x2[c] * rstd * g2[c]; o1[c] = n1 * cs - n2 * sn; o2[c] = n1 * sn + n2 * cs; }
        v4u r1, r2; r1.x = pk2(o1[0], o1[1]); r1.y = pk2(o1[2], o1[3]); r1.z = pk2(o1[4], o1[5]); r1.w = pk2(o1[6], o1[7]); r2.x = pk2(o2[0], o2[1]); r2.y = pk2(o2[2], o2[3]); r2.z = pk2(o2[4], o2[5]); r2.w = pk2(o2[6], o2[7]);
        bfu* q = P + (size_t)m * PP + coff; *(v4u*)q = r1; *(v4u*)(q + 32) = r2;
        if (hh >= 6) { unsigned char* k8 = F.ws + WS_K8 + (size_t)m * 256 + (hh - 6) * 128 + a1;
            pg8::u32x2 e1, e2; e1.x = pg8::cvt4_fp8(o1[0], o1[1], o1[2], o1[3]); e1.y = pg8::cvt4_fp8(o1[4], o1[5], o1[6], o1[7]); e2.x = pg8::cvt4_fp8(o2[0], o2[1], o2[2], o2[3]); e2.y = pg8::cvt4_fp8(o2[4], o2[5], o2[6], o2[7]);
            *(pg8::u32x2*)k8 = e1; *(pg8::u32x2*)(k8 + 32) = e2; }
    }
}

__device__ __forceinline__ void vt8_pass(Frame& F) {
    const bfu* P = (const bfu*)(F.ws + WS_PROJ); unsigned char* T = (unsigned char*)F.ldsg;
    const int tid = F.tid, s_ = tid >> 3, d0 = (tid & 7) * 16;
    const int pos = 32 * ((s_ >> 2) & 1) + (s_ & 3) + 4 * ((s_ & 31) >> 3) + (s_ >= 32 ? 16 : 0);
    for (int u = F.vcu; u < 2 * NCHUNK; u += F.G) { const int kvh = u / NCHUNK, tt = u % NCHUNK;
        const bfu* src = P + (size_t)(64 * tt + s_) * PP + C_AV + kvh * 128 + d0;
        const attn::bf16x8 va = *(const attn::bf16x8*)src, vb = *(const attn::bf16x8*)(src + 8);
        WG_SYNC();
#pragma unroll
        for (int i = 0; i < 8; ++i) { const float x = bf2f((bfu)va[i]), y = bf2f((bfu)vb[i]);
            T[(d0 + i) * 64 + pos] = (unsigned char)(__builtin_amdgcn_cvt_pk_fp8_f32(x, x, 0, false) & 0xff); T[(d0 + 8 + i) * 64 + pos] = (unsigned char)(__builtin_amdgcn_cvt_pk_fp8_f32(y, y, 0, false) & 0xff); }
        WG_SYNC();
        *(v4u*)(F.ws + WS_VT8 + ((size_t)(kvh * NCHUNK + tt) * 128) * 64 + (size_t)tid * 16) = *(const v4u*)(T + tid * 16);
    }
    WG_SYNC();
}
__device__ __forceinline__ void attn_a_unit(Frame& F, int id) {
    int row0, kv0, nkeys, h;
    if (id < 192) { h = id >> 5; const int qb = id & 31; row0 = qb * 256; kv0 = 0; nkeys = TP; }
    else { const int j = id - 192, s = j / 48, rem = j % 48; h = rem >> 3; const int qb = rem & 7; kv0 = TP + s * TS; row0 = kv0 + qb * 256; nkeys = TS; }
    const attn::bf16* P = (const attn::bf16*)(F.ws + WS_PROJ);
    const int kvh = h / 3;
    attn::attn_dense_body88r(P + (size_t)row0 * PP + C_AQ + h * 128, F.ws + WS_K8 + (size_t)kv0 * 256 + kvh * 128, F.ws + WS_VT8 + ((size_t)kvh * NCHUNK + kv0 / 64) * 8192,
                            (attn::bf16*)(F.ws + WS_MIX) + (size_t)row0 * D + h * 128, nkeys, F.ldsg);
}
__device__ __forceinline__ void attn_a_phase(Frame& F) {
    const int c = F.vcu;
    const int cnt = (F.G == 256) ? (c < 192 ? 3 : 6) : (960 - c + F.G - 1) / F.G;
    for (int i = 0; i < cnt; ++i) {
        int id;
        if (F.G == 256) id = c < 192 ? (i == 0 ? c : 192 + 2 * c + (i - 1)) : 192 + 384 + (c - 192) * 6 + i;
        else id = c + i * F.G;
        attn_a_unit(F, id);
    }
}

namespace mixb {
using attn::bf16x8; using attn::f32x16; using attn::u32x4;
constexpr float NEG = -1e30f;
__device__ __forceinline__ int t5_bucket(int rp) {
    const int n = rp < 0 ? -rp : rp;
    int large = 8 + (int)(logf((float)(n > 1 ? n : 1) / 8.f) / 4.852030263919617f * 8.f);
    large = large < 15 ? large : 15;
    return (rp > 0 ? 16 : 0) + (n < 8 ? n : large);
}
__device__ __forceinline__ void stage_tile(Frame& F, char* slot, bool isV, int bn, int nb, int tok0, int dil, int colbase, int tp) {
    const bfu* P = (const bfu*)(F.ws + WS_PROJ);
    const bool valid = bn >= 0 && bn < nb; const int sr = tp >> 4, sc = (tp & 15) * 8;
    bf16x8 v[8];
#pragma unroll
    for (int i = 0; i < 8; ++i) { const int kk = sr + 8 * i; v[i] = (bf16x8){0, 0, 0, 0, 0, 0, 0, 0};
        if (valid) v[i] = *(const bf16x8*)(P + (size_t)(tok0 + (64 * bn + kk) * dil) * PP + colbase + sc); }
#pragma unroll
    for (int i = 0; i < 8; ++i) { const int kk = sr + 8 * i;
        if (isV) *(bf16x8*)(slot + attn::v_st(kk, sc)) = v[i]; else *(bf16x8*)(slot + KSWZ(kk, sc * 2)) = v[i]; }
}
#define MB_PK4(P, BASE, OUT) do { unsigned a0 = attn::cvtpk(P[BASE + 0], P[BASE + 1]), a1 = attn::cvtpk(P[BASE + 2], P[BASE + 3]);   \
    unsigned b0 = attn::cvtpk(P[BASE + 4], P[BASE + 5]), b1 = attn::cvtpk(P[BASE + 6], P[BASE + 7]);                              \
    auto r0 = __builtin_amdgcn_permlane32_swap(a0, b0, false, false); auto r1 = __builtin_amdgcn_permlane32_swap(a1, b1, false, false); \
    u32x4 w = {r0[0], r1[0], r0[1], r1[1]}; OUT = *reinterpret_cast<bf16x8*>(&w); } while (0)
__device__ __forceinline__ float score_fix(f32x16& p0, f32x16& p1, int kt, bool bvalid, int iq, int hi, const float* bt, float mx) {
#pragma unroll
    for (int r = 0; r < 16; ++r) {
        const int kk = attn::crow(r, hi);
        { const int rel = 64 * (kt - 1) + kk - iq; const bool ok = bvalid && rel >= -64 && rel <= 64; const int bi = ok ? rel + 64 : 64;
          const float s = ok ? p0[r] * attn::SCALE + bt[bi] : NEG; p0[r] = s; mx = fmaxf(mx, s); }
        { const int rel = 64 * (kt - 1) + kk + 32 - iq; const bool ok = bvalid && rel >= -64 && rel <= 64; const int bi = ok ? rel + 64 : 64;
          const float s = ok ? p1[r] * attn::SCALE + bt[bi] : NEG; p1[r] = s; mx = fmaxf(mx, s); }
    }
    return mx;
}
__device__ __forceinline__ float score_exp(f32x16& p0, f32x16& p1, float m) {
    float sum = 0.f;
#pragma unroll
    for (int r = 0; r < 16; ++r) { p0[r] = __builtin_amdgcn_exp2f((p0[r] - m) * 1.4426950408889634f); p1[r] = __builtin_amdgcn_exp2f((p1[r] - m) * 1.4426950408889634f); sum += p0[r] + p1[r]; }
    return sum;
}
__device__ __forceinline__ void mixer_b_phase(Frame& F) {
    const int tid = F.tid, lane = F.lane, wave = F.wave, r32 = lane & 31, hi = lane >> 5;
    const int p = wave >> 1, wq = wave & 1, tp = tid & 127;
    char* slotA = F.ldsg + p * 32768; char* slotB = slotA + 16384;
    float* bt = (float*)(F.ldsg + 131072 + p * 528);
    float* li_l = (float*)(F.ldsg + 131072 + 2112 + wave * 128);
    const float* rel_bias = F.in[4];
    bfu* MIXp = (bfu*)(F.ws + WS_MIX); float* LSE = (float*)(F.ws + WS_LSE);
    const bfu* P = (const bfu*)(F.ws + WS_PROJ);
    for (int ui = F.vcu; ui < 960; ui += F.G) {
        const int qid = ui * 4 + p, head6 = qid / 640, blk = qid % 640;
        const int s = blk < 128 ? 0 : 1 + (blk - 128) / 32, lb = blk < 128 ? blk : (blk - 128) % 32;
        const int g = head6 >> 1, dil = 1 << (2 * g), T = seq_len(s), L = T / dil, nb = L / 64, r = lb / nb, n = lb % nb;
        const int tok0 = seq_start(s) + r;
        WG_SYNC();
        for (int bi = tp; bi < 129; bi += 128) bt[bi] = rel_bias[t5_bucket((bi - 64) * dil) * 6 + head6];
        const int iq = 32 * wq + r32;
        bf16x8 qr[8];
        { const bfu* Qw = P + (size_t)(tok0 + (64 * n + iq) * dil) * PP + C_BQ + head6 * 128 + hi * 8;
#pragma unroll
          for (int d0 = 0; d0 < 8; ++d0) qr[d0] = *(const bf16x8*)(Qw + d0 * 16); }
        const int kcol = C_BK + head6 * 128, vcol = C_BV + head6 * 128;
        f32x16 s00, s01, s10, s11, s20, s21;
        stage_tile(F, slotA, false, n - 1, nb, tok0, dil, kcol, tp); stage_tile(F, slotB, false, n, nb, tok0, dil, kcol, tp);
        WG_SYNC();
        attn::qkt(s00, s01, (const attn::bf16*)slotA, qr, r32, hi); attn::qkt(s10, s11, (const attn::bf16*)slotB, qr, r32, hi);
        WG_SYNC();
        stage_tile(F, slotA, false, n + 1, nb, tok0, dil, kcol, tp); stage_tile(F, slotB, true, n - 1, nb, tok0, dil, vcol, tp);
        WG_SYNC();
        attn::qkt(s20, s21, (const attn::bf16*)slotA, qr, r32, hi);
        float mx = NEG;
        mx = score_fix(s00, s01, 0, n - 1 >= 0, iq, hi, bt, mx); mx = score_fix(s10, s11, 1, true, iq, hi, bt, mx); mx = score_fix(s20, s21, 2, n + 1 < nb, iq, hi, bt, mx);
        { auto rr = __builtin_amdgcn_permlane32_swap(__float_as_uint(mx), __float_as_uint(mx), false, false); mx = fmaxf(__uint_as_float(rr[0]), __uint_as_float(rr[1])); }
        float den = score_exp(s00, s01, mx) + score_exp(s10, s11, mx) + score_exp(s20, s21, mx);
        { auto rr = __builtin_amdgcn_permlane32_swap(__float_as_uint(den), __float_as_uint(den), false, false); den = __uint_as_float(rr[0]) + __uint_as_float(rr[1]); }
        f32x16 o[4] = {};
        bf16x8 pa0, pa1, pa2, pa3;
        const int vbA = (int)(uintptr_t)slotA + attn::v_rd_base(lane), vbB = (int)(uintptr_t)slotB + attn::v_rd_base(lane);
        MB_PK4(s00, 0, pa0); MB_PK4(s00, 8, pa1); MB_PK4(s01, 0, pa2); MB_PK4(s01, 8, pa3);
        attn::pv_d0(o, vbB, pa0, pa1, pa2, pa3);
        WG_SYNC();
        stage_tile(F, slotA, true, n, nb, tok0, dil, vcol, tp); stage_tile(F, slotB, true, n + 1, nb, tok0, dil, vcol, tp);
        WG_SYNC();
        MB_PK4(s10, 0, pa0); MB_PK4(s10, 8, pa1); MB_PK4(s11, 0, pa2); MB_PK4(s11, 8, pa3);
        attn::pv_d0(o, vbA, pa0, pa1, pa2, pa3);
        MB_PK4(s20, 0, pa0); MB_PK4(s20, 8, pa1); MB_PK4(s21, 0, pa2); MB_PK4(s21, 8, pa3);
        attn::pv_d0(o, vbB, pa0, pa1, pa2, pa3);
        if (hi == 0) { li_l[r32] = den; LSE[(size_t)(tok0 + (64 * n + iq) * dil) * 6 + head6] = mx + logf(den); }
        asm volatile("s_waitcnt lgkmcnt(0)" ::: "memory");
#pragma unroll
        for (int rr = 0; rr < 16; ++rr) { const int q = attn::crow(rr, hi); const float rl = __builtin_amdgcn_rcpf(li_l[q]);
            bfu* orow = MIXp + (size_t)(tok0 + (64 * n + 32 * wq + q) * dil) * D + MIX_B + head6 * 128 + r32;
#pragma unroll
            for (int d0 = 0; d0 < 4; ++d0) orow[d0 * 32] = (bfu)f2bf(o[d0][rr] * rl); }
    }
    WG_SYNC();
}
__device__ __forceinline__ void mix_row_pass(Frame& F) {
    const int gw = F.vcu * NWAVES + F.wave, NGW = F.G * NWAVES, lane = F.lane;
    const bfu* MIXp = (const bfu*)(F.ws + WS_MIX); const float* LSE = (const float*)(F.ws + WS_LSE);
    for (int m = gw; m < M; m += NGW) {
        const float* l6 = LSE + (size_t)m * 6;
        float w[6];
#pragma unroll
        for (int j = 0; j < 2; ++j) { const float a = l6[j], b = l6[2 + j], c = l6[4 + j], mx = fmaxf(a, fmaxf(b, c));
            const float ea = expf(a - mx), eb = expf(b - mx), ec = expf(c - mx), inv = 1.f / (ea + eb + ec); w[j] = ea * inv; w[2 + j] = eb * inv; w[4 + j] = ec * inv; }
        f32x4 v[8];
        row_load_bf16(MIXp + (size_t)m * D, v, lane, 1.f);
#pragma unroll
        for (int j = 0; j < 4; ++j) { const int col = 8 * lane + 512 * j;
            if (col >= MIX_B && col < MIX_C) { const int h6 = (col - MIX_B) >> 7; float wt = w[0];
#pragma unroll
                for (int k = 1; k < 6; ++k) wt = (h6 == k) ? w[k] : wt;
                v[2 * j] = v[2 * j] * wt; v[2 * j + 1] = v[2 * j + 1] * wt; } }
        row_store_i8(F.ws + WS_MIXI8 + (size_t)m * D, (float*)(F.ws + WS_RSC2) + m, v, lane);
    }
}
}

namespace gla {
using attn::bf16x8; using attn::f32x16;
constexpr int L_CUM = 0, L_GT = 16384, L_TOT = 18432, L_Z = 18688, L_QT = 22784, L_KT = 32000, L_ATT = 41216, L_VT = 50432, L_ST = 68864, L_O = 87296, LD = 72, LDO_ = 132;
static_assert(L_O + 64 * LDO_ * 4 <= SCR_BYTES, "gla lds");
__device__ __forceinline__ float logsig(float x) { return fminf(x, 0.f) - log1pf(expf(-fabsf(x))); }
__device__ __forceinline__ f32x16 lds_mma(const bfu* A, const bfu* Bt, int K, f32x16 acc, int lane) {
    const int r = lane & 31, hi = lane >> 5;
    for (int k0 = 0; k0 < K; k0 += 16) {
        const bf16x8 a = *(const bf16x8*)(A + r * LD + k0 + hi * 8), b = *(const bf16x8*)(Bt + r * LD + k0 + hi * 8);
        acc = __builtin_amdgcn_mfma_f32_32x32x16_bf16(a, b, acc, 0, 0, 0);
    }
    return acc;
}
__device__ __forceinline__ void compute_cum(Frame& F, int l, int row0, int h, int dir) {
    float* CUM = (float*)(F.ldsg + L_CUM); float* GT = (float*)(F.ldsg + L_GT); float* TOT = (float*)(F.ldsg + L_TOT); float* Z = (float*)(F.ldsg + L_Z);
    const bfu* P = (const bfu*)(F.ws + WS_PROJ);
    const int tid = F.tid;
    { const int t = tid >> 3, r2 = (tid & 7) * 2; const unsigned zz = *(const unsigned*)(P + (size_t)(row0 + t) * PP + (dir ? C_ZB : C_ZF) + r2);
      Z[t * 16 + r2] = __uint_as_float(zz << 16); Z[t * 16 + r2 + 1] = __uint_as_float(zz & 0xffff0000u); }
    const int k = tid & 63, tg = tid >> 6, col = h * 64 + k;
    const float* wv = (dir ? F.in[10] : F.in[8]) + (size_t)l * 16 * 256; const float bias = ((dir ? F.in[11] : F.in[9]) + l * 256)[col];
    float w[16];
#pragma unroll
    for (int r = 0; r < 16; ++r) w[r] = wv[r * 256 + col];
    WG_SYNC();
    float la[8];
#pragma unroll
    for (int i = 0; i < 8; ++i) { const float* z = Z + (8 * tg + i) * 16; float pre = bias;
#pragma unroll
        for (int r = 0; r < 16; ++r) pre += z[r] * w[r];
        la[i] = logsig(pre) * (1.f / 16.f); }
    float run = 0.f;
    if (dir == 0) {
#pragma unroll
        for (int i = 0; i < 8; ++i) { run += la[i]; la[i] = run; }
    } else {
#pragma unroll
        for (int i = 7; i >= 0; --i) { run += la[i]; la[i] = run; }
    }
    GT[tg * 64 + k] = run;
    WG_SYNC();
    float off = 0.f, tot = 0.f;
#pragma unroll
    for (int g = 0; g < 8; ++g) { const float x = GT[g * 64 + k]; tot += x; if (dir == 0 ? (g < tg) : (g > tg)) off += x; }
#pragma unroll
    for (int i = 0; i < 8; ++i) CUM[(8 * tg + i) * 64 + k] = la[i] + off;
    if (tg == 0) TOT[k] = tot;
    WG_SYNC();
}
__device__ __forceinline__ void stage_vt(Frame& F, int row0, int h) {
    const bfu* P = (const bfu*)(F.ws + WS_PROJ); bfu* VT = (bfu*)(F.ldsg + L_VT);
    const int s = F.tid >> 3, vg = (F.tid & 7) * 16;
    const bfu* src = P + (size_t)(row0 + s) * PP + C_CV + h * 128 + vg;
    const bf16x8 a = *(const bf16x8*)src, b = *(const bf16x8*)(src + 8);
#pragma unroll
    for (int j = 0; j < 8; ++j) { VT[(vg + j) * LD + s] = (bfu)a[j]; VT[(vg + 8 + j) * LD + s] = (bfu)b[j]; }
}
constexpr int N_CUM0 = 0, N_CUM1 = 16384, N_GT0 = 32768, N_GT1 = 34816, N_TOT0 = 36864, N_TOT1 = 37120, N_Z0 = 37376, N_Z1 = 41472, N_KH0 = 45568, N_KH1 = 54784, N_VT = 64000;
static_assert(N_VT + 18432 <= SCR_BYTES, "gla c1 lds");
__device__ __forceinline__ float fexp(float x) { return __builtin_amdgcn_exp2f(x * 1.4426950408889634f); }
__device__ __forceinline__ float logsig_fast(float x) { return fminf(x, 0.f) - 0.6931471805599453f * __builtin_amdgcn_logf(1.f + fexp(-fabsf(x))); }
__device__ __forceinline__ void c1_phase(Frame& F, int l) {
    const bfu* P = (const bfu*)(F.ws + WS_PROJ);
    bfu* DUT = (bfu*)(F.ws + WS_HID); float* ADEC = (float*)(F.ws + WS_ADEC);
    bfu* QKT = (bfu*)(F.ws + WS_QKT);
    float* CUM0 = (float*)(F.ldsg + N_CUM0); float* CUM1 = (float*)(F.ldsg + N_CUM1); float* GT0 = (float*)(F.ldsg + N_GT0); float* GT1 = (float*)(F.ldsg + N_GT1);
    float* TOT0 = (float*)(F.ldsg + N_TOT0); float* TOT1 = (float*)(F.ldsg + N_TOT1); float* Z0 = (float*)(F.ldsg + N_Z0); float* Z1 = (float*)(F.ldsg + N_Z1);
    bfu* KH0 = (bfu*)(F.ldsg + N_KH0); bfu* KH1 = (bfu*)(F.ldsg + N_KH1); bfu* VT = (bfu*)(F.ldsg + N_VT);
    const int tid = F.tid, lane = F.lane, wave = F.wave;
    const int k_ = tid & 63, tg = tid >> 6, s_ = tid >> 3, kg = (tid & 7) * 8, vg = (tid & 7) * 16, r2 = (tid & 7) * 2;
    for (int u = F.vcu; u < NCHUNK * 4; u += F.G) {
        const int gc = u >> 2, h = u & 3, row0 = gc * 64, col = h * 64 + k_;
        const bfu* rowp = P + (size_t)(row0 + s_) * PP;
        const unsigned zf = *(const unsigned*)(rowp + C_ZF + r2), zb = *(const unsigned*)(rowp + C_ZB + r2);
        const bf16x8 kk = *(const bf16x8*)(rowp + C_CK + h * 64 + kg), qq = *(const bf16x8*)(rowp + C_CQ + h * 64 + kg);
        const bf16x8 va = *(const bf16x8*)(rowp + C_CV + h * 128 + vg), vb = *(const bf16x8*)(rowp + C_CV + h * 128 + vg + 8);
        float wf[16], wb[16];
        { const float* pf = F.in[8] + (size_t)l * 16 * 256 + col; const float* pb = F.in[10] + (size_t)l * 16 * 256 + col;
#pragma unroll
          for (int r = 0; r < 16; ++r) { wf[r] = pf[r * 256]; wb[r] = pb[r * 256]; } }
        const float bif = (F.in[9] + l * 256)[col], bib = (F.in[11] + l * 256)[col];
        WG_SYNC();
        Z0[s_ * 16 + r2] = __uint_as_float(zf << 16); Z0[s_ * 16 + r2 + 1] = __uint_as_float(zf & 0xffff0000u);
        Z1[s_ * 16 + r2] = __uint_as_float(zb << 16); Z1[s_ * 16 + r2 + 1] = __uint_as_float(zb & 0xffff0000u);
#pragma unroll
        for (int j = 0; j < 8; ++j) { VT[(vg + j) * LD + s_] = (bfu)va[j]; VT[(vg + 8 + j) * LD + s_] = (bfu)vb[j]; }
        WG_SYNC();
        float la0[8], la1[8];
#pragma unroll
        for (int i = 0; i < 8; ++i) { const float* z0 = Z0 + (8 * tg + i) * 16; const float* z1 = Z1 + (8 * tg + i) * 16; float p0 = bif, p1 = bib;
#pragma unroll
            for (int r = 0; r < 16; ++r) { p0 += z0[r] * wf[r]; p1 += z1[r] * wb[r]; }
            la0[i] = logsig_fast(p0) * (1.f / 16.f); la1[i] = logsig_fast(p1) * (1.f / 16.f); }
        { float run = 0.f;
#pragma unroll
          for (int i = 0; i < 8; ++i) { run += la0[i]; la0[i] = run; }
          GT0[tg * 64 + k_] = run; run = 0.f;
#pragma unroll
          for (int i = 7; i >= 0; --i) { run += la1[i]; la1[i] = run; }
          GT1[tg * 64 + k_] = run; }
        WG_SYNC();
        { float off0 = 0.f, tot0 = 0.f, off1 = 0.f, tot1 = 0.f;
#pragma unroll
          for (int g = 0; g < 8; ++g) { const float x0 = GT0[g * 64 + k_], x1 = GT1[g * 64 + k_]; tot0 += x0; tot1 += x1; if (g < tg) off0 += x0; if (g > tg) off1 += x1; }
#pragma unroll
          for (int i = 0; i < 8; ++i) { CUM0[(8 * tg + i) * 64 + k_] = la0[i] + off0; CUM1[(8 * tg + i) * 64 + k_] = la1[i] + off1; }
          if (tg == 0) { TOT0[k_] = tot0; TOT1[k_] = tot1; } }
        WG_SYNC();
#pragma unroll
        for (int dir = 0; dir < 2; ++dir) { const float* CUM = dir ? CUM1 : CUM0; const float* TOT = dir ? TOT1 : TOT0; bfu* KhT = dir ? KH1 : KH0;
            float qv[8], kv[8];
#pragma unroll
            for (int j = 0; j < 8; ++j) { const float c = CUM[s_ * 64 + kg + j], kf = bf2f((bfu)kk[j]), en = fexp(-c);
                KhT[(kg + j) * LD + s_] = (bfu)f2bf(kf * en * fexp(TOT[kg + j]));
                kv[j] = kf * en; qv[j] = bf2f((bfu)qq[j]) * 0.125f * fexp(c); }
            v4u wq_, wk_; wq_.x = pk2(qv[0], qv[1]); wq_.y = pk2(qv[2], qv[3]); wq_.z = pk2(qv[4], qv[5]); wq_.w = pk2(qv[6], qv[7]);
            wk_.x = pk2(kv[0], kv[1]); wk_.y = pk2(kv[2], kv[3]); wk_.z = pk2(kv[4], kv[5]); wk_.w = pk2(kv[6], kv[7]);
            bfu* qk = QKT + ((size_t)((gc * 4 + h) * 2 + dir) * 2) * 4096 + s_ * 64 + kg;
            *(v4u*)qk = wq_; *(v4u*)(qk + 4096) = wk_; }
        WG_SYNC();
        { const int dir = wave >> 2, vt = wave & 3; const bfu* KhT = dir ? KH1 : KH0; const float* TOT = dir ? TOT1 : TOT0;
          const int unit = (gc * 4 + h) * 2 + dir; bfu* dst = DUT + (size_t)unit * 8192;
#pragma unroll
          for (int kt = 0; kt < 2; ++kt) { f32x16 acc = {};
              acc = lds_mma(VT + 32 * vt * LD, KhT + 32 * kt * LD, 64, acc, lane);
#pragma unroll
              for (int rr = 0; rr < 16; ++rr) dst[(32 * vt + attn::crow(rr, lane >> 5)) * 64 + 32 * kt + (lane & 31)] = (bfu)f2bf(acc[rr]); }
          if ((tid & 255) < 64) ADEC[unit * 64 + (tid & 255)] = fexp(TOT[tid & 255]); }
    }
    WG_SYNC();
}
__device__ __forceinline__ void c2_phase(Frame& F) {
    bfu* DUT = (bfu*)(F.ws + WS_HID); const float* ADEC = (const float*)(F.ws + WS_ADEC);
    const int NT = 17 * 8 * 1024;
    for (int idx = F.vcu * NTHR + F.tid; idx < NT; idx += F.G * NTHR) {
        const int grp = idx >> 10, e8 = idx & 1023, s = grp >> 3, h = (grp >> 1) & 3, d = grp & 1;
        const int nch = seq_len(s) / 64, gc0 = seq_start(s) / 64;
        float S[8];
#pragma unroll
        for (int c = 0; c < 8; ++c) S[c] = 0.f;
        for (int n = 0; n < nch; n += 8) {
            v4u x[8]; f32x4 a0[8], a1[8]; v4u* p[8];
#pragma unroll
            for (int q = 0; q < 8; ++q) { const int gc = d == 0 ? gc0 + n + q : gc0 + nch - 1 - (n + q); const int unit = (gc * 4 + h) * 2 + d;
                p[q] = (v4u*)(DUT + (size_t)unit * 8192) + e8; x[q] = *p[q]; const float* ap = ADEC + unit * 64 + (e8 & 7) * 8; a0[q] = *(const f32x4*)ap; a1[q] = *(const f32x4*)(ap + 4); }
#pragma unroll
            for (int q = 0; q < 8; ++q) { v4u o; o.x = pk2(S[0], S[1]); o.y = pk2(S[2], S[3]); o.z = pk2(S[4], S[5]); o.w = pk2(S[6], S[7]); *p[q] = o;
                const unsigned* xu = (const unsigned*)&x[q];
                S[0] = a0[q].x * S[0] + __uint_as_float(xu[0] << 16); S[1] = a0[q].y * S[1] + __uint_as_float(xu[0] & 0xffff0000u);
                S[2] = a0[q].z * S[2] + __uint_as_float(xu[1] << 16); S[3] = a0[q].w * S[3] + __uint_as_float(xu[1] & 0xffff0000u);
                S[4] = a1[q].x * S[4] + __uint_as_float(xu[2] << 16); S[5] = a1[q].y * S[5] + __uint_as_float(xu[2] & 0xffff0000u);
                S[6] = a1[q].z * S[6] + __uint_as_float(xu[3] << 16); S[7] = a1[q].w * S[7] + __uint_as_float(xu[3] & 0xffff0000u); }
        }
    }
}
constexpr int M_QT0 = 0, M_KT0 = 9216, M_QT1 = 18432, M_KT1 = 27648, M_ATT0 = 36864, M_ATT1 = 46080, M_VT = 55296, M_ST0 = 73728, M_ST1 = 92160, M_O = 0;
static_assert(M_ST1 + 18432 <= SCR_BYTES && 64 * LDO_ * 4 <= M_ATT0, "gla c3 lds");
__device__ __forceinline__ void c3_phase(Frame& F, int l) {
    const bfu* P = (const bfu*)(F.ws + WS_PROJ); const bfu* DUT = (const bfu*)(F.ws + WS_HID); const bfu* QKT = (const bfu*)(F.ws + WS_QKT);
    bfu* VT = (bfu*)(F.ldsg + M_VT); float* O = (float*)(F.ldsg + M_O);
    bfu* MIXp = (bfu*)(F.ws + WS_MIX); const float* ng = F.in[12] + l * 128;
    const int tid = F.tid, lane = F.lane, wave = F.wave, hi = lane >> 5;
    const int s_ = tid >> 3, kg = (tid & 7) * 8, vg = (tid & 7) * 16, sv = tid >> 2, sk0 = (tid & 3) * 16;
    v4u q0, k0, q1, k1; bf16x8 va, vb, g0, g1; v4u sa0, sa1, sb0, sb1;
#define C3_LOAD(uu) do { const int gc_ = (uu) >> 2, h_ = (uu) & 3, row0_ = gc_ * 64; \
        const bfu* qk_ = QKT + (size_t)((gc_ * 4 + h_) * 4) * 4096 + s_ * 64 + kg;                \
        q0 = *(const v4u*)qk_; k0 = *(const v4u*)(qk_ + 4096); q1 = *(const v4u*)(qk_ + 8192); k1 = *(const v4u*)(qk_ + 12288); \
        const bfu* vsrc_ = P + (size_t)(row0_ + s_) * PP + C_CV + h_ * 128 + vg; va = *(const bf16x8*)vsrc_; vb = *(const bf16x8*)(vsrc_ + 8); \
        const bfu* gp_ = P + (size_t)(row0_ + s_) * PP + C_CG + h_ * 128 + vg; g0 = *(const bf16x8*)gp_; g1 = *(const bf16x8*)(gp_ + 8); \
        const bfu* s0p_ = DUT + (size_t)((gc_ * 4 + h_) * 2) * 8192 + sv * 64 + sk0; const bfu* s1p_ = s0p_ + 8192; \
        sa0 = *(const v4u*)s0p_; sa1 = *(const v4u*)(s0p_ + 8); sb0 = *(const v4u*)s1p_; sb1 = *(const v4u*)(s1p_ + 8); } while (0)
    if (F.vcu < NCHUNK * 4) C3_LOAD(F.vcu);
    for (int u = F.vcu; u < NCHUNK * 4; u += F.G) {
        const int gc = u >> 2, h = u & 3, row0 = gc * 64;
        const bf16x8 g0c = g0, g1c = g1;
        WG_SYNC();
        *(v4u*)(F.ldsg + M_QT0 + (s_ * LD + kg) * 2) = q0; *(v4u*)(F.ldsg + M_KT0 + (s_ * LD + kg) * 2) = k0;
        *(v4u*)(F.ldsg + M_QT1 + (s_ * LD + kg) * 2) = q1; *(v4u*)(F.ldsg + M_KT1 + (s_ * LD + kg) * 2) = k1;
#pragma unroll
        for (int j = 0; j < 8; ++j) { VT[(vg + j) * LD + s_] = (bfu)va[j]; VT[(vg + 8 + j) * LD + s_] = (bfu)vb[j]; }
        *(v4u*)(F.ldsg + M_ST0 + (sv * LD + sk0) * 2) = sa0; *(v4u*)(F.ldsg + M_ST0 + (sv * LD + sk0 + 8) * 2) = sa1;
        *(v4u*)(F.ldsg + M_ST1 + (sv * LD + sk0) * 2) = sb0; *(v4u*)(F.ldsg + M_ST1 + (sv * LD + sk0 + 8) * 2) = sb1;
        if (u + F.G < NCHUNK * 4) C3_LOAD(u + F.G);
        WG_SYNC();
        {
          const int dir = wave >> 2, th = (wave >> 1) & 1, sh = wave & 1;
          const bfu* QTd = (const bfu*)(F.ldsg + (dir ? M_QT1 : M_QT0)); const bfu* KTd = (const bfu*)(F.ldsg + (dir ? M_KT1 : M_KT0)); bfu* ATTd = (bfu*)(F.ldsg + (dir ? M_ATT1 : M_ATT0));
          f32x16 a = {};
          a = lds_mma(QTd + 32 * th * LD, KTd + 32 * sh * LD, 64, a, lane);
#pragma unroll
          for (int rr = 0; rr < 16; ++rr) { const int t = 32 * th + attn::crow(rr, hi), sx = 32 * sh + (lane & 31); const bool keep = dir == 0 ? (sx <= t) : (sx >= t);
              ATTd[t * LD + sx] = (bfu)f2bf(keep ? a[rr] : 0.f); } }
        WG_SYNC();
        f32x16 oacc = {};
        { const int th = wave >> 2, vq = wave & 3;
          oacc = lds_mma((const bfu*)(F.ldsg + M_ATT0) + 32 * th * LD, VT + 32 * vq * LD, 64, oacc, lane);
          oacc = lds_mma((const bfu*)(F.ldsg + M_QT0) + 32 * th * LD, (const bfu*)(F.ldsg + M_ST0) + 32 * vq * LD, 64, oacc, lane);
          oacc = lds_mma((const bfu*)(F.ldsg + M_ATT1) + 32 * th * LD, VT + 32 * vq * LD, 64, oacc, lane);
          oacc = lds_mma((const bfu*)(F.ldsg + M_QT1) + 32 * th * LD, (const bfu*)(F.ldsg + M_ST1) + 32 * vq * LD, 64, oacc, lane); }
        WG_SYNC();
        { const int th = wave >> 2, vq = wave & 3;
#pragma unroll
          for (int rr = 0; rr < 16; ++rr) O[(32 * th + attn::crow(rr, hi)) * LDO_ + 32 * vq + (lane & 31)] = oacc[rr]; }
        WG_SYNC();
        { const int t = s_; float ov[16]; float ss = 0.f;
#pragma unroll
          for (int j = 0; j < 16; ++j) { ov[j] = O[t * LDO_ + vg + j]; ss += ov[j] * ov[j]; }
          ss += __shfl_xor(ss, 1); ss += __shfl_xor(ss, 2); ss += __shfl_xor(ss, 4);
          const float rstd = 1.f / sqrtf(ss * (1.f / 128.f) + RMS_EPS);
          float r[16];
#pragma unroll
          for (int j = 0; j < 16; ++j) { const float gt = bf2f((bfu)(j < 8 ? g0c[j] : g1c[j - 8])); const float sg = gt / (1.f + expf(-gt)); r[j] = ov[j] * rstd * ng[vg + j] * sg; }
          v4u w0, w1; w0.x = pk2(r[0], r[1]); w0.y = pk2(r[2], r[3]); w0.z = pk2(r[4], r[5]); w0.w = pk2(r[6], r[7]); w1.x = pk2(r[8], r[9]); w1.y = pk2(r[10], r[11]); w1.z = pk2(r[12], r[13]); w1.w = pk2(r[14], r[15]);
          bfu* dst = MIXp + (size_t)(row0 + t) * D + MIX_C + h * 128 + vg;
          *(v4u*)dst = w0; *(v4u*)(dst + 8) = w1; }
    }
    WG_SYNC();
}
}

__device__ __forceinline__ void ln1_router_phase(Frame& F, int l) {
    float* WL = (float*)F.ldsg;
    const float* wr = F.in[16] + (size_t)l * D * NEXP;
    WG_SYNC();
    for (int idx = F.tid; idx < D * 4; idx += NTHR) { const int col = idx >> 2, e4 = (idx & 3) * 4; const f32x4 w = *(const f32x4*)(wr + col * 16 + e4);
        const int jj = (col >> 9) * 2 + ((col >> 2) & 1), ln = (col & 511) >> 3, c = col & 3;
        float* dst = WL + (jj * 64 + ln) * 4 + c;
        dst[(e4 + 0) * D] = w.x; dst[(e4 + 1) * D] = w.y; dst[(e4 + 2) * D] = w.z; dst[(e4 + 3) * D] = w.w; }
    WG_SYNC();
    const int gw = F.vcu * NWAVES + F.wave, NGW = F.G * NWAVES, lane = F.lane;
    const float* g = F.in[14] + l * D; const float* b = F.in[15] + l * D;
    float* AFFT = (float*)(F.ws + WS_AFFT);
    const bfu* XNb = (const bfu*)(F.ws + WS_XN); const bfu* MOb = (const bfu*)(F.ws + WS_HID);
    v4u px[4], pm[4];
#pragma unroll
    for (int j = 0; j < 4; ++j) { px[j] = (v4u){0u, 0u, 0u, 0u}; pm[j] = px[j]; }
    if (gw < M) {
#pragma unroll
        for (int j = 0; j < 4; ++j) { px[j] = *(const v4u*)(XNb + (size_t)gw * D + 8 * lane + 512 * j); pm[j] = *(const v4u*)(MOb + (size_t)gw * D + 8 * lane + 512 * j); } }
    for (int m = gw; m < M; m += NGW) {
        bfu* xn = (bfu*)(F.ws + WS_XN) + (size_t)m * D;
        f32x4 v[8];
#pragma unroll
        for (int j = 0; j < 4; ++j) { const v4u x = px[j], y = pm[j];
            v[2 * j] = (f32x4){__uint_as_float(x.x << 16) * DN_ALPHA + __uint_as_float(y.x << 16), __uint_as_float(x.x & 0xffff0000u) * DN_ALPHA + __uint_as_float(y.x & 0xffff0000u),
                               __uint_as_float(x.y << 16) * DN_ALPHA + __uint_as_float(y.y << 16), __uint_as_float(x.y & 0xffff0000u) * DN_ALPHA + __uint_as_float(y.y & 0xffff0000u)};
            v[2 * j + 1] = (f32x4){__uint_as_float(x.z << 16) * DN_ALPHA + __uint_as_float(y.z << 16), __uint_as_float(x.z & 0xffff0000u) * DN_ALPHA + __uint_as_float(y.z & 0xffff0000u),
                                   __uint_as_float(x.w << 16) * DN_ALPHA + __uint_as_float(y.w << 16), __uint_as_float(x.w & 0xffff0000u) * DN_ALPHA + __uint_as_float(y.w & 0xffff0000u)}; }
        if (m + NGW < M) {
#pragma unroll
            for (int j = 0; j < 4; ++j) { px[j] = *(const v4u*)(XNb + (size_t)(m + NGW) * D + 8 * lane + 512 * j); pm[j] = *(const v4u*)(MOb + (size_t)(m + NGW) * D + 8 * lane + 512 * j); } }
        ln_norm(v, g, b, lane);
        row_store_bf16(xn, v, lane);
        row_store_i8(F.ws + WS_XNI8 + (size_t)m * D, (float*)(F.ws + WS_RSC) + m, v, lane);
        float lg[16];
#pragma unroll
        for (int e = 0; e < 16; ++e) lg[e] = 0.f;
#pragma unroll
        for (int j = 0; j < 8; ++j) {
#pragma unroll
            for (int e = 0; e < 16; ++e) { const f32x4 w = *(const f32x4*)(WL + e * D + (j * 64 + lane) * 4); lg[e] += (v[j].x * w.x + v[j].y * w.y) + (v[j].z * w.z + v[j].w * w.w); }
            asm volatile("" ::: "memory");
        }
        float r8[8], r4[4], r2[2], r1;
        { const bool up = (lane & 32) != 0;
#pragma unroll
          for (int i = 0; i < 8; ++i) { const float keep = up ? lg[i + 8] : lg[i], send = up ? lg[i] : lg[i + 8]; r8[i] = keep + __shfl_xor(send, 32); } }
        { const bool up = (lane & 16) != 0;
#pragma unroll
          for (int i = 0; i < 4; ++i) { const float keep = up ? r8[i + 4] : r8[i], send = up ? r8[i] : r8[i + 4]; r4[i] = keep + __shfl_xor(send, 16); } }
        { const bool up = (lane & 8) != 0;
#pragma unroll
          for (int i = 0; i < 2; ++i) { const float keep = up ? r4[i + 2] : r4[i], send = up ? r4[i] : r4[i + 2]; r2[i] = keep + __shfl_xor(send, 8); } }
        { const bool up = (lane & 4) != 0; const float keep = up ? r2[1] : r2[0], send = up ? r2[0] : r2[1]; r1 = keep + __shfl_xor(send, 4); }
        r1 += __shfl_xor(r1, 2); r1 += __shfl_xor(r1, 1);
        float mx = r1;
        mx = fmaxf(mx, __shfl_xor(mx, 4)); mx = fmaxf(mx, __shfl_xor(mx, 8)); mx = fmaxf(mx, __shfl_xor(mx, 16)); mx = fmaxf(mx, __shfl_xor(mx, 32));
        const float ex = expf(r1 - mx);
        float sum = ex;
        sum += __shfl_xor(sum, 4); sum += __shfl_xor(sum, 8); sum += __shfl_xor(sum, 16); sum += __shfl_xor(sum, 32);
        const int eL = ((lane >> 5) & 1) * 8 + ((lane >> 4) & 1) * 4 + ((lane >> 3) & 1) * 2 + ((lane >> 2) & 1);
        if ((lane & 3) == 0) AFFT[(size_t)eL * M + m] = ex / sum;
    }
    WG_SYNC();
}

#define VPH(i) ((i) + ((i) >> 6))
template <int NV> __device__ __forceinline__ void topk_fill(unsigned* VALS, const float* srcf, int tid) {
    const v4u* src = (const v4u*)srcf; v4u t[NV];
#pragma unroll
    for (int j = 0; j < NV; ++j) t[j] = src[j * NTHR + tid];
#pragma unroll
    for (int j = 0; j < NV; ++j) { unsigned* d_ = VALS + VPH((j * NTHR + tid) * 4); d_[0] = t[j].x; d_[1] = t[j].y; d_[2] = t[j].z; d_[3] = t[j].w; }
}
__device__ __forceinline__ void topk_phase(Frame& F) {
    unsigned* VALS = (unsigned*)F.ldsg; unsigned* HIST = (unsigned*)(F.ldsg + 135168); unsigned* SC = (unsigned*)(F.ldsg + 135168 + 8192); unsigned* BC = (unsigned*)(F.ldsg + 135168 + 8192 + 1024);
    static_assert(135168 + 8192 + 1024 + 64 <= SCR_BYTES, "top-k lds");
    const float* AFFT = (const float*)(F.ws + WS_AFFT);
    int* SLOT = (int*)(F.ws + WS_SLOT); int* IDX = (int*)(F.ws + WS_IDX); float* GATE = (float*)(F.ws + WS_GATE);
    float* XRS = (float*)(F.ws + WS_XRS); const float* RSC = (const float*)(F.ws + WS_RSC);
    const int tid = F.tid;
    for (int u = F.vcu; u < 32; u += F.G) {
        const int tr = u >> 4, e = u & 15, n = tr ? NSAMP * TS : TP, base = tr ? TP : 0, cap = n / 8, vpt = n / NTHR;
        WG_SYNC();
        if (tr) topk_fill<16>(VALS, AFFT + (size_t)e * M + base, tid); else topk_fill<4>(VALS, AFFT + (size_t)e * M + base, tid);
        unsigned prefix = 0u, remaining = (unsigned)cap;
        for (int pass = 0; pass < 3; ++pass) {
            const int shift = pass == 0 ? 21 : pass == 1 ? 10 : 0, width = pass == 2 ? 10 : 11; const unsigned mask = (1u << width) - 1u;
            HIST[tid] = 0u; HIST[tid + 512] = 0u; HIST[tid + 1024] = 0u; HIST[tid + 1536] = 0u;
            WG_SYNC();
            for (int i = tid; i < n; i += NTHR) { const unsigned k = VALS[VPH(i)]; if (pass == 0 || (k >> (shift + width)) == prefix) atomicAdd(&HIST[(k >> shift) & mask], 1u); }
            WG_SYNC();
            if (F.wave == 0) {
                const int ln = F.lane; unsigned sl = 0u;
#pragma unroll 8
                for (int q = 0; q < 32; ++q) sl += HIST[32 * ln + ((q + ln) & 31)];
                unsigned suf = sl;
#pragma unroll
                for (int o = 1; o < 64; o <<= 1) { const unsigned t = __shfl_down(suf, o); if (ln + o < 64) suf += t; }
                const unsigned above = suf - sl;
                if (above < remaining && remaining <= above + sl) { unsigned cum = above; int bsel = 0;
                    for (int q = 31; q >= 0; --q) { const unsigned h = HIST[32 * ln + q]; if (cum + h >= remaining) { bsel = q; break; } cum += h; }
                    BC[0] = (unsigned)(32 * ln + bsel); BC[1] = remaining - cum; } }
            WG_SYNC();
            prefix = (prefix << width) | BC[0]; remaining = BC[1];
            WG_SYNC();
        }
        const unsigned thr = prefix, need_eq = remaining;
        unsigned cgt = 0u, ceq = 0u;
        for (int i = 0; i < vpt; ++i) { const unsigned k = VALS[VPH(tid * vpt + i)]; cgt += k > thr; ceq += k == thr; }
        unsigned gtb, eqb;
        {
          unsigned ia = cgt, ib = ceq;
#pragma unroll
          for (int o = 1; o < 64; o <<= 1) { const unsigned ta = __shfl_up(ia, o), tb = __shfl_up(ib, o); if (F.lane >= o) { ia += ta; ib += tb; } }
          if (F.lane == 63) { SC[F.wave] = ia; SC[8 + F.wave] = ib; }
          WG_SYNC();
          unsigned oa = 0u, ob = 0u;
#pragma unroll
          for (int w = 0; w < 8; ++w) { const unsigned xa = SC[w], xb = SC[8 + w]; if (w < F.wave) { oa += xa; ob += xb; } }
          gtb = oa + ia - cgt; eqb = ob + ib - ceq;
          WG_SYNC(); }
        const int xbase = e * XE_PER_E + (tr ? 1024 : 0);
        for (int i = 0; i < vpt; ++i) { const int ix = tid * vpt + i; const unsigned k = VALS[VPH(ix)];
            const bool sel = k > thr || (k == thr && eqb < need_eq);
            const unsigned slot = gtb + (eqb < need_eq ? eqb : need_eq);
            int xr = -1;
            if (sel) { xr = xbase + (int)slot; IDX[xr] = base + ix; GATE[xr] = __uint_as_float(k); XRS[xr] = RSC[base + ix]; }
            VALS[VPH(ix)] = (unsigned)xr;
            gtb += k > thr; eqb += k == thr; }
        WG_SYNC();
        for (int i = tid; i < n; i += NTHR) SLOT[(size_t)e * M + base + i] = (int)VALS[VPH(i)];
    }
    WG_SYNC();
}
__device__ __forceinline__ void gather_phase(Frame& F) {
    const int gw = F.vcu * NWAVES + F.wave, NGW = F.G * NWAVES, lane = F.lane;
    const int* IDX = (const int*)(F.ws + WS_IDX); const bfu* XN = (const bfu*)(F.ws + WS_XN); bfu* XE = (bfu*)(F.ws + WS_PROJ);
    for (int xr = gw; xr < XE_ROWS; xr += NGW) { const int tok = IDX[xr]; const v4u* src = (const v4u*)(XN + (size_t)tok * D); v4u* dst = (v4u*)(XE + (size_t)xr * D);
        v4u a = src[lane], b = src[64 + lane], c = src[128 + lane], d = src[192 + lane]; dst[lane] = a; dst[64 + lane] = b; dst[128 + lane] = c; dst[192 + lane] = d; }
}
__device__ __forceinline__ void ln2_phase(Frame& F, int l) {
    const int gw = F.vcu * NWAVES + F.wave, NGW = F.G * NWAVES, lane = F.lane;
    const float* g = F.in[20] + l * D; const float* b = F.in[21] + l * D;
    const int* SLOT = (const int*)(F.ws + WS_SLOT); const unsigned char* YE = F.ws + WS_PROJ;
    const bool poison = (l + 1 == DEPTH) && __hip_atomic_load(F.ctl + CW_BAR + XB_TMO, RLX_AGENT) != 0u; const float qnan = __builtin_nanf("");
    const bfu* XNb = (const bfu*)(F.ws + WS_XN);
    v4u px[4]; int pxs = -1;
#pragma unroll
    for (int j = 0; j < 4; ++j) px[j] = (v4u){0u, 0u, 0u, 0u};
    if (gw < M) { pxs = lane < 16 ? SLOT[(size_t)lane * M + gw] : -1;
#pragma unroll
        for (int j = 0; j < 4; ++j) px[j] = *(const v4u*)(XNb + (size_t)gw * D + 8 * lane + 512 * j); }
    for (int m = gw; m < M; m += NGW) {
        bfu* xn = (bfu*)(F.ws + WS_XN) + (size_t)m * D;
        f32x4 v[8];
#pragma unroll
        for (int j = 0; j < 4; ++j) { const v4u x = px[j];
            v[2 * j] = (f32x4){__uint_as_float(x.x << 16) * DN_ALPHA, __uint_as_float(x.x & 0xffff0000u) * DN_ALPHA, __uint_as_float(x.y << 16) * DN_ALPHA, __uint_as_float(x.y & 0xffff0000u) * DN_ALPHA};
            v[2 * j + 1] = (f32x4){__uint_as_float(x.z << 16) * DN_ALPHA, __uint_as_float(x.z & 0xffff0000u) * DN_ALPHA, __uint_as_float(x.w << 16) * DN_ALPHA, __uint_as_float(x.w & 0xffff0000u) * DN_ALPHA}; }
        const int xs = pxs;
        if (m + NGW < M) { pxs = lane < 16 ? SLOT[(size_t)lane * M + m + NGW] : -1;
#pragma unroll
            for (int j = 0; j < 4; ++j) px[j] = *(const v4u*)(XNb + (size_t)(m + NGW) * D + 8 * lane + 512 * j); }
        unsigned long long mask = __ballot(xs >= 0);
        while (mask) {
            const int e1 = __builtin_ctzll(mask); mask &= mask - 1ull; const int xr1 = __builtin_amdgcn_readlane(xs, e1);
            if (mask) { const int e2 = __builtin_ctzll(mask); mask &= mask - 1ull; const int xr2 = __builtin_amdgcn_readlane(xs, e2);
                pg8::u32x2 a_[4], b_[4];
#pragma unroll
                for (int j = 0; j < 4; ++j) { a_[j] = *(const pg8::u32x2*)(YE + (size_t)xr1 * D + 8 * lane + 512 * j); b_[j] = *(const pg8::u32x2*)(YE + (size_t)xr2 * D + 8 * lane + 512 * j); }
#pragma unroll
                for (int j = 0; j < 4; ++j) {
                    const pg8::f32x2 a0 = __builtin_amdgcn_cvt_pk_f32_fp8(a_[j].x, false), a1 = __builtin_amdgcn_cvt_pk_f32_fp8(a_[j].x, true), a2 = __builtin_amdgcn_cvt_pk_f32_fp8(a_[j].y, false), a3 = __builtin_amdgcn_cvt_pk_f32_fp8(a_[j].y, true);
                    const pg8::f32x2 b0 = __builtin_amdgcn_cvt_pk_f32_fp8(b_[j].x, false), b1 = __builtin_amdgcn_cvt_pk_f32_fp8(b_[j].x, true), b2 = __builtin_amdgcn_cvt_pk_f32_fp8(b_[j].y, false), b3 = __builtin_amdgcn_cvt_pk_f32_fp8(b_[j].y, true);
                    const float sc = 1.f / YE_SCALE;
                    v[2 * j].x += (a0.x + b0.x) * sc; v[2 * j].y += (a0.y + b0.y) * sc; v[2 * j].z += (a1.x + b1.x) * sc; v[2 * j].w += (a1.y + b1.y) * sc;
                    v[2 * j + 1].x += (a2.x + b2.x) * sc; v[2 * j + 1].y += (a2.y + b2.y) * sc; v[2 * j + 1].z += (a3.x + b3.x) * sc; v[2 * j + 1].w += (a3.y + b3.y) * sc; }
            } else row_add_fp8(YE + (size_t)xr1 * D, v, lane, 1.f / YE_SCALE);
        }
        ln_norm(v, g, b, lane);
        if (poison) {
#pragma unroll
            for (int j = 0; j < 8; ++j) v[j] = (f32x4){qnan, qnan, qnan, qnan}; }
        if (l + 1 < DEPTH) { row_store_bf16(xn, v, lane); row_store_i8(F.ws + WS_XNI8 + (size_t)m * D, (float*)(F.ws + WS_RSC) + m, v, lane); } else row_store_f32(F.X + (size_t)m * D, v, lane);
    }
}


constexpr int NPL = 11, NPH = 1 + DEPTH * NPL;
#if defined(PROBE_CONSIST)
__device__ __forceinline__ void chk_region(Frame& F, const void* base, size_t bytes, unsigned long long* dst, unsigned long long salt) {
    const unsigned* buf = (const unsigned*)base; const size_t nwords = bytes / 4;
    unsigned long long acc = 0ull;
    for (size_t i = (size_t)F.vcu * NTHR + F.tid; i < nwords; i += (size_t)F.G * NTHR) acc += (unsigned long long)buf[i] * (2ull * i + 1ull + salt);
    for (int o = 1; o < 64; o <<= 1) acc += __shfl_xor(acc, o);
    if (F.lane == 0) atomicAdd(dst, acc);
}
__device__ __forceinline__ void probe_chk(Frame& F, int run, int ph) {
    unsigned long long* dst = (unsigned long long*)(F.ws + 512 * 1024) + run * 32 + ph;
    unsigned char* ws = F.ws; const int k = ph == 0 ? -1 : (ph - 1) % NPL;
    if (ph == 0) { chk_region(F, ws + WS_WIN, WS_XN - WS_WIN, dst, 1); chk_region(F, F.X, (size_t)M * D * 4, dst, 3); chk_region(F, ws + WS_XN, (size_t)M * D * 2, dst, 5); }
    else if (k == 0) chk_region(F, ws + WS_PROJ, (size_t)M * PP * 2, dst, 7);
    else if (k == 1) { chk_region(F, ws + WS_PROJ, (size_t)M * PP * 2, dst, 7); chk_region(F, ws + WS_HID, (size_t)NCHUNK * 8 * 8192 * 4, dst, 9); chk_region(F, ws + WS_ADEC, (size_t)NCHUNK * 8 * 64 * 4, dst, 11); }
    else if (k == 2) {
        { const unsigned* buf = (const unsigned*)(ws + WS_MIX); unsigned long long accA = 0ull, accB = 0ull;
          for (size_t i = (size_t)F.vcu * NTHR + F.tid; i < (size_t)M * D / 2; i += (size_t)F.G * NTHR) { const int cw = (int)(i % (D / 2)); const unsigned long long t = (unsigned long long)buf[i] * (2ull * i + 1ull);
              if (cw < 384) accA += t; else if (cw < 768) accB += t; }
          for (int o = 1; o < 64; o <<= 1) { accA += __shfl_xor(accA, o); accB += __shfl_xor(accB, o); }
          if (F.lane == 0) { atomicAdd(dst, accA); atomicAdd(dst + 1, accB); } }
        chk_region(F, ws + WS_HID, (size_t)NCHUNK * 8 * 8192 * 4, dst + 2, 9); chk_region(F, ws + WS_LSE, (size_t)M * 6 * 4, dst + 3, 15); }
    else if (k == 3) chk_region(F, ws + WS_MIX, (size_t)M * D * 2, dst, 13);
    else if (k == 4) chk_region(F, F.X, (size_t)M * D * 4, dst, 3);
    else if (k == 5) { chk_region(F, F.X, (size_t)M * D * 4, dst, 3); chk_region(F, ws + WS_XN, (size_t)M * D * 2, dst, 5); chk_region(F, ws + WS_AFFT, (size_t)16 * M * 4, dst, 17); }
    else if (k == 6) { chk_region(F, ws + WS_SLOT, (size_t)16 * M * 4, dst, 19); chk_region(F, ws + WS_IDX, (size_t)XE_ROWS * 4, dst, 21); chk_region(F, ws + WS_GATE, (size_t)XE_ROWS * 4, dst, 23); }
    else if (k == 7) chk_region(F, ws + WS_PROJ, (size_t)XE_ROWS * D * 2, dst, 25);
    else if (k == 8) chk_region(F, ws + WS_HID, (size_t)XE_ROWS * DFF * 2, dst, 27);
    else if (k == 9) chk_region(F, ws + WS_PROJ, (size_t)XE_ROWS * D * 2, dst, 25);
    else if (k == 10) chk_region(F, F.X, (size_t)M * D * 4, dst, 3);
}
__device__ __forceinline__ void probe_report(Frame& F, int R, int n_out) {
    const unsigned long long* chk = (const unsigned long long*)(F.ws + 512 * 1024);
    int first = 99;
    for (int r = 1; r < R; ++r) for (int p = 0; p < NPH; ++p) if (__hip_atomic_load(chk + r * 32 + p, __ATOMIC_RELAXED, __HIP_MEMORY_SCOPE_AGENT) != __hip_atomic_load(chk + p, __ATOMIC_RELAXED, __HIP_MEMORY_SCOPE_AGENT)) { if (p < first) first = p; break; }
    const float c = first == 99 ? 2.0f : 3.0f + (float)first;
    for (long i = (long)F.vcu * NTHR + F.tid; i < n_out; i += (long)F.G * NTHR) F.X[i] = c;
}
#endif
struct Args { const float* in[22]; float* out; unsigned char* ws; int ph_lo, ph_hi, run, pad; };
#define KARG_RUN() (((const Args __attribute__((address_space(4)))*)__builtin_amdgcn_kernarg_segment_ptr())->run)
__global__ void __launch_bounds__(NWAVES * 64, 2) trunk_fwd(Args args) {
    extern __shared__ __attribute__((aligned(16))) unsigned char lds[];
    Frame F;
    F.lds = (LAS unsigned char*)lds; F.ldsg = (char*)lds;
    F.MISC = (volatile LAS unsigned*)(F.lds + MISC_OFF);
    F.tid = threadIdx.x; F.lane = F.tid & 63; F.wave = __builtin_amdgcn_readfirstlane(F.tid >> 6);
#define KAS __attribute__((address_space(4)))
#define REFRESH() do { const unsigned char KAS* ka_ = (const unsigned char KAS*)__builtin_amdgcn_kernarg_segment_ptr(); asm volatile("" : "+s"(ka_)); const Args KAS* ap_ = (const Args KAS*)ka_; \
    _Pragma("unroll") for (int i_ = 0; i_ < 22; ++i_) F.in[i_] = ap_->in[i_]; F.X = ap_->out; F.ws = ap_->ws; F.ctl = (gu32*)(F.ws + WS_CTL); \
    F.tid = threadIdx.x; asm volatile("" : "+v"(F.tid)); F.lane = F.tid & 63; F.wave = __builtin_amdgcn_readfirstlane(F.tid >> 6); \
    { int bx_ = blockIdx.x, g_ = gridDim.x; asm volatile("" : "+s"(bx_), "+s"(g_)); F.G = g_; F.bx = bx_; F.vcu = (g_ % 8 == 0) ? (bx_ % 8) * (g_ / 8) + bx_ / 8 : bx_; } } while (0)
    REFRESH();
    for (int u = F.tid; u < (LDS_BYTES - LDSCTL_OFF) / 4; u += NWAVES * 64) ((LAS unsigned*)(F.lds + LDSCTL_OFF))[u] = 0u;
    __syncthreads();
#if MK_FIXED_RANGE
    const bool multi = true;
#else
    const int lo = args.ph_lo, hi = args.ph_hi;
    const bool multi = (hi - lo) > 1;
#endif
    XcdBarrier bar; bar.bar = (unsigned*)(F.ctl + CW_BAR) + args.run * XCD_BAR_WORDS; bar.x = 0; bar.st = nullptr;
    if (multi) bar = xcd_barrier_post((unsigned*)(F.ctl + CW_BAR) + args.run * XCD_BAR_WORDS, F.MISC + 8);
#ifndef TIMING_DUP
#define TIMING_DUP 0
#endif
#ifndef PHASE_MASK
#define PHASE_MASK 0xFFFFFFFFu
#endif
#define PM(b) ((PHASE_MASK >> (b)) & 1u)
#if MK_FIXED_RANGE
#define IN(k) true
#else
#define IN(k) (lo <= (k) && (k) < hi)
#endif
#if defined(PROBE_CONSIST)
#define SEAM(k) do { if (IN(k)) { xcd_barrier(bar); REFRESH(); probe_chk(F, KARG_RUN(), (k)); if (IN((k) + 1)) xcd_barrier(bar); } } while (0)
#else
#define SEAM(k) do { if (IN(k) && IN((k) + 1)) xcd_barrier(bar); } while (0)
#endif
#define XN_ ((bfu*)(F.ws + WS_XN))
#define PROJ_ ((bfu*)(F.ws + WS_PROJ))
#define MIX_ ((bfu*)(F.ws + WS_MIX))
#define HID_ ((bfu*)(F.ws + WS_HID))

    if (IN(0) && PM(0)) { REFRESH(); p0_prologue(F);
#if (TIMING_DUP & 32)
        __syncthreads(); p0_prologue(F);
#endif
    } SEAM(0);
    {
        constexpr int l = 0; constexpr int pb = 1 + l * NPL;
        if (IN(pb + 0) && PM(1)) { REFRESH();
            const bool split = (l == 0) && F.G > 2 * NCONV;
            const int GW = split ? F.G - NCONV : F.G;
            if (F.bx < GW) {
            {
              pg8::Gemm g{(const bfu*)(F.ws + WS_XNI8), (const bfu*)(F.ws + WS_WINI8 + l * WINI8_L), M, DIN_PAD, D / 2  , 0}; pg8::StaticOrder S; S.init(M, DIN_PAD, GW, F.bx);
              pg8::EpiProjI8 E{PROJ_, PP, DIN, 0, (const float*)(F.ws + WS_RSC), (const float*)(F.ws + WS_CSC) + l * DIN_PAD};
              pg8::gemm_phase<pg8::EpiProjI8, pg8::StaticOrder, true, true, false, false, true>(F.lds, g, S, E); }
            } else conv_worker(F, F.bx - GW, NCONV);
        } SEAM(pb + 0);
        if (IN(pb + 1) && PM(2)) { REFRESH(); if (PM(12)) { qk_prep(F, l); vt8_pass(F); } if (PM(13)) gla::c1_phase(F, l);
#if (TIMING_DUP & 8)
            gla::c1_phase(F, l);
#endif
            } SEAM(pb + 1);
        if (IN(pb + 2) && PM(3)) { REFRESH(); if (PM(14)) attn_a_phase(F);
#if (TIMING_DUP & 2)
            attn_a_phase(F);
#endif
            if (PM(15)) mixb::mixer_b_phase(F);
#if (TIMING_DUP & 4)
            mixb::mixer_b_phase(F);
#endif
            if (PM(16)) gla::c2_phase(F); } SEAM(pb + 2);
        if (IN(pb + 3) && PM(4)) { REFRESH(); if (PM(17)) gla::c3_phase(F, l);
#if (TIMING_DUP & 8)
            gla::c3_phase(F, l);
#endif
            } SEAM(pb + 3);
        if (IN(pb + 4) && PM(5)) { REFRESH();
            mixb::mix_row_pass(F); xcd_barrier(bar); REFRESH();
            pg8::Gemm g{(const bfu*)(F.ws + WS_MIXI8), (const bfu*)(F.ws + WS_WOUTI8 + l * WOUTI8_L), M, D, D / 2  , 0}; pg8::StaticOrder S; S.init(M, D, F.G, F.bx);
            pg8::EpiProjI8 E{HID_  , D, D, 0, (const float*)(F.ws + WS_RSC2), (const float*)(F.ws + WS_CSC2) + l * D};
            pg8::gemm_phase<pg8::EpiProjI8, pg8::StaticOrder, true, true, false, false, true>(F.lds, g, S, E);
        } SEAM(pb + 4);
        if (IN(pb + 5) && PM(6)) { REFRESH(); ln1_router_phase(F, l); } SEAM(pb + 5);
        if (IN(pb + 6) && PM(7)) { REFRESH(); topk_phase(F);
#if (TIMING_DUP & 16)
            topk_phase(F);
#endif
            if (F.G <= 32) conv_window(F, l, F.vcu, F.G); else if (F.vcu >= 32) conv_window(F, l, F.vcu - 32, F.G - 32);
            } SEAM(pb + 6);
        if (IN(pb + 8) && PM(9)) { REFRESH();
            pg8::Gemm g{(const bfu*)(F.ws + WS_XNI8)  , (const bfu*)(F.ws + WS_WGU + l * WGU_L), XE_ROWS, 2 * DFF, D / 2  , WGU_E}; pg8::StaticOrder S; S.init(XE_ROWS, 2 * DFF, F.G, F.bx, XE_PER_E / 256);
            pg8::EpiSwiGLUI8 E{F.ws + WS_HID, DFF, (const float*)(F.ws + WS_XRS), (const float*)(F.ws + WS_CSCGU) + (size_t)l * NEXP * 4096};
            pg8::gemm_phase<pg8::EpiSwiGLUI8, pg8::StaticOrder, true, true, true, false, true>(F.lds, g, S, E, (const int*)(F.ws + WS_IDX));
#if (TIMING_DUP & 1)
            __syncthreads(); pg8::gemm_phase<pg8::EpiSwiGLU8, pg8::StaticOrder, true, true, true, true>(F.lds, g, S, E, (const int*)(F.ws + WS_IDX));
#endif
        } SEAM(pb + 8);
        if (IN(pb + 9) && PM(10)) { REFRESH();
#if defined(NOP_SLED)
            asm volatile(".rept 16384\n s_nop 0\n .endr" ::: "memory");
#endif
            pg8::Gemm g{HID_  , (const bfu*)(F.ws + WS_WD + l * WD_L), XE_ROWS, D, DFF / 2  , WD_E}; pg8::StaticOrder S; S.init(XE_ROWS, D, F.G, F.bx, XE_PER_E / 256);
            pg8::EpiGate8 E{F.ws + WS_PROJ  , D, (const float*)(F.ws + WS_GATE), YE_SCALE / WD_SCALE};
            pg8::gemm_phase<pg8::EpiGate8, pg8::StaticOrder, true, true, false, true>(F.lds, g, S, E);
#if (TIMING_DUP & 1)
            __syncthreads(); pg8::gemm_phase<pg8::EpiGate8, pg8::StaticOrder, true, true, false, true>(F.lds, g, S, E);
#endif
        } SEAM(pb + 9);
        if (IN(pb + 10) && PM(11)) { REFRESH(); ln2_phase(F, l); } SEAM(pb + 10);
    }
    {
        constexpr int l = 1; constexpr int pb = 1 + l * NPL;
        if (IN(pb + 0) && PM(1)) { REFRESH();
            const bool split = (l == 0) && F.G > 2 * NCONV;
            const int GW = split ? F.G - NCONV : F.G;
            if (F.bx < GW) {
            {
              pg8::Gemm g{(const bfu*)(F.ws + WS_XNI8), (const bfu*)(F.ws + WS_WINI8 + l * WINI8_L), M, DIN_PAD, D / 2  , 0}; pg8::StaticOrder S; S.init(M, DIN_PAD, GW, F.bx);
              pg8::EpiProjI8 E{PROJ_, PP, DIN, 0, (const float*)(F.ws + WS_RSC), (const float*)(F.ws + WS_CSC) + l * DIN_PAD};
              pg8::gemm_phase<pg8::EpiProjI8, pg8::StaticOrder, true, true, false, false, true>(F.lds, g, S, E); }
            } else conv_worker(F, F.bx - GW, NCONV);
        } SEAM(pb + 0);
        if (IN(pb + 1) && PM(2)) { REFRESH(); if (PM(12)) { qk_prep(F, l); vt8_pass(F); } if (PM(13)) gla::c1_phase(F, l);
#if (TIMING_DUP & 8)
            gla::c1_phase(F, l);
#endif
            } SEAM(pb + 1);
        if (IN(pb + 2) && PM(3)) { REFRESH(); if (PM(14)) attn_a_phase(F);
#if (TIMING_DUP & 2)
            attn_a_phase(F);
#endif
            if (PM(15)) mixb::mixer_b_phase(F);
#if (TIMING_DUP & 4)
            mixb::mixer_b_phase(F);
#endif
            if (PM(16)) gla::c2_phase(F); } SEAM(pb + 2);
        if (IN(pb + 3) && PM(4)) { REFRESH(); if (PM(17)) gla::c3_phase(F, l);
#if (TIMING_DUP & 8)
            gla::c3_phase(F, l);
#endif
            } SEAM(pb + 3);
        if (IN(pb + 4) && PM(5)) { REFRESH();
            mixb::mix_row_pass(F); xcd_barrier(bar); REFRESH();
            pg8::Gemm g{(const bfu*)(F.ws + WS_MIXI8), (const bfu*)(F.ws + WS_WOUTI8 + l * WOUTI8_L), M, D, D / 2  , 0}; pg8::StaticOrder S; S.init(M, D, F.G, F.bx);
            pg8::EpiProjI8 E{HID_  , D, D, 0, (const float*)(F.ws + WS_RSC2), (const float*)(F.ws + WS_CSC2) + l * D};
            pg8::gemm_phase<pg8::EpiProjI8, pg8::StaticOrder, true, true, false, false, true>(F.lds, g, S, E);
        } SEAM(pb + 4);
        if (IN(pb + 5) && PM(6)) { REFRESH(); ln1_router_phase(F, l); } SEAM(pb + 5);
        if (IN(pb + 6) && PM(7)) { REFRESH(); topk_phase(F);
#if (TIMING_DUP & 16)
            topk_phase(F);
#endif
            if (F.G <= 32) conv_window(F, l, F.vcu, F.G); else if (F.vcu >= 32) conv_window(F, l, F.vcu - 32, F.G - 32);
            } SEAM(pb + 6);
        if (IN(pb + 8) && PM(9)) { REFRESH();
            pg8::Gemm g{(const bfu*)(F.ws + WS_XNI8)  , (const bfu*)(F.ws + WS_WGU + l * WGU_L), XE_ROWS, 2 * DFF, D / 2  , WGU_E}; pg8::StaticOrder S; S.init(XE_ROWS, 2 * DFF, F.G, F.bx, XE_PER_E / 256);
            pg8::EpiSwiGLUI8 E{F.ws + WS_HID, DFF, (const float*)(F.ws + WS_XRS), (const float*)(F.ws + WS_CSCGU) + (size_t)l * NEXP * 4096};
            pg8::gemm_phase<pg8::EpiSwiGLUI8, pg8::StaticOrder, true, true, true, false, true>(F.lds, g, S, E, (const int*)(F.ws + WS_IDX));
#if (TIMING_DUP & 1)
            __syncthreads(); pg8::gemm_phase<pg8::EpiSwiGLU8, pg8::StaticOrder, true, true, true, true>(F.lds, g, S, E, (const int*)(F.ws + WS_IDX));
#endif
        } SEAM(pb + 8);
        if (IN(pb + 9) && PM(10)) { REFRESH();
#if defined(NOP_SLED)
            asm volatile(".rept 16384\n s_nop 0\n .endr" ::: "memory");
#endif
            pg8::Gemm g{HID_  , (const bfu*)(F.ws + WS_WD + l * WD_L), XE_ROWS, D, DFF / 2  , WD_E}; pg8::StaticOrder S; S.init(XE_ROWS, D, F.G, F.bx, XE_PER_E / 256);
            pg8::EpiGate8 E{F.ws + WS_PROJ  , D, (const float*)(F.ws + WS_GATE), YE_SCALE / WD_SCALE};
            pg8::gemm_phase<pg8::EpiGate8, pg8::StaticOrder, true, true, false, true>(F.lds, g, S, E);
#if (TIMING_DUP & 1)
            __syncthreads(); pg8::gemm_phase<pg8::EpiGate8, pg8::StaticOrder, true, true, false, true>(F.lds, g, S, E);
#endif
        } SEAM(pb + 9);
        if (IN(pb + 10) && PM(11)) { REFRESH(); ln2_phase(F, l); } SEAM(pb + 10);
    }
#undef IN
#undef SEAM
}


#if defined(PROBE_CONSIST)
__global__ void __launch_bounds__(256) chk_report(const unsigned long long* chk, int R, int nph, float* out, int n_out) {
    int first = 99;
    for (int r = 1; r < R; ++r) for (int p = 0; p < nph; ++p) if (chk[r * 32 + p] != chk[p]) { if (p < first) first = p; break; }
    const float c = first == 99 ? 2.0f : 3.0f + (float)first;
    for (long i = (long)blockIdx.x * 256 + threadIdx.x; i < n_out; i += (long)gridDim.x * 256) out[i] = c;
}
#endif
#ifndef MK_ONE_LAUNCH
#define MK_ONE_LAUNCH 1
#endif
extern "C" void kernel_launch(void* const* d_in, const int* in_sizes, int n_in, void* d_out, int out_size, void* d_ws, size_t ws_size, hipStream_t stream) {
    static int grid = 0;
    if (grid == 0) {
        if (n_in != 22 || out_size != M * D || ws_size < WS_END) { fprintf(stderr, "kernel_launch: shape mismatch (n_in %d out %d ws %zu, need ws >= %zu); nothing launched\n", n_in, out_size, ws_size, (size_t)WS_END); grid = -1; return; }
        int dev = 0, cus = 0, per_cu = 0;
        if (hipGetDevice(&dev) != hipSuccess || hipDeviceGetAttribute(&cus, hipDeviceAttributeMultiprocessorCount, dev) != hipSuccess) { grid = -1; return; }
        if (hipFuncSetAttribute((const void*)trunk_fwd, hipFuncAttributeMaxDynamicSharedMemorySize, LDS_BYTES) != hipSuccess) { fprintf(stderr, "kernel_launch: hipFuncSetAttribute failed\n"); grid = -1; return; }
        if (hipOccupancyMaxActiveBlocksPerMultiprocessor(&per_cu, (const void*)trunk_fwd, NWAVES * 64, LDS_BYTES) != hipSuccess || per_cu < 1)
            fprintf(stderr, "kernel_launch: note: occupancy query reports %d workgroups per CU\n", per_cu);
        (void)hipGetLastError();
        grid = cus;
    }
    if (grid < 0) return;
#if defined(PROBE_POISON)
    (void)hipMemsetAsync((char*)d_ws + 2 * MiB, 0xAA, WS_END - 2 * MiB, stream); (void)hipMemsetAsync(d_out, 0xAA, (size_t)M * D * 4, stream);
#endif
    if (hipMemsetAsync((char*)d_ws + WS_CTL, 0, CTL_ZERO_BYTES, stream) != hipSuccess) return;
    Args a{};
    for (int i = 0; i < 22; ++i) a.in[i] = (const float*)d_in[i];
    a.out = (float*)d_out; a.ws = (unsigned char*)d_ws;
#ifndef CUT_MASK
#define CUT_MASK 0u
#endif
#if defined(PROBE_CONSIST)
    for (int r = 0; r < PROBE_CONSIST; ++r) { a.ph_lo = 0; a.ph_hi = NPH; a.run = r; hipLaunchKernelGGL(trunk_fwd, dim3(grid), dim3(NWAVES * 64), LDS_BYTES, stream, a); }
    hipLaunchKernelGGL(chk_report, dim3(1024), dim3(256), 0, stream, (const unsigned long long*)((char*)d_ws + 512 * 1024), (int)PROBE_CONSIST, NPH, (float*)d_out, out_size);
#else
    { int lo = 0;
      for (int ph = 0; ph < NPH; ++ph) {
          const bool cut = (ph == NPH - 1) || ((CUT_MASK >> ph) & 1u) || !MK_ONE_LAUNCH;
          if (cut) { a.ph_lo = lo; a.ph_hi = ph + 1; if (lo != 0 && ph + 1 - lo > 1) (void)hipMemsetAsync((char*)d_ws + WS_CTL, 0, CTL_ZERO_BYTES, stream); hipLaunchKernelGGL(trunk_fwd, dim3(grid), dim3(NWAVES * 64), LDS_BYTES, stream, a); lo = ph + 1; }
      } }

#endif
    const hipError_t le = hipPeekAtLastError();
    if (le != hipSuccess) fprintf(stderr, "kernel_launch: launch failed: %s\n", hipGetErrorName(le));
}
```

```cpp
#include <hip/hip_runtime.h>
#include <hip/hip_bf16.h>
#include <cstdio>
#include <cstdint>
#include <cmath>

constexpr int D = 2048, TP = 8192, NSAMP = 16, TS = 2048, M = TP + NSAMP * TS  , DEPTH = 2;
constexpr int DIN = 5152, DIN_PAD = 5376, PP = 5152  ;
constexpr int C_AQ = 0, C_AK = 768, C_AV = 1024, C_BQ = 1280, C_BK = 2048, C_BV = 2816, C_CQ = 3584, C_CK = 3840, C_CV = 4096, C_CG = 4608, C_ZF = 5120, C_ZB = 5136;
constexpr int MIX_B = 768, MIX_C = 1536;
constexpr int NEXP = 16, XE_PER_E = 5120  , XE_ROWS = NEXP * XE_PER_E, DFF = 2048;
constexpr float LN_EPS = 1e-5f, RMS_EPS = 1e-6f, DN_ALPHA = 1.41421356237309515f  ;
constexpr int NCHUNK = M / 64;
__host__ __device__ __forceinline__ int seq_start(int s) { return s == 0 ? 0 : TP + (s - 1) * TS; }
__host__ __device__ __forceinline__ int seq_len(int s) { return s == 0 ? TP : TS; }
namespace pg8 {
#define PG8_LAS __attribute__((address_space(3)))
typedef unsigned short bf16_t;
typedef short bf16x8 __attribute__((ext_vector_type(8)));
typedef float f32x4 __attribute__((ext_vector_type(4)));
typedef unsigned u32x4 __attribute__((ext_vector_type(4)));
constexpr int BM = 256, BK = 64, HALF = 128, HTB = HALF * BK * 2  , STAGE_BYTES = 8 * HTB, NXCD = 8, WGM = 8;

__host__ __device__ __forceinline__ int lds_byte(int r, int c) { const int st = (r >> 4) * 2 + (c >> 5), rr = r & 15, cc = c & 31, ob = rr * 64 + cc * 2; return st * 1024 + (ob ^ (((ob >> 9) & 1) << 5)); }
__host__ __device__ __forceinline__ void stage_rc(int b, int& R, int& C) { const int st = b / 1024, sb = b % 1024, swz = sb ^ (((sb >> 9) & 1) << 5); R = (st >> 1) * 16 + swz / 64; C = (st & 1) * 32 + (swz % 64) / 2; }
__host__ __device__ __forceinline__ int perm32(int rho) { const int n = rho >> 4, i = rho & 15; return 8 * (i >> 2) + 4 * n + (i & 3); }
typedef int i32x4_t __attribute__((ext_vector_type(4)));
typedef float f32x2 __attribute__((ext_vector_type(2)));
typedef int i32x8_t __attribute__((ext_vector_type(8)));
struct Unit { int pm, pn, e; };
struct Gemm { const bf16_t* A; const bf16_t* Bt; int M, N, K; size_t bstride; };

struct StaticOrder {
    int nM, nN, nwg, G, c, tpe; int same = 0;
    __host__ __device__ void init(int M, int N, int G_, int c_, int tpe_ = 0) { nM = M / BM; nN = N / BM; nwg = nM * nN; G = G_; c = c_; tpe = tpe_; }
    __host__ __device__ bool next(int i, Unit& u) const {
        const long L = same ? (i < same ? (long)c : (long)nwg) : (long)i * G + c; if (L >= nwg) return false;
        int wgid = (int)L; { const int q = nwg / NXCD, r = nwg % NXCD, xcd = wgid % NXCD, off = wgid / NXCD; wgid = (xcd < r ? xcd * (q + 1) : r * (q + 1) + (xcd - r) * q) + off; }
        const int nig = WGM * nN, gid = wgid / nig, fm = gid * WGM, gsz = (nM - fm) < WGM ? (nM - fm) : WGM;
        u.pm = fm + ((wgid % nig) % gsz); u.pn = (wgid % nig) / gsz; u.e = tpe ? u.pm / tpe : 0; return true;
    }
    __device__ __forceinline__ void a_ready(const Unit&) const {}
    __device__ __forceinline__ void done(const Unit&) const {}
};
__device__ __forceinline__ unsigned cvt_pk_bf16(float lo, float hi) { unsigned r; asm volatile("v_cvt_pk_bf16_f32 %0, %1, %2" : "=v"(r) : "v"(lo), "v"(hi)); return r; }

struct EpiProj {
    static constexpr bool PERM = true, AFTER_DRAIN = false;
    bf16_t* O; int ldc; int nvalid;
    __device__ __forceinline__ void operator()(const f32x4 (&acc)[2][2][4][2], const Unit& u, int wr, int wc, int fr, int fq) const {
        const int row0 = u.pm * BM + wr * 64 + fr, col0 = u.pn * BM + wc * 32 + 8 * fq;
#pragma unroll
        for (int ai = 0; ai < 2; ++ai)
#pragma unroll
            for (int m = 0; m < 4; ++m) { bf16_t* rowp = O + (size_t)(row0 + ai * HALF + m * 16) * ldc + col0;
#pragma unroll
                for (int bj = 0; bj < 2; ++bj) { if (col0 + bj * HALF < nvalid) { const f32x4 v0 = acc[ai][bj][m][0], v1 = acc[ai][bj][m][1];
                    u32x4 w; w.x = cvt_pk_bf16(v0[0], v0[1]); w.y = cvt_pk_bf16(v0[2], v0[3]); w.z = cvt_pk_bf16(v1[0], v1[1]); w.w = cvt_pk_bf16(v1[2], v1[3]);
                    *(u32x4*)(rowp + bj * HALF) = w; } } }
    }
};
struct EpiResid {
    static constexpr bool PERM = false, AFTER_DRAIN = false;
    float* X; int ldc; float alpha;
    __device__ __forceinline__ void operator()(const f32x4 (&acc)[2][2][4][2], const Unit& u, int wr, int wc, int fr, int fq) const {
        const int row0 = u.pm * BM + wr * 64 + fr, col0 = u.pn * BM + wc * 32 + 4 * fq;
#pragma unroll
        for (int ai = 0; ai < 2; ++ai)
#pragma unroll
            for (int m = 0; m < 4; ++m) { float* rowp = X + (size_t)(row0 + ai * HALF + m * 16) * ldc + col0;
#pragma unroll
                for (int bj = 0; bj < 2; ++bj)
#pragma unroll
                    for (int n = 0; n < 2; ++n) { f32x4* p = (f32x4*)(rowp + bj * HALF + n * 16); const f32x4 x = *p; *p = x * alpha + acc[ai][bj][m][n]; } }
    }
};
__device__ __forceinline__ float silu_f(float g) { return g * __builtin_amdgcn_rcpf(1.0f + __builtin_amdgcn_exp2f(-1.4426950408889634f * g)); }
struct EpiSwiGLU {
    static constexpr bool PERM = true, AFTER_DRAIN = false;
    bf16_t* H; int ldc;
    __device__ __forceinline__ void operator()(const f32x4 (&acc)[2][2][4][2], const Unit& u, int wr, int wc, int fr, int fq) const {
        const int row0 = u.pm * BM + wr * 64 + fr, col0 = u.pn * HALF + wc * 32 + 8 * fq;
#pragma unroll
        for (int ai = 0; ai < 2; ++ai)
#pragma unroll
            for (int m = 0; m < 4; ++m) { bf16_t* rowp = H + (size_t)(row0 + ai * HALF + m * 16) * ldc + col0;
                const f32x4 g0 = acc[ai][0][m][0], g1 = acc[ai][0][m][1], u0 = acc[ai][1][m][0], u1 = acc[ai][1][m][1];
                float h[8];
#pragma unroll
                for (int i = 0; i < 4; ++i) { h[i] = silu_f(g0[i]) * u0[i]; h[4 + i] = silu_f(g1[i]) * u1[i]; }
                u32x4 w; w.x = cvt_pk_bf16(h[0], h[1]); w.y = cvt_pk_bf16(h[2], h[3]); w.z = cvt_pk_bf16(h[4], h[5]); w.w = cvt_pk_bf16(h[6], h[7]);
                *(u32x4*)rowp = w; }
    }
};
struct EpiGate {
    static constexpr bool PERM = true, AFTER_DRAIN = false;
    bf16_t* O; int ldc; const float* gate;
    __device__ __forceinline__ void operator()(const f32x4 (&acc)[2][2][4][2], const Unit& u, int wr, int wc, int fr, int fq) const {
        const int row0 = u.pm * BM + wr * 64 + fr, col0 = u.pn * BM + wc * 32 + 8 * fq;
#pragma unroll
        for (int ai = 0; ai < 2; ++ai)
#pragma unroll
            for (int m = 0; m < 4; ++m) { const int row = row0 + ai * HALF + m * 16; const float gt = gate[row]; bf16_t* rowp = O + (size_t)row * ldc + col0;
#pragma unroll
                for (int bj = 0; bj < 2; ++bj) { const f32x4 v0 = acc[ai][bj][m][0] * gt, v1 = acc[ai][bj][m][1] * gt;
                    u32x4 w; w.x = cvt_pk_bf16(v0[0], v0[1]); w.y = cvt_pk_bf16(v0[2], v0[3]); w.z = cvt_pk_bf16(v1[0], v1[1]); w.w = cvt_pk_bf16(v1[2], v1[3]);
                    *(u32x4*)(rowp + bj * HALF) = w; } }
    }
};

__device__ __forceinline__ unsigned cvt4_fp8(float a, float b, float c, float d) { unsigned w = 0u; w = __builtin_amdgcn_cvt_pk_fp8_f32(a, b, w, false); w = __builtin_amdgcn_cvt_pk_fp8_f32(c, d, w, true); return w; }
typedef unsigned u32x2 __attribute__((ext_vector_type(2)));
struct EpiSwiGLU8 {
    static constexpr bool PERM = true, AFTER_DRAIN = false;
    unsigned char* H; int ldc; float inv_ws;
    __device__ __forceinline__ void operator()(const f32x4 (&acc)[2][2][4][2], const Unit& u, int wr, int wc, int fr, int fq) const {
        const int row0 = u.pm * BM + wr * 64 + fr, col0 = u.pn * HALF + wc * 32 + 8 * fq;
#pragma unroll
        for (int ai = 0; ai < 2; ++ai)
#pragma unroll
            for (int m = 0; m < 4; ++m) { unsigned char* rowp = H + (size_t)(row0 + ai * HALF + m * 16) * ldc + col0;
                const f32x4 g0 = acc[ai][0][m][0] * inv_ws, g1 = acc[ai][0][m][1] * inv_ws, u0 = acc[ai][1][m][0] * inv_ws, u1 = acc[ai][1][m][1] * inv_ws;
                float h[8];
#pragma unroll
                for (int i = 0; i < 4; ++i) { h[i] = silu_f(g0[i]) * u0[i]; h[4 + i] = silu_f(g1[i]) * u1[i]; }
                u32x2 w; w.x = cvt4_fp8(h[0], h[1], h[2], h[3]); w.y = cvt4_fp8(h[4], h[5], h[6], h[7]);
                *(u32x2*)rowp = w; }
    }
};
struct EpiGate8 {
    static constexpr bool PERM = true, AFTER_DRAIN = false;
    unsigned char* O; int ldc; const float* gate; float inv_ws;
    bool nul = false;
    __device__ __forceinline__ void operator()(const f32x4 (&acc)[2][2][4][2], const Unit& u, int wr, int wc, int fr, int fq) const {
        if (nul) return;
        const int row0 = u.pm * BM + wr * 64 + fr, col0 = u.pn * BM + wc * 32 + 8 * fq;
#pragma unroll
        for (int ai = 0; ai < 2; ++ai)
#pragma unroll
            for (int m = 0; m < 4; ++m) { const int row = row0 + ai * HALF + m * 16; const float gt = gate[row] * inv_ws; unsigned char* rowp = O + (size_t)row * ldc + col0;
#pragma unroll
                for (int bj = 0; bj < 2; ++bj) { const f32x4 v0 = acc[ai][bj][m][0] * gt, v1 = acc[ai][bj][m][1] * gt;
                    u32x2 w; w.x = cvt4_fp8(v0[0], v0[1], v0[2], v0[3]); w.y = cvt4_fp8(v1[0], v1[1], v1[2], v1[3]);
                    *(u32x2*)(rowp + bj * HALF) = w; } }
    }
};
struct EpiProjS {
    static constexpr bool PERM = true, AFTER_DRAIN = false;
    bf16_t* O; int ldc; int nvalid; int colbase; float scale;
    __device__ __forceinline__ void operator()(const f32x4 (&acc)[2][2][4][2], const Unit& u, int wr, int wc, int fr, int fq) const {
        const int row0 = u.pm * BM + wr * 64 + fr, col0 = colbase + u.pn * BM + wc * 32 + 8 * fq;
#pragma unroll
        for (int ai = 0; ai < 2; ++ai)
#pragma unroll
            for (int m = 0; m < 4; ++m) { bf16_t* rowp = O + (size_t)(row0 + ai * HALF + m * 16) * ldc + col0;
#pragma unroll
                for (int bj = 0; bj < 2; ++bj) { if (col0 + bj * HALF < nvalid) { const f32x4 v0 = acc[ai][bj][m][0] * scale, v1 = acc[ai][bj][m][1] * scale;
                    u32x4 w; w.x = cvt_pk_bf16(v0[0], v0[1]); w.y = cvt_pk_bf16(v0[2], v0[3]); w.z = cvt_pk_bf16(v1[0], v1[1]); w.w = cvt_pk_bf16(v1[2], v1[3]);
                    *(u32x4*)(rowp + bj * HALF) = w; } } }
    }
};

struct EpiProjI8 {
    static constexpr bool PERM = true, AFTER_DRAIN = false;
    bf16_t* O; int ldc; int nvalid; int colbase; const float* rowscale; const float* colscale;
    __device__ __forceinline__ void operator()(const f32x4 (&acc)[2][2][4][2], const Unit& u, int wr, int wc, int fr, int fq) const {
        const int row0 = u.pm * BM + wr * 64 + fr, tcol0 = u.pn * BM + wc * 32 + 8 * fq, col0 = colbase + tcol0;
        f32x4 cs[2][2];
#pragma unroll
        for (int bj = 0; bj < 2; ++bj) { cs[bj][0] = *(const f32x4*)(colscale + tcol0 + bj * HALF); cs[bj][1] = *(const f32x4*)(colscale + tcol0 + bj * HALF + 4); }
#pragma unroll
        for (int ai = 0; ai < 2; ++ai)
#pragma unroll
            for (int m = 0; m < 4; ++m) { const int row = row0 + ai * HALF + m * 16; const float rs = rowscale[row]; bf16_t* rowp = O + (size_t)row * ldc + col0;
#pragma unroll
                for (int bj = 0; bj < 2; ++bj) { if (col0 + bj * HALF < nvalid) {
                    const i32x4_t a0 = __builtin_bit_cast(i32x4_t, acc[ai][bj][m][0]), a1 = __builtin_bit_cast(i32x4_t, acc[ai][bj][m][1]);
                    const f32x4 v0 = (f32x4){(float)a0[0], (float)a0[1], (float)a0[2], (float)a0[3]} * cs[bj][0] * rs, v1 = (f32x4){(float)a1[0], (float)a1[1], (float)a1[2], (float)a1[3]} * cs[bj][1] * rs;
                    u32x4 w; w.x = cvt_pk_bf16(v0[0], v0[1]); w.y = cvt_pk_bf16(v0[2], v0[3]); w.z = cvt_pk_bf16(v1[0], v1[1]); w.w = cvt_pk_bf16(v1[2], v1[3]);
                    *(u32x4*)(rowp + bj * HALF) = w; } } }
    }
};

struct EpiSwiGLUI8 {
    static constexpr bool PERM = true, AFTER_DRAIN = false;
    unsigned char* H; int ldc; const float* rowscale; const float* colscale;
    __device__ __forceinline__ void operator()(const f32x4 (&acc)[2][2][4][2], const Unit& u, int wr, int wc, int fr, int fq) const {
        const int row0 = u.pm * BM + wr * 64 + fr, tcol0 = u.pn * BM + wc * 32 + 8 * fq, col0 = u.pn * HALF + wc * 32 + 8 * fq;
        const float* cs = colscale + (size_t)u.e * 4096 + tcol0;
        const f32x4 cg0 = *(const f32x4*)cs, cg1 = *(const f32x4*)(cs + 4), cu0 = *(const f32x4*)(cs + HALF), cu1 = *(const f32x4*)(cs + HALF + 4);
#pragma unroll
        for (int ai = 0; ai < 2; ++ai)
#pragma unroll
            for (int m = 0; m < 4; ++m) { const int row = row0 + ai * HALF + m * 16; const float rs = rowscale[row]; unsigned char* rowp = H + (size_t)row * ldc + col0;
                const i32x4_t ig0 = __builtin_bit_cast(i32x4_t, acc[ai][0][m][0]), ig1 = __builtin_bit_cast(i32x4_t, acc[ai][0][m][1]), iu0 = __builtin_bit_cast(i32x4_t, acc[ai][1][m][0]), iu1 = __builtin_bit_cast(i32x4_t, acc[ai][1][m][1]);
                const f32x4 g0 = (f32x4){(float)ig0[0], (float)ig0[1], (float)ig0[2], (float)ig0[3]} * cg0 * rs, g1 = (f32x4){(float)ig1[0], (float)ig1[1], (float)ig1[2], (float)ig1[3]} * cg1 * rs;
                const f32x4 u0 = (f32x4){(float)iu0[0], (float)iu0[1], (float)iu0[2], (float)iu0[3]} * cu0 * rs, u1 = (f32x4){(float)iu1[0], (float)iu1[1], (float)iu1[2], (float)iu1[3]} * cu1 * rs;
                float h[8];
#pragma unroll
                for (int i = 0; i < 4; ++i) { h[i] = silu_f(g0[i]) * u0[i]; h[4 + i] = silu_f(g1[i]) * u1[i]; }
                u32x2 w; w.x = cvt4_fp8(h[0], h[1], h[2], h[3]); w.y = cvt4_fp8(h[4], h[5], h[6], h[7]);
                *(u32x2*)rowp = w; }
    }
};
template <class Epi, class Sched, bool ALIGN_EPI = false, bool SP2 = false, bool GATHER = false, bool FP8 = false, bool I8 = false>
__device__ __forceinline__ void gemm_phase(PG8_LAS unsigned char* lds, const Gemm g, const Sched& S, const Epi& E, const int* gidx = nullptr) {
    static_assert((!GATHER && !FP8) || SP2, "gathered A rows / fp8 operands: SP2 loop only");
    int tid_ = threadIdx.x; asm volatile("" : "+v"(tid_));
    const int tid = tid_, wid = __builtin_amdgcn_readfirstlane(tid >> 6), lane = tid & 63, wr = wid >> 2, wc = wid & 3, fr = lane & 15, fq = lane >> 4;
    const int K = g.K, nt = K / BK;
    unsigned voffA[2], voffB[2];
#pragma unroll
    for (int i = 0; i < 2; ++i) { int R, C; stage_rc(tid * 16 + i * 8192, R, C); const int Rb = Epi::PERM ? ((R & ~31) + perm32(R & 31)) : R;
        voffA[i] = (unsigned)(R * K + C) * 2u; voffB[i] = (unsigned)(Rb * K + C) * 2u; }
    PG8_LAS unsigned* gofs = (PG8_LAS unsigned*)(lds + STAGE_BYTES) + tid;
#define PG8_GVO(u, slot) do { _Pragma("unroll") for (int _i = 0; _i < 2; ++_i) { int R_, C_; stage_rc(tid * 16 + _i * 8192, R_, C_); \
        gofs[(((slot) * 2 + 0) * 2 + _i) * 512] = (unsigned)gidx[(u).pm * BM + R_] * (unsigned)(K * 2) + (unsigned)(C_ * 2); \
        gofs[(((slot) * 2 + 1) * 2 + _i) * 512] = (unsigned)gidx[(u).pm * BM + HALF + R_] * (unsigned)(K * 2) + (unsigned)(C_ * 2); } } while (0)
#define PG8_STAGE_A(bufoff, base, hh, slot) do { if constexpr (GATHER) { unsigned o_[2]; o_[0] = gofs[(((slot) * 2 + (hh)) * 2 + 0) * 512]; o_[1] = gofs[(((slot) * 2 + (hh)) * 2 + 1) * 512]; PG8_STAGE(bufoff, base, o_); } \
        else PG8_STAGE(bufoff, (base) + (hh) * hstep, voffA); } while (0)
    const size_t kstep = (size_t)(BK * 2);
    const size_t hstep = (size_t)HALF * K * 2;
    const size_t tstep = 2 * hstep;
    const unsigned ldsw = (unsigned)wid * 1024u;
    const int aoff = lds_byte(wr * 64 + fr, fq * 8), boff = lds_byte(wc * 32 + fr, fq * 8);
#define PG8_SA(b, h) (((b) * 2 + (h)) * HTB)
#define PG8_SB(b, h) ((4 + (b) * 2 + (h)) * HTB)
#define PG8_STAGE(bufoff, gbase, voff) do { _Pragma("unroll") for (int _i = 0; _i < 2; ++_i) \
        __builtin_amdgcn_global_load_lds((const unsigned*)((const char*)(gbase) + (voff)[_i]), (PG8_LAS unsigned*)(lds + (bufoff) + ldsw + _i * 8192), 16, 0, 0); } while (0)
#define PG8_LDA(dst, b, h) do { _Pragma("unroll") for (int m = 0; m < 4; ++m) _Pragma("unroll") for (int k = 0; k < 2; ++k) dst[m][k] = *(const PG8_LAS bf16x8*)(lds + PG8_SA(b, h) + aoff + m * 2048 + k * 1024); } while (0)
#define PG8_LDB(dst, b, h) do { _Pragma("unroll") for (int n = 0; n < 2; ++n) _Pragma("unroll") for (int k = 0; k < 2; ++k) dst[n][k] = *(const PG8_LAS bf16x8*)(lds + PG8_SB(b, h) + boff + n * 2048 + k * 1024); } while (0)
#define PG8_LDA8(dst, b, h) do { _Pragma("unroll") for (int m = 0; m < 4; ++m) dst[m] = __builtin_shufflevector(*(const PG8_LAS i32x4_t*)(lds + PG8_SA(b, h) + aoff + m * 2048), *(const PG8_LAS i32x4_t*)(lds + PG8_SA(b, h) + aoff + m * 2048 + 1024), 0, 1, 2, 3, 4, 5, 6, 7); } while (0)
#define PG8_LDB8(dst, b, h) do { _Pragma("unroll") for (int n = 0; n < 2; ++n) dst[n] = __builtin_shufflevector(*(const PG8_LAS i32x4_t*)(lds + PG8_SB(b, h) + boff + n * 2048), *(const PG8_LAS i32x4_t*)(lds + PG8_SB(b, h) + boff + n * 2048 + 1024), 0, 1, 2, 3, 4, 5, 6, 7); } while (0)
#define PG8_MMA8(ai, bj, A8, Bx8) do { _Pragma("unroll") for (int m = 0; m < 4; ++m) _Pragma("unroll") for (int n = 0; n < 2; ++n) \
        acc[ai][bj][m][n] = __builtin_amdgcn_mfma_scale_f32_16x16x128_f8f6f4(Bx8[n], A8[m], acc[ai][bj][m][n], 0, 0, 0, 0x7F7F7F7F, 0, 0x7F7F7F7F); __builtin_amdgcn_s_setprio(0); } while (0)
#define PG8_MMA(ai, bj, At, Bt) do { __builtin_amdgcn_s_setprio(1); _Pragma("unroll") for (int m = 0; m < 4; ++m) _Pragma("unroll") for (int n = 0; n < 2; ++n) _Pragma("unroll") for (int k = 0; k < 2; ++k) \
        { if constexpr (I8) acc[ai][bj][m][n] = __builtin_bit_cast(f32x4, __builtin_amdgcn_mfma_i32_16x16x64_i8(__builtin_bit_cast(i32x4_t, Bt[n][k]), __builtin_bit_cast(i32x4_t, At[m][k]), __builtin_bit_cast(i32x4_t, acc[ai][bj][m][n]), 0, 0, 0)); \
          else acc[ai][bj][m][n] = __builtin_amdgcn_mfma_f32_16x16x32_bf16(Bt[n][k], At[m][k], acc[ai][bj][m][n], 0, 0, 0); } __builtin_amdgcn_s_setprio(0); } while (0)
#define PG8_WAIT_V(n) asm volatile("s_waitcnt vmcnt(" #n ")" ::: "memory")
#define PG8_WAIT_L(n) asm volatile("s_waitcnt lgkmcnt(" #n ")" ::: "memory")
#define PG8_BAR __builtin_amdgcn_s_barrier()
#define PG8_SCHED __builtin_amdgcn_sched_barrier(0)
    Unit cur, nxt; int ui = 0;
    if (!S.next(0, cur)) return;
    f32x4 acc[2][2][4][2];
#pragma unroll
    for (int a = 0; a < 2; ++a)
#pragma unroll
        for (int b = 0; b < 2; ++b)
#pragma unroll
            for (int m = 0; m < 4; ++m)
#pragma unroll
                for (int n = 0; n < 2; ++n) acc[a][b][m][n] = (f32x4){0.f, 0.f, 0.f, 0.f};
    bf16x8 At[4][2], B0[2][2], B1[2][2];
    i32x8_t At8[4], B08[2], B18[2];
    const char* cA = GATHER ? (const char*)g.A : (const char*)g.A + (size_t)cur.pm * tstep; if constexpr (GATHER) PG8_GVO(cur, 0);
    const char* cB = (const char*)g.Bt + (size_t)cur.e * g.bstride + (size_t)cur.pn * tstep;
    S.a_ready(cur);
    if constexpr (SP2) {
        PG8_STAGE(PG8_SB(0, 0), cB, voffB); PG8_STAGE(PG8_SB(0, 1), cB + hstep, voffB); PG8_STAGE_A(PG8_SA(0, 0), cA, 0, 0); PG8_STAGE_A(PG8_SA(0, 1), cA, 1, 0);
        if (wr == 1) PG8_BAR;
        PG8_WAIT_V(2); PG8_BAR;
        PG8_STAGE(PG8_SB(1, 0), cB + kstep, voffB); PG8_STAGE_A(PG8_SA(1, 0), cA + kstep, 0, 0); PG8_STAGE(PG8_SB(1, 1), cB + hstep + kstep, voffB);
        PG8_WAIT_V(6); PG8_BAR;
    } else {
        PG8_STAGE(PG8_SB(0, 0), cB, voffB); PG8_STAGE(PG8_SA(0, 0), cA, voffA); PG8_STAGE(PG8_SB(0, 1), cB + hstep, voffB); PG8_STAGE(PG8_SA(0, 1), cA + hstep, voffA);
        if (wr == 1) PG8_BAR;
        PG8_WAIT_V(4); PG8_BAR;
        PG8_STAGE(PG8_SB(1, 0), cB + kstep, voffB); PG8_STAGE(PG8_SA(1, 0), cA + kstep, voffA); PG8_STAGE(PG8_SB(1, 1), cB + hstep + kstep, voffB);
        PG8_WAIT_V(6); PG8_BAR;
    }
    for (;;) {
        const bool has_next = S.next(ui + 1, nxt);
        const char* nA = GATHER ? cA : (has_next ? (const char*)g.A + (size_t)nxt.pm * tstep : cA);
        const int cslot = ui & 1, nslot = has_next ? (cslot ^ 1) : cslot;
        if constexpr (GATHER) { if (has_next) PG8_GVO(nxt, nslot); } const char* nB = has_next ? (const char*)g.Bt + (size_t)nxt.e * g.bstride + (size_t)nxt.pn * tstep : cB;
        for (int t = 0; t < nt; t += 2) {
            const bool last = (t == nt - 2);
            const char* a1 = cA + (size_t)(t + 1) * kstep;
            const char* a2 = last ? nA : cA + (size_t)(t + 2) * kstep; const char* b2 = last ? nB : cB + (size_t)(t + 2) * kstep;
            const char* a3 = a2 + kstep; const char* b3 = b2 + kstep;
            if (last && has_next) S.a_ready(nxt);
            const int xslot = last ? nslot : cslot;
            if constexpr (SP2) {
            if constexpr (FP8) { PG8_LDB8(B08, 0, 0); PG8_LDB8(B18, 0, 1); PG8_SCHED; PG8_LDA8(At8, 0, 0); } else { PG8_LDB(B0, 0, 0); PG8_LDB(B1, 0, 1); PG8_SCHED; PG8_LDA(At, 0, 0); } PG8_STAGE_A(PG8_SA(1, 1), a1, 1, cslot);
            PG8_WAIT_V(8); PG8_WAIT_L(0); PG8_BAR; if constexpr (FP8) { PG8_MMA8(0, 0, At8, B08); PG8_MMA8(0, 1, At8, B18); } else { PG8_MMA(0, 0, At, B0); PG8_MMA(0, 1, At, B1); } PG8_BAR; PG8_SCHED;
            if constexpr (FP8) PG8_LDA8(At8, 0, 1); else PG8_LDA(At, 0, 1); PG8_STAGE(PG8_SB(0, 0), b2, voffB); PG8_STAGE(PG8_SB(0, 1), b2 + hstep, voffB); PG8_STAGE_A(PG8_SA(0, 0), a2, 0, xslot);
            PG8_WAIT_V(8); PG8_WAIT_L(0); PG8_BAR; if constexpr (FP8) { PG8_MMA8(1, 0, At8, B08); PG8_MMA8(1, 1, At8, B18); } else { PG8_MMA(1, 0, At, B0); PG8_MMA(1, 1, At, B1); } PG8_BAR; PG8_SCHED;
            if constexpr (FP8) { PG8_LDB8(B08, 1, 0); PG8_LDB8(B18, 1, 1); PG8_SCHED; PG8_LDA8(At8, 1, 0); } else { PG8_LDB(B0, 1, 0); PG8_LDB(B1, 1, 1); PG8_SCHED; PG8_LDA(At, 1, 0); } PG8_STAGE_A(PG8_SA(0, 1), a2, 1, xslot);
            PG8_WAIT_V(8); PG8_WAIT_L(0); PG8_BAR; if constexpr (FP8) { PG8_MMA8(0, 0, At8, B08); PG8_MMA8(0, 1, At8, B18); } else { PG8_MMA(0, 0, At, B0); PG8_MMA(0, 1, At, B1); } PG8_BAR; PG8_SCHED;
            if constexpr (FP8) PG8_LDA8(At8, 1, 1); else PG8_LDA(At, 1, 1); PG8_STAGE(PG8_SB(1, 0), b3, voffB); PG8_STAGE(PG8_SB(1, 1), b3 + hstep, voffB); PG8_STAGE_A(PG8_SA(1, 0), a3, 0, xslot);
            PG8_WAIT_V(8); PG8_WAIT_L(0); PG8_BAR; if constexpr (FP8) { PG8_MMA8(1, 0, At8, B08); PG8_MMA8(1, 1, At8, B18); } else { PG8_MMA(1, 0, At, B0); PG8_MMA(1, 1, At, B1); } PG8_BAR; PG8_SCHED;
            } else {
            PG8_LDB(B0, 0, 0); PG8_SCHED; PG8_LDA(At, 0, 0); PG8_STAGE(PG8_SA(1, 1), a1 + hstep, voffA);
            PG8_WAIT_L(8); PG8_BAR; PG8_WAIT_L(0); PG8_MMA(0, 0, At, B0); PG8_BAR; PG8_SCHED;
            PG8_LDB(B1, 0, 1); PG8_STAGE(PG8_SB(0, 0), b2, voffB);
            PG8_BAR; PG8_WAIT_L(0); PG8_MMA(0, 1, At, B1); PG8_BAR;
            PG8_LDA(At, 0, 1); PG8_STAGE(PG8_SA(0, 0), a2, voffA);
            PG8_BAR; PG8_WAIT_L(0); PG8_MMA(1, 0, At, B0); PG8_BAR; PG8_SCHED;
            PG8_STAGE(PG8_SB(0, 1), b2 + hstep, voffB);
            PG8_WAIT_V(6); PG8_BAR; PG8_MMA(1, 1, At, B1); PG8_BAR;
            PG8_LDB(B0, 1, 0); PG8_SCHED; PG8_LDA(At, 1, 0); PG8_STAGE(PG8_SA(0, 1), a2 + hstep, voffA);
            PG8_WAIT_L(8); PG8_BAR; PG8_WAIT_L(0); PG8_MMA(0, 0, At, B0); PG8_BAR; PG8_SCHED;
            PG8_LDB(B1, 1, 1); PG8_STAGE(PG8_SB(1, 0), b3, voffB);
            PG8_BAR; PG8_WAIT_L(0); PG8_MMA(0, 1, At, B1); PG8_BAR;
            PG8_LDA(At, 1, 1); PG8_STAGE(PG8_SA(1, 0), a3, voffA);
            PG8_BAR; PG8_WAIT_L(0); PG8_MMA(1, 0, At, B0); PG8_BAR; PG8_SCHED;
            PG8_STAGE(PG8_SB(1, 1), b3 + hstep, voffB);
            PG8_WAIT_V(6); PG8_BAR; PG8_MMA(1, 1, At, B1); PG8_BAR;
            }
        }
        if constexpr (ALIGN_EPI) { if (wr == 0) PG8_BAR; }
        if constexpr (!Epi::AFTER_DRAIN) { E(acc, cur, wr, wc, fr, fq); S.done(cur); }
        if (!has_next) break;
#pragma unroll
        for (int a = 0; a < 2; ++a)
#pragma unroll
            for (int b = 0; b < 2; ++b)
#pragma unroll
                for (int m = 0; m < 4; ++m)
#pragma unroll
                    for (int n = 0; n < 2; ++n) acc[a][b][m][n] = (f32x4){0.f, 0.f, 0.f, 0.f};
        cur = nxt; cA = nA; cB = nB; ++ui;
        if constexpr (ALIGN_EPI) { if (wr == 1) PG8_BAR; }
    }
    PG8_WAIT_V(0);
    if constexpr (!ALIGN_EPI) { if (wr == 0) PG8_BAR; }
    PG8_BAR;
    if constexpr (Epi::AFTER_DRAIN) { E.fused(acc, cur, wr, wc, fr, fq, lds, wid, lane); S.done(cur); }
#undef PG8_SA
#undef PG8_GVO
#undef PG8_STAGE_A
#undef PG8_SB
#undef PG8_STAGE
#undef PG8_LDA
#undef PG8_LDB
#undef PG8_MMA
#undef PG8_LDA8
#undef PG8_LDB8
#undef PG8_MMA8
#undef PG8_WAIT_V
#undef PG8_WAIT_L
#undef PG8_BAR
#undef PG8_SCHED
}
}
namespace attn {
using bf16 = __hip_bfloat16;
constexpr int   D = 128, NW = 8, QBLK = 32, KVBLK = 64;
constexpr float SCALE = 0.088388347648318440f;
constexpr float THR = 8.f;
constexpr int SDEPTH = 1;
constexpr int LDQ = PP, LDK = PP, LDO = ::D;
constexpr size_t SHM_V = KVBLK * D * 2, SHM_K = KVBLK * D * 2, SHM_ATTN = 2 * SHM_V + 2 * SHM_K + NW * 64 * 4;
using bf16x8 = __attribute__((ext_vector_type(8))) short;
using s16x4  = __attribute__((ext_vector_type(4))) short;
using f32x16 = __attribute__((ext_vector_type(16))) float;
using f32x8  = __attribute__((ext_vector_type(8))) float;
using u32x4  = __attribute__((ext_vector_type(4))) unsigned;
#define KSWZ(row, colB) ((row) * 256 + ((colB) ^ (((row) & 7) << 4)))
#define SBAR() __builtin_amdgcn_sched_barrier(0)
__device__ __forceinline__ int crow(int r, int hi) { return (r & 3) + 8 * (r >> 2) + 4 * hi; }
__device__ __forceinline__ unsigned cvtpk(float lo, float hi) {
  unsigned r; asm volatile("v_cvt_pk_bf16_f32 %0, %1, %2" : "=v"(r) : "v"(lo), "v"(hi)); return r;
}
template <typename TIn> struct Stage;
template <> struct Stage<bf16>  { using T = bf16x8;
  __device__ static __forceinline__ T ld8(const bf16* p) { return *reinterpret_cast<const bf16x8*>(p); }
  __device__ static __forceinline__ bf16x8 tobf(T x) { return x; } };
template <> struct Stage<float> { using T = f32x8;
  __device__ static __forceinline__ T ld8(const float* p) { return *reinterpret_cast<const f32x8*>(p); }
  __device__ static __forceinline__ bf16x8 tobf(T x) {
    u32x4 w = {cvtpk(x[0], x[1]), cvtpk(x[2], x[3]), cvtpk(x[4], x[5]), cvtpk(x[6], x[7])}; return *reinterpret_cast<bf16x8*>(&w); } };

__device__ __forceinline__ void partialSM(f32x16& p0, f32x16& p1, float& m_reg, float& mn, float& alpha) {
  constexpr float C = SCALE * 1.4426950408889634f;
  float pmax = p0[0]; for (int r = 1; r < 16; ++r) pmax = fmaxf(pmax, p0[r]); for (int r = 0; r < 16; ++r) pmax = fmaxf(pmax, p1[r]);
  { auto rr = __builtin_amdgcn_permlane32_swap(__float_as_uint(pmax), __float_as_uint(pmax), false, false);
    pmax = fmaxf(__uint_as_float(rr[0]), __uint_as_float(rr[1])); }
  if (__builtin_expect(__all(pmax - m_reg <= THR / SCALE), 1)) { mn = m_reg; alpha = 1.f; }
  else { mn = fmaxf(m_reg, pmax); alpha = __builtin_amdgcn_exp2f((m_reg - mn) * C); m_reg = mn; }
  float mnC = -mn * C;
  for (int r = 0; r < 16; ++r) p0[r] = fmaf(p0[r], C, mnC); for (int r = 0; r < 16; ++r) p1[r] = fmaf(p1[r], C, mnC);
  for (int r = 0; r < 16; ++r) p0[r] = __builtin_amdgcn_exp2f(p0[r]);
}
__device__ __forceinline__ void finishSM(f32x16& p0, f32x16& p1, float alpha, float& l_reg, bf16x8& pa0, bf16x8& pa1, bf16x8& pa2, bf16x8& pa3) {
  for (int r = 0; r < 16; ++r) p1[r] = __builtin_amdgcn_exp2f(p1[r]);
  float ps = 0; for (int r = 0; r < 16; ++r) ps += p0[r]; for (int r = 0; r < 16; ++r) ps += p1[r];
  { auto rr = __builtin_amdgcn_permlane32_swap(__float_as_uint(ps), __float_as_uint(ps), false, false);
    ps = __uint_as_float(rr[0]) + __uint_as_float(rr[1]); }
  l_reg = l_reg * alpha + ps;
#define PK4(P, BASE, OUT) do { unsigned a0 = cvtpk(P[BASE + 0], P[BASE + 1]), a1 = cvtpk(P[BASE + 2], P[BASE + 3]);   \
    unsigned b0 = cvtpk(P[BASE + 4], P[BASE + 5]), b1 = cvtpk(P[BASE + 6], P[BASE + 7]);                              \
    auto r0 = __builtin_amdgcn_permlane32_swap(a0, b0, false, false); auto r1 = __builtin_amdgcn_permlane32_swap(a1, b1, false, false); \
    u32x4 w = {r0[0], r1[0], r0[1], r1[1]}; OUT = *reinterpret_cast<bf16x8*>(&w); } while (0)
  PK4(p0, 0, pa0); PK4(p0, 8, pa1); PK4(p1, 0, pa2); PK4(p1, 8, pa3);
#undef PK4
}
__device__ __forceinline__ void qkt(f32x16& p0, f32x16& p1, const bf16* Ks, const bf16x8* qr, int r32, int hi) {
  p0 = f32x16{}; p1 = f32x16{};
  for (int d0 = 0; d0 < 8; ++d0) { int cb = (d0 * 16 + hi * 8) * 2;
    bf16x8 b0 = *reinterpret_cast<const bf16x8*>((const char*)Ks + KSWZ(r32, cb));
    bf16x8 b1 = *reinterpret_cast<const bf16x8*>((const char*)Ks + KSWZ(32 + r32, cb));
    p0 = __builtin_amdgcn_mfma_f32_32x32x16_bf16(b0, qr[d0], p0, 0, 0, 0);
    p1 = __builtin_amdgcn_mfma_f32_32x32x16_bf16(b1, qr[d0], p1, 0, 0, 0); }
}
__device__ __forceinline__ int v_st(int k, int c) { const int kk = (k & ~0xC) | ((k & 4) << 1) | ((k & 8) >> 1); return ((kk >> 3) * 4 + (c >> 5)) * 512 + ((kk & 7) * 32 + (c & 31)) * 2; }
__device__ __forceinline__ int v_rd_base(int lane) { return ((lane & 3) << 3) | (((lane >> 2) & 3) << 6) | (((lane >> 4) & 1) << 5) | (((lane >> 5) & 1) << 8); }
constexpr int v_rd_off(int d0, int ks, int half) { return d0 * 512 + ks * 4096 + half * 2048; }
template <int OFF> __device__ __forceinline__ s16x4 tr_read(int vb) {
  s16x4 r; asm volatile("ds_read_b64_tr_b16 %0, %1 offset:%2" : "=&v"(r) : "v"(vb), "i"(OFF) : "memory"); return r;
}
template <int D0> __device__ __forceinline__ void pv_one(f32x16& od, int vb, bf16x8 pa0, bf16x8 pa1, bf16x8 pa2, bf16x8 pa3) {
  const s16x4 l0 = tr_read<v_rd_off(D0, 0, 0)>(vb), h0 = tr_read<v_rd_off(D0, 0, 1)>(vb), l1 = tr_read<v_rd_off(D0, 1, 0)>(vb), h1 = tr_read<v_rd_off(D0, 1, 1)>(vb);
  const s16x4 l2 = tr_read<v_rd_off(D0, 2, 0)>(vb), h2 = tr_read<v_rd_off(D0, 2, 1)>(vb), l3 = tr_read<v_rd_off(D0, 3, 0)>(vb), h3 = tr_read<v_rd_off(D0, 3, 1)>(vb);
  asm volatile("s_waitcnt lgkmcnt(0)" ::: "memory"); SBAR();
#define PK(L, H) (bf16x8){L[0], L[1], L[2], L[3], H[0], H[1], H[2], H[3]}
  od = __builtin_amdgcn_mfma_f32_32x32x16_bf16(pa0, PK(l0, h0), od, 0, 0, 0);
  od = __builtin_amdgcn_mfma_f32_32x32x16_bf16(pa1, PK(l1, h1), od, 0, 0, 0);
  od = __builtin_amdgcn_mfma_f32_32x32x16_bf16(pa2, PK(l2, h2), od, 0, 0, 0);
  od = __builtin_amdgcn_mfma_f32_32x32x16_bf16(pa3, PK(l3, h3), od, 0, 0, 0);
#undef PK
}
__device__ __forceinline__ void pv_d0(f32x16* o, int vb, bf16x8 pa0, bf16x8 pa1, bf16x8 pa2, bf16x8 pa3) {
  pv_one<0>(o[0], vb, pa0, pa1, pa2, pa3); pv_one<1>(o[1], vb, pa0, pa1, pa2, pa3); pv_one<2>(o[2], vb, pa0, pa1, pa2, pa3); pv_one<3>(o[3], vb, pa0, pa1, pa2, pa3);
}

using i32x8 = __attribute__((ext_vector_type(8))) int;
using i32x4 = __attribute__((ext_vector_type(4))) int;
constexpr int LDK8 = 256;
#define K8SWZ(row, colB) ((row) * 128 + ((colB) ^ ((((row) >> 1) & 7) << 4)))
__device__ __forceinline__ void qkt8(f32x16& p0, f32x16& p1, const bf16* Ks, const i32x8* qr, int r32, int hi) {
  p0 = f32x16{}; p1 = f32x16{};
#pragma unroll
  for (int d0 = 0; d0 < 2; ++d0) { const int cb = d0 * 64 + hi * 32;
    const i32x4 a0 = *reinterpret_cast<const i32x4*>((const char*)Ks + K8SWZ(r32, cb)), a1 = *reinterpret_cast<const i32x4*>((const char*)Ks + K8SWZ(r32, cb + 16));
    const i32x4 b0 = *reinterpret_cast<const i32x4*>((const char*)Ks + K8SWZ(32 + r32, cb)), b1 = *reinterpret_cast<const i32x4*>((const char*)Ks + K8SWZ(32 + r32, cb + 16));
    const i32x8 A0 = __builtin_shufflevector(a0, a1, 0, 1, 2, 3, 4, 5, 6, 7), A1 = __builtin_shufflevector(b0, b1, 0, 1, 2, 3, 4, 5, 6, 7);
    p0 = __builtin_amdgcn_mfma_scale_f32_32x32x64_f8f6f4(A0, qr[d0], p0, 0, 0, 0, 0x7F7F7F7F, 0, 0x7F7F7F7F);
    p1 = __builtin_amdgcn_mfma_scale_f32_32x32x64_f8f6f4(A1, qr[d0], p1, 0, 0, 0, 0x7F7F7F7F, 0, 0x7F7F7F7F); }
}
__device__ __forceinline__ void attn_dense_body(const bf16* __restrict__ Qb, const bf16* __restrict__ Kh, const bf16* __restrict__ Vh,
                                                bf16* __restrict__ Ob, int seq, char* lds) {
  using TQ = bf16; using St = Stage<bf16>; using SQ = Stage<TQ>;
  int tid_ = threadIdx.x; asm volatile("" : "+v"(tid_));
  const int tid = tid_, wid = tid >> 6, lane = tid & 63, r32 = lane & 31, hi = lane >> 5;
  bf16* V_lds = (bf16*)lds; bf16* K_lds = (bf16*)(lds + 2 * SHM_V);
  float* ws = (float*)(lds + 2 * SHM_V + 2 * SHM_K) + wid * 64; float* li_l = ws; float* al_l = ws + 32;
  float m_reg = -1e30f, l_reg = 0; f32x16 o[4] = {}; bf16x8 qr[8];
  const TQ* Qw = Qb + (long)(wid * QBLK + r32) * LDQ + hi * 8;
#pragma unroll
  for (int d0 = 0; d0 < 8; ++d0) qr[d0] = SQ::tobf(SQ::ld8(Qw + d0 * 16));
  const int sr = tid >> 4, sc = (tid & 15) * 8, vst0 = v_st(sr, sc), vst1 = v_st(32 + sr, sc);
  const int vb0 = (int)(uintptr_t)V_lds + v_rd_base(lane);
  struct { typename St::T vs0, vs1, ks0, ks1; } sr_[SDEPTH];
#define SLOAD(i, k0) do { sr_[i].vs0 = St::ld8(&Vh[(long)((k0) + sr) * LDK + sc]); sr_[i].vs1 = St::ld8(&Vh[(long)((k0) + 32 + sr) * LDK + sc]); \
    sr_[i].ks0 = St::ld8(&Kh[(long)((k0) + sr) * LDK + sc]); sr_[i].ks1 = St::ld8(&Kh[(long)((k0) + 32 + sr) * LDK + sc]); } while (0)
#define SWRITE(b, i) do { *(bf16x8*)((char*)V_lds + (b) * SHM_V + vst0) = St::tobf(sr_[i].vs0);          \
    *(bf16x8*)((char*)V_lds + (b) * SHM_V + vst1) = St::tobf(sr_[i].vs1); int kc = sc * 2;               \
    *(bf16x8*)((char*)K_lds + (b) * SHM_K + KSWZ(sr, kc)) = St::tobf(sr_[i].ks0);                       \
    *(bf16x8*)((char*)K_lds + (b) * SHM_K + KSWZ(32 + sr, kc)) = St::tobf(sr_[i].ks1); } while (0)
#define SWAIT() do { if constexpr (SDEPTH == 2) asm volatile("s_waitcnt vmcnt(4)" ::: "memory"); else asm volatile("s_waitcnt vmcnt(0)" ::: "memory"); } while (0)
#define RESC(a) do { if (__any((a) < 1.f)) { if (hi == 0) al_l[r32] = (a); asm volatile("s_waitcnt lgkmcnt(0)" ::: "memory"); \
    for (int d = 0; d < 4; ++d) for (int r = 0; r < 16; ++r) o[d][r] *= al_l[crow(r, hi)]; } } while (0)
  f32x16 pA0, pA1, pB0, pB1; float mnA, mnB, alA, alB; bf16x8 pa0, pa1, pa2, pa3; const int NT = seq / KVBLK;
  constexpr int SE = 0, SO = SDEPTH - 1;
  SLOAD(SE, 0); asm volatile("s_waitcnt vmcnt(0)" ::: "memory"); SWRITE(0, SE); __syncthreads();
  qkt(pA0, pA1, K_lds, qr, r32, hi); partialSM(pA0, pA1, m_reg, mnA, alA);
  SLOAD(SO, KVBLK); if constexpr (SDEPTH == 2) { if (2 < NT) SLOAD(SE, 2 * KVBLK); }
  SWAIT(); SWRITE(1, SO); __syncthreads();
  for (int j = 1; j + 1 < NT; j += 2) {
    SBAR(); qkt(pB0, pB1, (bf16*)((char*)K_lds + SHM_K), qr, r32, hi);
    finishSM(pA0, pA1, alA, l_reg, pa0, pa1, pa2, pa3); SBAR();
    SLOAD(SO, (j + SDEPTH) * KVBLK); SBAR();
    pv_d0(o, vb0, pa0, pa1, pa2, pa3); partialSM(pB0, pB1, m_reg, mnB, alB);
    __syncthreads(); SWAIT(); SWRITE(0, SE);
    RESC(alB); __syncthreads();
    SBAR(); qkt(pA0, pA1, K_lds, qr, r32, hi);
    finishSM(pB0, pB1, alB, l_reg, pa0, pa1, pa2, pa3); SBAR();
    if (SDEPTH == 1 || j + 3 < NT) SLOAD(SE, (j + 1 + SDEPTH) * KVBLK); SBAR();
    pv_d0(o, vb0 + (int)SHM_V, pa0, pa1, pa2, pa3); partialSM(pA0, pA1, m_reg, mnA, alA);
    __syncthreads(); SWAIT(); SWRITE(1, SO);
    RESC(alA); __syncthreads();
  }
  SBAR(); qkt(pB0, pB1, (bf16*)((char*)K_lds + SHM_K), qr, r32, hi);
  finishSM(pA0, pA1, alA, l_reg, pa0, pa1, pa2, pa3); SBAR();
  pv_d0(o, vb0, pa0, pa1, pa2, pa3); partialSM(pB0, pB1, m_reg, mnB, alB);
  __syncthreads(); RESC(alB);
  finishSM(pB0, pB1, alB, l_reg, pa0, pa1, pa2, pa3); SBAR();
  pv_d0(o, vb0 + (int)SHM_V, pa0, pa1, pa2, pa3);
  if (hi == 0) li_l[r32] = l_reg; asm volatile("s_waitcnt lgkmcnt(0)" ::: "memory");
  float rli[16];
#pragma unroll
  for (int r = 0; r < 16; ++r) rli[r] = __builtin_amdgcn_rcpf(li_l[crow(r, hi)]);
  bf16* Ow = Ob + (long)(wid * QBLK) * LDO;
#pragma unroll
  for (int r = 0; r < 16; ++r) { int orow = crow(r, hi);
    for (int d0 = 0; d0 < 4; ++d0) Ow[(long)orow * LDO + d0 * 32 + r32] = __float2bfloat16(o[d0][r] * rli[r]); }
  __syncthreads();
#undef SLOAD
#undef SWRITE
#undef SWAIT
#undef RESC
}

__device__ __forceinline__ void attn_dense_body8(const bf16* __restrict__ Qb, const unsigned char* __restrict__ K8h, const bf16* __restrict__ Vh,
                                                 bf16* __restrict__ Ob, int seq, char* lds) {
  using TQ = bf16; using St = Stage<bf16>; using SQ = Stage<TQ>;
  int tid_ = threadIdx.x; asm volatile("" : "+v"(tid_));
  const int tid = tid_, wid = tid >> 6, lane = tid & 63, r32 = lane & 31, hi = lane >> 5;
  bf16* V_lds = (bf16*)lds; bf16* K_lds = (bf16*)(lds + 2 * SHM_V);
  float* ws = (float*)(lds + 2 * SHM_V + 2 * SHM_K) + wid * 64; float* li_l = ws; float* al_l = ws + 32;
  float m_reg = -1e30f, l_reg = 0; f32x16 o[4] = {}; i32x8 qr[2];
  const TQ* Qw = Qb + (long)(wid * QBLK + r32) * LDQ + hi * 32;
#pragma unroll
  for (int d0 = 0; d0 < 2; ++d0) {
#pragma unroll
    for (int c = 0; c < 4; ++c) { const bf16x8 x = *reinterpret_cast<const bf16x8*>(Qw + d0 * 64 + c * 8); const unsigned* xu = reinterpret_cast<const unsigned*>(&x);
      unsigned w0 = 0u, w1 = 0u;
      w0 = __builtin_amdgcn_cvt_pk_fp8_f32(__uint_as_float(xu[0] << 16), __uint_as_float(xu[0] & 0xffff0000u), w0, false); w0 = __builtin_amdgcn_cvt_pk_fp8_f32(__uint_as_float(xu[1] << 16), __uint_as_float(xu[1] & 0xffff0000u), w0, true);
      w1 = __builtin_amdgcn_cvt_pk_fp8_f32(__uint_as_float(xu[2] << 16), __uint_as_float(xu[2] & 0xffff0000u), w1, false); w1 = __builtin_amdgcn_cvt_pk_fp8_f32(__uint_as_float(xu[3] << 16), __uint_as_float(xu[3] & 0xffff0000u), w1, true);
      qr[d0][2 * c] = (int)w0; qr[d0][2 * c + 1] = (int)w1; } }
  const int sr = tid >> 4, sc = (tid & 15) * 8, vst0 = v_st(sr, sc), vst1 = v_st(32 + sr, sc);
  const int vb0 = (int)(uintptr_t)V_lds + v_rd_base(lane);
  const int kr8 = tid >> 3, kc8 = (tid & 7) * 16;
  struct { typename St::T vs0, vs1; i32x4 k8; } sr_[SDEPTH];
#define SLOAD(i, k0) do { sr_[i].vs0 = St::ld8(&Vh[(long)((k0) + sr) * LDK + sc]); sr_[i].vs1 = St::ld8(&Vh[(long)((k0) + 32 + sr) * LDK + sc]); \
    sr_[i].k8 = *reinterpret_cast<const i32x4*>(K8h + (long)((k0) + kr8) * LDK8 + kc8); } while (0)
#define SWRITE(b, i) do { *(bf16x8*)((char*)V_lds + (b) * SHM_V + vst0) = St::tobf(sr_[i].vs0);          \
    *(bf16x8*)((char*)V_lds + (b) * SHM_V + vst1) = St::tobf(sr_[i].vs1);                                \
    *(i32x4*)((char*)K_lds + (b) * SHM_K + K8SWZ(kr8, kc8)) = sr_[i].k8; } while (0)
#define SWAIT() do { if constexpr (SDEPTH == 2) asm volatile("s_waitcnt vmcnt(4)" ::: "memory"); else asm volatile("s_waitcnt vmcnt(0)" ::: "memory"); } while (0)
#define RESC(a) do { if (__any((a) < 1.f)) { if (hi == 0) al_l[r32] = (a); asm volatile("s_waitcnt lgkmcnt(0)" ::: "memory"); \
    for (int d = 0; d < 4; ++d) for (int r = 0; r < 16; ++r) o[d][r] *= al_l[crow(r, hi)]; } } while (0)
  f32x16 pA0, pA1, pB0, pB1; float mnA, mnB, alA, alB; bf16x8 pa0, pa1, pa2, pa3; const int NT = seq / KVBLK;
  constexpr int SE = 0, SO = SDEPTH - 1;
  SLOAD(SE, 0); asm volatile("s_waitcnt vmcnt(0)" ::: "memory"); SWRITE(0, SE); __syncthreads();
  qkt8(pA0, pA1, K_lds, qr, r32, hi); partialSM(pA0, pA1, m_reg, mnA, alA);
  SLOAD(SO, KVBLK); if constexpr (SDEPTH == 2) { if (2 < NT) SLOAD(SE, 2 * KVBLK); }
  SWAIT(); SWRITE(1, SO); __syncthreads();
  for (int j = 1; j + 1 < NT; j += 2) {
    SBAR(); qkt8(pB0, pB1, (bf16*)((char*)K_lds + SHM_K), qr, r32, hi);
    finishSM(pA0, pA1, alA, l_reg, pa0, pa1, pa2, pa3); SBAR();
    SLOAD(SO, (j + SDEPTH) * KVBLK); SBAR();
    pv_d0(o, vb0, pa0, pa1, pa2, pa3); partialSM(pB0, pB1, m_reg, mnB, alB);
    __syncthreads(); SWAIT(); SWRITE(0, SE);
    RESC(alB); __syncthreads();
    SBAR(); qkt8(pA0, pA1, K_lds, qr, r32, hi);
    finishSM(pB0, pB1, alB, l_reg, pa0, pa1, pa2, pa3); SBAR();
    if (SDEPTH == 1 || j + 3 < NT) SLOAD(SE, (j + 1 + SDEPTH) * KVBLK); SBAR();
    pv_d0(o, vb0 + (int)SHM_V, pa0, pa1, pa2, pa3); partialSM(pA0, pA1, m_reg, mnA, alA);
    __syncthreads(); SWAIT(); SWRITE(1, SO);
    RESC(alA); __syncthreads();
  }
  SBAR(); qkt8(pB0, pB1, (bf16*)((char*)K_lds + SHM_K), qr, r32, hi);
  finishSM(pA0, pA1, alA, l_reg, pa0, pa1, pa2, pa3); SBAR();
  pv_d0(o, vb0, pa0, pa1, pa2, pa3); partialSM(pB0, pB1, m_reg, mnB, alB);
  __syncthreads(); RESC(alB);
  finishSM(pB0, pB1, alB, l_reg, pa0, pa1, pa2, pa3); SBAR();
  pv_d0(o, vb0 + (int)SHM_V, pa0, pa1, pa2, pa3);
  if (hi == 0) li_l[r32] = l_reg; asm volatile("s_waitcnt lgkmcnt(0)" ::: "memory");
  float rli[16];
#pragma unroll
  for (int r = 0; r < 16; ++r) rli[r] = __builtin_amdgcn_rcpf(li_l[crow(r, hi)]);
  bf16* Ow = Ob + (long)(wid * QBLK) * LDO;
#pragma unroll
  for (int r = 0; r < 16; ++r) { int orow = crow(r, hi);
    for (int d0 = 0; d0 < 4; ++d0) Ow[(long)orow * LDO + d0 * 32 + r32] = __float2bfloat16(o[d0][r] * rli[r]); }
  __syncthreads();
#undef SLOAD
#undef SWRITE
#undef SWAIT
#undef RESC
}

#define V8SWZ(row, colB) ((row) * 64 + ((colB) ^ ((((row) >> 2) & 3) << 4)))
__device__ __forceinline__ unsigned pk4_fp8(float a, float b, float c, float d) { unsigned w = 0u; w = __builtin_amdgcn_cvt_pk_fp8_f32(a, b, w, false); w = __builtin_amdgcn_cvt_pk_fp8_f32(c, d, w, true); return w; }
constexpr float PB8 = 6.f, THR8 = 2.f;
typedef float f32x2v __attribute__((ext_vector_type(2)));
__device__ __forceinline__ void partialSM8(f32x16& p0, f32x16& p1, float& m_reg, float& mn, float& alpha) {
  constexpr float C = SCALE * 1.4426950408889634f;
  float pmax = p0[0]; for (int r = 1; r < 16; ++r) pmax = fmaxf(pmax, p0[r]); for (int r = 0; r < 16; ++r) pmax = fmaxf(pmax, p1[r]);
  { auto rr = __builtin_amdgcn_permlane32_swap(__float_as_uint(pmax), __float_as_uint(pmax), false, false);
    pmax = fmaxf(__uint_as_float(rr[0]), __uint_as_float(rr[1])); }
  if (__builtin_expect(__all(pmax - m_reg <= THR8 / C), 1)) { mn = m_reg; alpha = 1.f; }
  else { mn = fmaxf(m_reg, pmax); alpha = __builtin_amdgcn_exp2f((m_reg - mn) * C); m_reg = mn; }
  const float mnC = PB8 - mn * C; const f32x2v C2 = {C, C}, M2 = {mnC, mnC};
#pragma unroll
  for (int r = 0; r < 16; r += 2) { const f32x2v a = __builtin_elementwise_fma((f32x2v){p0[r], p0[r + 1]}, C2, M2), b = __builtin_elementwise_fma((f32x2v){p1[r], p1[r + 1]}, C2, M2);
    p0[r] = a.x; p0[r + 1] = a.y; p1[r] = b.x; p1[r + 1] = b.y; }
  for (int r = 0; r < 16; ++r) p0[r] = __builtin_amdgcn_exp2f(p0[r]);
}
__device__ __forceinline__ unsigned pk4_fp8n(float a, float b, float c, float d) {
  unsigned w = __float_as_uint(a); w = __builtin_amdgcn_cvt_pk_fp8_f32(a, b, w, false); w = __builtin_amdgcn_cvt_pk_fp8_f32(c, d, w, true); return w; }
__device__ __forceinline__ void finishSM8(f32x16& p0, f32x16& p1, float alpha, float& l_reg, i32x8& P8) {
  for (int r = 0; r < 16; ++r) p1[r] = __builtin_amdgcn_exp2f(p1[r]);
  f32x2v s2 = {p0[0], p0[1]};
#pragma unroll
  for (int r = 2; r < 16; r += 2) s2 += (f32x2v){p0[r], p0[r + 1]};
#pragma unroll
  for (int r = 0; r < 16; r += 2) s2 += (f32x2v){p1[r], p1[r + 1]};
  float ps = s2.x + s2.y;
  { auto rr = __builtin_amdgcn_permlane32_swap(__float_as_uint(ps), __float_as_uint(ps), false, false);
    ps = __uint_as_float(rr[0]) + __uint_as_float(rr[1]); }
  l_reg = l_reg * alpha + ps;
#pragma unroll
  for (int k = 0; k < 4; ++k) { P8[k] = (int)pk4_fp8n(p0[4 * k], p0[4 * k + 1], p0[4 * k + 2], p0[4 * k + 3]); P8[4 + k] = (int)pk4_fp8n(p1[4 * k], p1[4 * k + 1], p1[4 * k + 2], p1[4 * k + 3]); }
}
__device__ __forceinline__ void pv8_load(i32x8* va, const char* Vs, int r32, int hi) {
#pragma unroll
  for (int db = 0; db < 4; ++db) {
    const i32x4 a0 = *reinterpret_cast<const i32x4*>(Vs + V8SWZ(32 * db + r32, 32 * hi)), a1 = *reinterpret_cast<const i32x4*>(Vs + V8SWZ(32 * db + r32, 32 * hi + 16));
    va[db] = __builtin_shufflevector(a0, a1, 0, 1, 2, 3, 4, 5, 6, 7); }
}
__device__ __forceinline__ void pv8_mma(f32x16* o, const i32x8* va, const i32x8& P8) {
#pragma unroll
  for (int db = 0; db < 4; ++db) o[db] = __builtin_amdgcn_mfma_scale_f32_32x32x64_f8f6f4(va[db], P8, o[db], 0, 0, 0, 0x7F7F7F7F, 0, 0x7F7F7F7F);
}
#define PIN16(p) do { _Pragma("unroll") for (int r_ = 0; r_ < 16; ++r_) asm volatile("" : "+v"((p)[r_])); } while (0)
#define PV_SCHED() do { __builtin_amdgcn_sched_group_barrier(0x002, 20, 0); __builtin_amdgcn_sched_group_barrier(0x008, 1, 0); __builtin_amdgcn_sched_group_barrier(0x002, 20, 0); __builtin_amdgcn_sched_group_barrier(0x008, 1, 0); \
    __builtin_amdgcn_sched_group_barrier(0x002, 20, 0); __builtin_amdgcn_sched_group_barrier(0x008, 1, 0); __builtin_amdgcn_sched_group_barrier(0x002, 6, 0); __builtin_amdgcn_sched_group_barrier(0x008, 1, 0); } while (0)
#define QK_SCHED16() do { __builtin_amdgcn_sched_group_barrier(0x100, 16, 0); __builtin_amdgcn_sched_group_barrier(0x002, 14, 0); __builtin_amdgcn_sched_group_barrier(0x008, 1, 0); __builtin_amdgcn_sched_group_barrier(0x002, 14, 0); \
    __builtin_amdgcn_sched_group_barrier(0x008, 1, 0); __builtin_amdgcn_sched_group_barrier(0x002, 14, 0); __builtin_amdgcn_sched_group_barrier(0x008, 1, 0); __builtin_amdgcn_sched_group_barrier(0x002, 14, 0); __builtin_amdgcn_sched_group_barrier(0x008, 1, 0); } while (0)
#define QK_SCHED() do { __builtin_amdgcn_sched_group_barrier(0x100, 8, 0); __builtin_amdgcn_sched_group_barrier(0x002, 14, 0); __builtin_amdgcn_sched_group_barrier(0x008, 1, 0); __builtin_amdgcn_sched_group_barrier(0x002, 14, 0); \
    __builtin_amdgcn_sched_group_barrier(0x008, 1, 0); __builtin_amdgcn_sched_group_barrier(0x002, 14, 0); __builtin_amdgcn_sched_group_barrier(0x008, 1, 0); __builtin_amdgcn_sched_group_barrier(0x002, 14, 0); __builtin_amdgcn_sched_group_barrier(0x008, 1, 0); } while (0)
__device__ __forceinline__ void attn_dense_body88(const bf16* __restrict__ Qb, const unsigned char* __restrict__ K8h, const unsigned char* __restrict__ VT8h,
                                                  bf16* __restrict__ Ob, int seq, char* lds) {
  using TQ = bf16;
  int tid_ = threadIdx.x; asm volatile("" : "+v"(tid_));
  const int tid = tid_, wid = tid >> 6, lane = tid & 63, r32 = lane & 31, hi = lane >> 5;
  char* V_lds = lds; bf16* K_lds = (bf16*)(lds + 2 * SHM_V);
  float m_reg = -1e30f, l_reg = 0; f32x16 o[4] = {}; i32x8 qr[2];
  const TQ* Qw = Qb + (long)(wid * QBLK + r32) * LDQ + hi * 32;
#pragma unroll
  for (int d0 = 0; d0 < 2; ++d0) {
#pragma unroll
    for (int c = 0; c < 4; ++c) { const bf16x8 x = *reinterpret_cast<const bf16x8*>(Qw + d0 * 64 + c * 8); const unsigned* xu = reinterpret_cast<const unsigned*>(&x);
      qr[d0][2 * c] = (int)pk4_fp8(__uint_as_float(xu[0] << 16), __uint_as_float(xu[0] & 0xffff0000u), __uint_as_float(xu[1] << 16), __uint_as_float(xu[1] & 0xffff0000u));
      qr[d0][2 * c + 1] = (int)pk4_fp8(__uint_as_float(xu[2] << 16), __uint_as_float(xu[2] & 0xffff0000u), __uint_as_float(xu[3] << 16), __uint_as_float(xu[3] & 0xffff0000u)); } }
  const int kr8 = tid >> 3, kc8 = (tid & 7) * 16;
  constexpr int SD8 = 1;
  struct { i32x4 v8, k8; } sr_[SD8];
#define SLOAD(i, k0) do { sr_[i].v8 = *reinterpret_cast<const i32x4*>(VT8h + (long)((k0) >> 6) * 8192 + tid * 16); \
    sr_[i].k8 = *reinterpret_cast<const i32x4*>(K8h + (long)((k0) + kr8) * LDK8 + kc8); } while (0)
#define SWRITE(b, i) do { *(i32x4*)(V_lds + (b) * SHM_V + V8SWZ(tid >> 2, (tid & 3) * 16)) = sr_[i].v8; \
    *(i32x4*)((char*)K_lds + (b) * SHM_K + K8SWZ(kr8, kc8)) = sr_[i].k8; } while (0)
#define SWAIT(more) do { if (SD8 == 2 && (more)) asm volatile("s_waitcnt vmcnt(2)" ::: "memory"); else asm volatile("s_waitcnt vmcnt(0)" ::: "memory"); } while (0)
#define RESC(a) do { if (__any((a) < 1.f)) { for (int d = 0; d < 4; ++d) for (int r = 0; r < 16; ++r) o[d][r] *= (a); } } while (0)
  f32x16 pA0, pA1, pB0, pB1; float mnA, mnB, alA, alB; i32x8 P8; i32x8 va[4]; const int NT = seq / KVBLK;
  constexpr int SE = 0, SO = SD8 - 1;
  SLOAD(SE, 0); asm volatile("s_waitcnt vmcnt(0)" ::: "memory"); SWRITE(0, SE); __syncthreads();
  qkt8(pA0, pA1, K_lds, qr, r32, hi); partialSM8(pA0, pA1, m_reg, mnA, alA);
  SLOAD(SO, KVBLK); if constexpr (SD8 == 2) { if (2 < NT) SLOAD(SE, 2 * KVBLK); }
  SWAIT(2 < NT); SWRITE(1, SO); __syncthreads();
  for (int j = 1; j + 1 < NT; j += 2) {
    SBAR(); qkt8(pB0, pB1, (bf16*)((char*)K_lds + SHM_K), qr, r32, hi);
    finishSM8(pA0, pA1, alA, l_reg, P8); QK_SCHED(); SBAR();
    SLOAD(SO, (j + SD8) * KVBLK); pv8_load(va, V_lds, r32, hi); SBAR();
    pv8_mma(o, va, P8); partialSM8(pB0, pB1, m_reg, mnB, alB); PIN16(pB0); PIN16(pB1); PV_SCHED(); SBAR();
    __syncthreads(); SWAIT(true); SWRITE(0, SE);
    RESC(alB); __syncthreads();
    SBAR(); qkt8(pA0, pA1, K_lds, qr, r32, hi);
    finishSM8(pB0, pB1, alB, l_reg, P8); QK_SCHED(); SBAR();
    if (SD8 == 1 || j + 3 < NT) SLOAD(SE, (j + 1 + SD8) * KVBLK); pv8_load(va, V_lds + SHM_V, r32, hi); SBAR();
    pv8_mma(o, va, P8); partialSM8(pA0, pA1, m_reg, mnA, alA); PIN16(pA0); PIN16(pA1); PV_SCHED(); SBAR();
    __syncthreads(); SWAIT(j + 3 < NT); SWRITE(1, SO);
    RESC(alA); __syncthreads();
  }
  SBAR(); qkt8(pB0, pB1, (bf16*)((char*)K_lds + SHM_K), qr, r32, hi);
  finishSM8(pA0, pA1, alA, l_reg, P8); QK_SCHED(); SBAR();
  pv8_load(va, V_lds, r32, hi); SBAR(); pv8_mma(o, va, P8); partialSM8(pB0, pB1, m_reg, mnB, alB); PIN16(pB0); PIN16(pB1); PV_SCHED(); SBAR();
  __syncthreads(); RESC(alB);
  finishSM8(pB0, pB1, alB, l_reg, P8); SBAR();
  pv8_load(va, V_lds + SHM_V, r32, hi); pv8_mma(o, va, P8);
  const float rl = __builtin_amdgcn_rcpf(l_reg);
  bf16* Ow = Ob + (long)(wid * QBLK + r32) * LDO;
#pragma unroll
  for (int db = 0; db < 4; ++db)
#pragma unroll
    for (int g = 0; g < 4; ++g) { const unsigned lo = cvtpk(o[db][4 * g] * rl, o[db][4 * g + 1] * rl), hw = cvtpk(o[db][4 * g + 2] * rl, o[db][4 * g + 3] * rl);
      *reinterpret_cast<unsigned long long*>(Ow + 32 * db + 8 * g + 4 * hi) = (unsigned long long)lo | ((unsigned long long)hw << 32); }
  __syncthreads();
#undef SLOAD
#undef SWRITE
#undef SWAIT
#undef RESC
}

__device__ __forceinline__ void attn_dense_body88p(const bf16* __restrict__ Qb, const unsigned char* __restrict__ K8h, const unsigned char* __restrict__ VT8h,
                                                  bf16* __restrict__ Ob, int seq, char* lds) {
  using TQ = bf16;
  int tid_ = threadIdx.x; asm volatile("" : "+v"(tid_));
  const int tid = tid_, wid = tid >> 6, lane = tid & 63, r32 = lane & 31, hi = lane >> 5;
  char* V_lds = lds; bf16* K_lds = (bf16*)(lds + 2 * SHM_V);
  float m_reg = -1e30f, l_reg = 0; f32x16 o[4] = {}; i32x8 qr[2];
  const TQ* Qw = Qb + (long)(wid * QBLK + r32) * LDQ + hi * 32;
#pragma unroll
  for (int d0 = 0; d0 < 2; ++d0) {
#pragma unroll
    for (int c = 0; c < 4; ++c) { const bf16x8 x = *reinterpret_cast<const bf16x8*>(Qw + d0 * 64 + c * 8); const unsigned* xu = reinterpret_cast<const unsigned*>(&x);
      qr[d0][2 * c] = (int)pk4_fp8(__uint_as_float(xu[0] << 16), __uint_as_float(xu[0] & 0xffff0000u), __uint_as_float(xu[1] << 16), __uint_as_float(xu[1] & 0xffff0000u));
      qr[d0][2 * c + 1] = (int)pk4_fp8(__uint_as_float(xu[2] << 16), __uint_as_float(xu[2] & 0xffff0000u), __uint_as_float(xu[3] << 16), __uint_as_float(xu[3] & 0xffff0000u)); } }
  const int kr8 = tid >> 3, kc8 = (tid & 7) * 16;
  struct { i32x4 v8[2], k8[2]; } sr_;
#define SLOADP(pr) do { _Pragma("unroll") for (int s_ = 0; s_ < 2; ++s_) { const long tl_ = 2 * (long)(pr) + s_; \
    sr_.v8[s_] = *reinterpret_cast<const i32x4*>(VT8h + tl_ * 8192 + tid * 16); sr_.k8[s_] = *reinterpret_cast<const i32x4*>(K8h + (tl_ * 64 + kr8) * LDK8 + kc8); } } while (0)
#define SWRITEP(b) do { _Pragma("unroll") for (int s_ = 0; s_ < 2; ++s_) { *(i32x4*)(V_lds + (b) * SHM_V + s_ * 8192 + V8SWZ(tid >> 2, (tid & 3) * 16)) = sr_.v8[s_]; \
    *(i32x4*)((char*)K_lds + (b) * SHM_K + s_ * 8192 + K8SWZ(kr8, kc8)) = sr_.k8[s_]; } } while (0)
#define RESC(a) do { if (__any((a) < 1.f)) { for (int d = 0; d < 4; ++d) for (int r = 0; r < 16; ++r) o[d][r] *= (a); } } while (0)
#define KT(b, s) ((const bf16*)((const char*)K_lds + (b) * SHM_K + (s) * 8192))
#define VT(b, s) (V_lds + (b) * SHM_V + (s) * 8192)
#define STEP(pN0, pN1, mnN, alN, pC0, pC1, alC, KP, VP) do { \
    SBAR(); qkt8(pN0, pN1, KP, qr, r32, hi); finishSM8(pC0, pC1, alC, l_reg, P8); QK_SCHED(); SBAR(); \
    pv8_load(va, VP, r32, hi); SBAR(); \
    pv8_mma(o, va, P8); partialSM8(pN0, pN1, m_reg, mnN, alN); PIN16(pN0); PIN16(pN1); PV_SCHED(); SBAR(); \
    RESC(alN); } while (0)
  f32x16 pA0, pA1, pB0, pB1; float mnA, mnB, alA, alB; i32x8 P8; i32x8 va[4]; const int NT = seq / KVBLK, NP = NT >> 1, NI = NT >> 2;
  SLOADP(0); asm volatile("s_waitcnt vmcnt(0)" ::: "memory"); SWRITEP(0); SLOADP(1); __syncthreads();
  qkt8(pA0, pA1, KT(0, 0), qr, r32, hi); partialSM8(pA0, pA1, m_reg, mnA, alA);
  SWRITEP(1); if (2 < NP) SLOADP(2);
  for (int i = 0; i + 1 < NI; ++i) {
    STEP(pB0, pB1, mnB, alB, pA0, pA1, alA, KT(0, 1), VT(0, 0));
    __syncthreads();
    STEP(pA0, pA1, mnA, alA, pB0, pB1, alB, KT(1, 0), VT(0, 1));
    __syncthreads();
    SWRITEP(0); SLOADP(2 * i + 3);
    STEP(pB0, pB1, mnB, alB, pA0, pA1, alA, KT(1, 1), VT(1, 0));
    __syncthreads();
    STEP(pA0, pA1, mnA, alA, pB0, pB1, alB, KT(0, 0), VT(1, 1));
    __syncthreads();
    SWRITEP(1); if (2 * i + 4 < NP) SLOADP(2 * i + 4);
  }
  STEP(pB0, pB1, mnB, alB, pA0, pA1, alA, KT(0, 1), VT(0, 0));
  __syncthreads();
  STEP(pA0, pA1, mnA, alA, pB0, pB1, alB, KT(1, 0), VT(0, 1));
  STEP(pB0, pB1, mnB, alB, pA0, pA1, alA, KT(1, 1), VT(1, 0));
  finishSM8(pB0, pB1, alB, l_reg, P8); SBAR();
  pv8_load(va, VT(1, 1), r32, hi); pv8_mma(o, va, P8);
  const float rl = __builtin_amdgcn_rcpf(l_reg);
  bf16* Ow = Ob + (long)(wid * QBLK + r32) * LDO;
#pragma unroll
  for (int db = 0; db < 4; ++db)
#pragma unroll
    for (int g = 0; g < 4; ++g) { const unsigned lo = cvtpk(o[db][4 * g] * rl, o[db][4 * g + 1] * rl), hw = cvtpk(o[db][4 * g + 2] * rl, o[db][4 * g + 3] * rl);
      *reinterpret_cast<unsigned long long*>(Ow + 32 * db + 8 * g + 4 * hi) = (unsigned long long)lo | ((unsigned long long)hw << 32); }
  __syncthreads();
#undef SLOADP
#undef SWRITEP
#undef RESC
#undef KT
#undef VT
#undef STEP
}

__device__ __forceinline__ void attn_dense_body88q(const bf16* __restrict__ Qb, const unsigned char* __restrict__ K8h, const unsigned char* __restrict__ VT8h,
                                                  bf16* __restrict__ Ob, int seq, char* lds) {
  using TQ = bf16;
  int tid_ = threadIdx.x; asm volatile("" : "+v"(tid_));
  const int tid = tid_, wid = tid >> 6, lane = tid & 63, r32 = lane & 31, hi = lane >> 5;
  char* V_lds = lds; bf16* K_lds = (bf16*)(lds + 2 * SHM_V);
  float m_reg = -1e30f, l_reg = 0; f32x16 o[4] = {}; i32x8 qr[2];
  const TQ* Qw = Qb + (long)(wid * QBLK + r32) * LDQ + hi * 32;
#pragma unroll
  for (int d0 = 0; d0 < 2; ++d0) {
#pragma unroll
    for (int c = 0; c < 4; ++c) { const bf16x8 x = *reinterpret_cast<const bf16x8*>(Qw + d0 * 64 + c * 8); const unsigned* xu = reinterpret_cast<const unsigned*>(&x);
      qr[d0][2 * c] = (int)pk4_fp8(__uint_as_float(xu[0] << 16), __uint_as_float(xu[0] & 0xffff0000u), __uint_as_float(xu[1] << 16), __uint_as_float(xu[1] & 0xffff0000u));
      qr[d0][2 * c + 1] = (int)pk4_fp8(__uint_as_float(xu[2] << 16), __uint_as_float(xu[2] & 0xffff0000u), __uint_as_float(xu[3] << 16), __uint_as_float(xu[3] & 0xffff0000u)); } }
  const int kr8 = tid >> 3, kc8 = (tid & 7) * 16;
  typedef __attribute__((address_space(3))) char aldsc; typedef __attribute__((address_space(3))) i32x4 aldsc_i4;
#define LDS_BASE(expr) ({ unsigned u_ = (unsigned)(uintptr_t)(aldsc*)(expr); asm volatile("" : "+v"(u_)); (aldsc*)(uintptr_t)u_; })
  aldsc* const kb00 = LDS_BASE(lds + 65536 + K8SWZ(r32, hi * 32)),      * const kb01 = LDS_BASE(lds + 65536 + K8SWZ(r32, hi * 32 + 16));
  aldsc* const kb10 = LDS_BASE(lds + 65536 + K8SWZ(r32, 64 + hi * 32)), * const kb11 = LDS_BASE(lds + 65536 + K8SWZ(r32, 64 + hi * 32 + 16));
  aldsc* const vb0 = LDS_BASE(lds + V8SWZ(r32, 32 * hi)), * const vb1 = LDS_BASE(lds + V8SWZ(r32, 32 * hi + 16));
  aldsc* const kw = LDS_BASE(lds + 65536 + K8SWZ(kr8, kc8)), * const vw = LDS_BASE(lds + V8SWZ(tid >> 2, (tid & 3) * 16));
#define LD4(p) (*(const aldsc_i4*)(p))
#define CAT8(x, y) __builtin_shufflevector(x, y, 0, 1, 2, 3, 4, 5, 6, 7)
#define QKT8Q(p0, p1, ko) do { p0 = f32x16{}; p1 = f32x16{}; \
    { const i32x8 A0 = CAT8(LD4(kb00 + (ko)), LD4(kb01 + (ko))), A1 = CAT8(LD4(kb00 + (ko) + 4096), LD4(kb01 + (ko) + 4096)); \
      p0 = __builtin_amdgcn_mfma_scale_f32_32x32x64_f8f6f4(A0, qr[0], p0, 0, 0, 0, 0x7F7F7F7F, 0, 0x7F7F7F7F); p1 = __builtin_amdgcn_mfma_scale_f32_32x32x64_f8f6f4(A1, qr[0], p1, 0, 0, 0, 0x7F7F7F7F, 0, 0x7F7F7F7F); } \
    { const i32x8 A0 = CAT8(LD4(kb10 + (ko)), LD4(kb11 + (ko))), A1 = CAT8(LD4(kb10 + (ko) + 4096), LD4(kb11 + (ko) + 4096)); \
      p0 = __builtin_amdgcn_mfma_scale_f32_32x32x64_f8f6f4(A0, qr[1], p0, 0, 0, 0, 0x7F7F7F7F, 0, 0x7F7F7F7F); p1 = __builtin_amdgcn_mfma_scale_f32_32x32x64_f8f6f4(A1, qr[1], p1, 0, 0, 0, 0x7F7F7F7F, 0, 0x7F7F7F7F); } } while (0)
#define PV8LQ(vo) do { _Pragma("unroll") for (int db_ = 0; db_ < 4; ++db_) va[db_] = CAT8(LD4(vb0 + (vo) + 2048 * db_), LD4(vb1 + (vo) + 2048 * db_)); } while (0)
  struct { i32x4 v8[2], k8[2]; } sr_;
#define SLOADH(qd, h) do { _Pragma("unroll") for (int s_ = 0; s_ < 2; ++s_) { const long tl_ = 4 * (long)(qd) + 2 * (h) + s_; \
    sr_.v8[s_] = *reinterpret_cast<const i32x4*>(VT8h + tl_ * 8192 + tid * 16); sr_.k8[s_] = *reinterpret_cast<const i32x4*>(K8h + (tl_ * 64 + kr8) * LDK8 + kc8); } } while (0)
#define SWRITEH(b, h) do { _Pragma("unroll") for (int s_ = 0; s_ < 2; ++s_) { *(aldsc_i4*)(vw + (b) * 32768 + (2 * (h) + s_) * 8192) = sr_.v8[s_]; \
    *(aldsc_i4*)(kw + (b) * 32768 + (2 * (h) + s_) * 8192) = sr_.k8[s_]; } } while (0)
#define RESC(a) do { if (__any((a) < 1.f)) { for (int d = 0; d < 4; ++d) for (int r = 0; r < 16; ++r) o[d][r] *= (a); } } while (0)
#define KT(b, s) ((b) * 32768 + (s) * 8192)
#define VT(b, s) ((b) * 32768 + (s) * 8192)
#define STEP(pN0, pN1, mnN, alN, pC0, pC1, alC, KP, VP) do { \
    SBAR(); QKT8Q(pN0, pN1, KP); finishSM8(pC0, pC1, alC, l_reg, P8); QK_SCHED(); SBAR(); \
    PV8LQ(VP); SBAR(); \
    pv8_mma(o, va, P8); partialSM8(pN0, pN1, m_reg, mnN, alN); PIN16(pN0); PIN16(pN1); PV_SCHED(); SBAR(); \
    RESC(alN); } while (0)
#define STEP_E(KP, VP) STEP(pB0, pB1, mnB, alB, pA0, pA1, alA, KP, VP)
#define STEP_O(KP, VP) STEP(pA0, pA1, mnA, alA, pB0, pB1, alB, KP, VP)
  static_assert(65536 + 2 * 32768 <= 147456, "attention quad buffers");
  f32x16 pA0, pA1, pB0, pB1; float mnA, mnB, alA, alB; i32x8 P8; i32x8 va[4]; const int NT = seq / KVBLK, NQ = NT >> 2, NI = NT >> 3;
  SLOADH(0, 0); asm volatile("s_waitcnt vmcnt(0)" ::: "memory"); SWRITEH(0, 0); SLOADH(0, 1); SWRITEH(0, 1); SLOADH(1, 0); __syncthreads();
  QKT8Q(pA0, pA1, KT(0, 0)); partialSM8(pA0, pA1, m_reg, mnA, alA);
  SWRITEH(1, 0); SLOADH(1, 1);
  for (int i = 0; i + 1 < NI; ++i) {
    STEP_E(KT(0, 1), VT(0, 0)); STEP_O(KT(0, 2), VT(0, 1));
    SWRITEH(1, 1); SLOADH(2 * i + 2, 0);
    STEP_E(KT(0, 3), VT(0, 2));
    __syncthreads();
    STEP_O(KT(1, 0), VT(0, 3));
    __syncthreads();
    SWRITEH(0, 0); SLOADH(2 * i + 2, 1);
    STEP_E(KT(1, 1), VT(1, 0)); STEP_O(KT(1, 2), VT(1, 1));
    SWRITEH(0, 1); SLOADH(2 * i + 3, 0);
    STEP_E(KT(1, 3), VT(1, 2));
    __syncthreads();
    STEP_O(KT(0, 0), VT(1, 3));
    __syncthreads();
    SWRITEH(1, 0); SLOADH(2 * i + 3, 1);
  }
  STEP_E(KT(0, 1), VT(0, 0)); STEP_O(KT(0, 2), VT(0, 1));
  SWRITEH(1, 1);
  STEP_E(KT(0, 3), VT(0, 2));
  __syncthreads();
  STEP_O(KT(1, 0), VT(0, 3));
  STEP_E(KT(1, 1), VT(1, 0)); STEP_O(KT(1, 2), VT(1, 1)); STEP_E(KT(1, 3), VT(1, 2));
  finishSM8(pB0, pB1, alB, l_reg, P8); SBAR();
  PV8LQ(VT(1, 3)); pv8_mma(o, va, P8);
  const float rl = __builtin_amdgcn_rcpf(l_reg);
  bf16* Ow = Ob + (long)(wid * QBLK + r32) * LDO;
#pragma unroll
  for (int db = 0; db < 4; ++db)
#pragma unroll
    for (int g = 0; g < 4; ++g) { const unsigned lo = cvtpk(o[db][4 * g] * rl, o[db][4 * g + 1] * rl), hw = cvtpk(o[db][4 * g + 2] * rl, o[db][4 * g + 3] * rl);
      *reinterpret_cast<unsigned long long*>(Ow + 32 * db + 8 * g + 4 * hi) = (unsigned long long)lo | ((unsigned long long)hw << 32); }
  __syncthreads();
#undef SLOADH
#undef SWRITEH
#undef LDS_BASE
#undef LD4
#undef CAT8
#undef QKT8Q
#undef PV8LQ
#undef RESC
#undef KT
#undef VT
#undef STEP
#undef STEP_E
#undef STEP_O
}

}
#define GAS __attribute__((address_space(1)))
#define LAS __attribute__((address_space(3)))
typedef unsigned short bfu;
typedef unsigned v4u __attribute__((ext_vector_type(4)));
typedef float f32x4 __attribute__((ext_vector_type(4)));
typedef short bf16x8 __attribute__((ext_vector_type(8)));
typedef GAS unsigned gu32;
typedef GAS unsigned long long gu64;
#define RLX_AGENT __ATOMIC_RELAXED, __HIP_MEMORY_SCOPE_AGENT
#define LDS_WAIT() asm volatile("s_waitcnt lgkmcnt(0)" ::: "memory")
#define VM_WAIT() asm volatile("s_waitcnt vmcnt(0)" ::: "memory")
__device__ __forceinline__ unsigned long long rt() { return __builtin_amdgcn_s_memrealtime(); }
__device__ __forceinline__ unsigned f2bf(float f) { unsigned u = __builtin_bit_cast(unsigned, f); return (u + 0x7fffu + ((u >> 16) & 1u)) >> 16; }
__device__ __forceinline__ unsigned pk2(float lo, float hi) { return f2bf(lo) | (f2bf(hi) << 16); }

#define XB_TMO      128
#define XB_XCNT(j)  (256  + 64 * (j))
#define XB_XSUB(j)  (1280 + 64 * (j))
#define XB_XGEN(j)  (2304 + 64 * (j))
#define XB_TOP      3328
#define XB_TOPGEN   3392
#define XCD_BAR_WORDS 3456
#define XB_SPIN_CAP (1u << 18)

__device__ __forceinline__ unsigned xb_ld(unsigned* p)              { return __hip_atomic_load(p, __ATOMIC_RELAXED, __HIP_MEMORY_SCOPE_AGENT); }
__device__ __forceinline__ unsigned xb_add(unsigned* p, unsigned v) { return __hip_atomic_fetch_add(p, v, __ATOMIC_RELAXED, __HIP_MEMORY_SCOPE_AGENT); }
__device__ __forceinline__ unsigned xb_xcc_id() { return (unsigned)__builtin_amdgcn_s_getreg((3 << 11) | 20) & 0xFu; }
#define XB_SPIN(cond, bar) do { unsigned _sp = 0; while (cond) { __builtin_amdgcn_s_sleep(1); \
    if ((++_sp & 255u) == 0u) { if (xb_ld(&(bar)[XB_TMO])) break; if (_sp > XB_SPIN_CAP) { atomicAdd(&(bar)[XB_TMO], 1u); break; } } } } while (0)

struct XcdBarrier {
    unsigned* bar; unsigned x;
    volatile LAS unsigned* st;
};

__device__ __forceinline__ XcdBarrier xcd_barrier_post(unsigned* bar, volatile LAS unsigned* st) {
    XcdBarrier b; b.bar = bar; b.x = xb_xcc_id(); b.st = st;
    if (threadIdx.x == 0) (void)xb_add(&bar[XB_XCNT(b.x)], 1u);
    return b;
}
__device__ __forceinline__ void xcd_barrier_complete(unsigned* bar, unsigned x, unsigned& nloc, unsigned& nx) {
    const unsigned G = gridDim.x * gridDim.y * gridDim.z;
    unsigned sum, cnt, mine, sp = 0u;
    for (;;) {
        sum = 0u; cnt = 0u; mine = 0u;
#pragma unroll
        for (unsigned j = 0; j < 16; ++j) { const unsigned c = xb_ld(&bar[XB_XCNT(j)]); sum += c; cnt += (c > 0u) ? 1u : 0u; mine = (j == x) ? c : mine; }
        if (sum == G) break;
        __builtin_amdgcn_s_sleep(1);
        if ((++sp & 255u) == 0u) { if (xb_ld(&bar[XB_TMO])) break; if (sp > XB_SPIN_CAP) { atomicAdd(&bar[XB_TMO], 1u); break; } }
    }
    nloc = mine > 0u ? mine : 1u; nx = cnt > 0u ? cnt : 1u;
}

__device__ __forceinline__ void xcd_barrier(const XcdBarrier& b) {
    asm volatile("s_waitcnt vmcnt(0)" ::: "memory");
    __syncthreads();
    if (threadIdx.x == 0) {
        unsigned* bar = b.bar;
        __builtin_amdgcn_s_waitcnt(0);
        unsigned nloc = b.st[0], nx = b.st[1];
        if (nloc == 0u) { xcd_barrier_complete(bar, b.x, nloc, nx); b.st[0] = nloc; b.st[1] = nx; }
#if defined(BAR_ALL_RELEASE)
        __builtin_amdgcn_fence(__ATOMIC_RELEASE, "agent"); asm volatile("s_waitcnt vmcnt(0)" ::: "memory");
#endif
        const unsigned old = xb_add(&bar[XB_XSUB(b.x)], 1u);
        const unsigned gen = old / nloc;
        if (old + 1u == (gen + 1u) * nloc) {
            __builtin_amdgcn_fence(__ATOMIC_RELEASE, "agent");
            asm volatile("s_waitcnt vmcnt(0)" ::: "memory");
            const unsigned og = xb_add(&bar[XB_TOP], 1u);
            const unsigned tg = og / nx;
            if (og + 1u == (tg + 1u) * nx) xb_add(&bar[XB_TOPGEN], 1u);
            else XB_SPIN(xb_ld(&bar[XB_TOPGEN]) == tg, bar);
            __builtin_amdgcn_fence(__ATOMIC_ACQUIRE, "agent");
            xb_add(&bar[XB_XGEN(b.x)], 1u);
            asm volatile("s_waitcnt vmcnt(0)" ::: "memory");
        } else {
            XB_SPIN(xb_ld(&bar[XB_XGEN(b.x)]) == gen, bar);
            __builtin_amdgcn_fence(__ATOMIC_ACQUIRE, "agent");
            asm volatile("s_waitcnt vmcnt(0)" ::: "memory");
        }
    }
    __syncthreads();
}
constexpr size_t MiB = 1u << 20;
constexpr size_t WS_CTL = 0, CTL_ZERO_BYTES = 1 * MiB;
constexpr size_t WS_WIN = 2 * MiB,  WIN_L = 21 * MiB;
constexpr size_t WS_WOUT = 44 * MiB, WOUT_L = 8 * MiB;
constexpr size_t WS_WGU = 60 * MiB, WGU_E = 8 * MiB, WGU_L = 16 * WGU_E;
constexpr size_t WS_WD = 316 * MiB, WD_E = 4 * MiB, WD_L = 16 * WD_E;
constexpr size_t WS_XN8 = 444 * MiB;
constexpr size_t WS_WIN8 = 524 * MiB, WIN8_L = 7 * MiB;
constexpr size_t WS_XNI8 = 540 * MiB;
constexpr size_t WS_WINI8 = 444 * MiB, WINI8_L = 11 * MiB;
constexpr size_t WS_MIXI8 = 632 * MiB;
constexpr size_t WS_WOUTI8 = 712 * MiB, WOUTI8_L = 4 * MiB;
constexpr size_t WS_K8 = 468 * MiB;
constexpr size_t WS_VT8 = 480 * MiB;
constexpr int NCOLI = 1792;
constexpr int NCOL8 = 3584;
constexpr float WGU_SCALE = 32.f, WD_SCALE = 64.f, WIN_SCALE = 32.f, YE_SCALE = 16.f;
constexpr size_t WS_XN = 828 * MiB;
constexpr size_t WS_PROJ = 988 * MiB;
constexpr size_t WS_MIX = 1392 * MiB;
constexpr size_t WS_HID = 1552 * MiB;
constexpr size_t WS_QKT = WS_HID + 160 * MiB;
constexpr size_t WS_MISC = 1872 * MiB;
constexpr size_t WS_LSE = WS_MISC, WS_AFFT = WS_MISC + 1 * MiB, WS_SLOT = WS_MISC + 4 * MiB, WS_IDX = WS_MISC + 7 * MiB, WS_GATE = WS_MISC + 7 * MiB + 512 * 1024, WS_ADEC = WS_MISC + 8 * MiB;
constexpr size_t WS_RSC = WS_MISC + 10 * MiB, WS_CSC = WS_MISC + 11 * MiB;
constexpr size_t WS_CSCGU = WS_MISC + 9 * MiB + 256 * 1024, WS_XRS = WS_MISC + 10 * MiB + 256 * 1024;
constexpr size_t WS_RSC2 = WS_MISC + 10 * MiB + 640 * 1024, WS_CSC2 = WS_MISC + 11 * MiB + 512 * 1024;
constexpr size_t WS_END = 1884 * MiB;
static_assert(WS_WIN + 2 * WIN_L <= WS_WOUT && WS_WOUT + 2 * WOUT_L <= WS_WGU && WS_WGU + 2 * WGU_L <= WS_WD && WS_WD + 2 * WD_L <= WS_WINI8 && WS_WINI8 + 2 * WINI8_L <= WS_K8 && WS_K8 + (size_t)M * 256 <= WS_VT8 && WS_VT8 + (size_t)2 * NCHUNK * 8192 <= WS_XNI8 && WS_XNI8 + (size_t)M * D <= WS_MIXI8 && WS_MIXI8 + (size_t)M * D <= WS_WOUTI8 && WS_WOUTI8 + 2 * WOUTI8_L <= WS_XN, "ws map (weights)");
static_assert(WS_XN + (size_t)M * D * 2 <= WS_PROJ && WS_PROJ + (size_t)M * PP * 2 <= WS_MIX && WS_PROJ + (size_t)XE_ROWS * D * 2 <= WS_MIX && WS_MIX + (size_t)M * D * 2 <= WS_HID, "ws map (activations)");
static_assert(WS_HID + (size_t)XE_ROWS * DFF <= WS_MISC && WS_HID + (size_t)NCHUNK * 8 * 8192 * 4 <= WS_MISC, "ws map (hid)");
static_assert((size_t)M * 6 * 4 <= 1 * MiB && (size_t)16 * M * 4 <= 3 * MiB && (size_t)XE_ROWS * 4 <= 512 * 1024 && (size_t)NCHUNK * 8 * 64 * 4 <= 2 * MiB, "ws map (misc)");
constexpr int CW_BAR = 4096;

#ifndef MK_ONE_LAUNCH
#define MK_ONE_LAUNCH 1
#endif
#ifndef CUT_MASK
#define CUT_MASK 0u
#endif
#define MK_FIXED_RANGE (MK_ONE_LAUNCH && CUT_MASK == 0u)
constexpr int SCR_BYTES = 147456;
constexpr int LDSCTL_OFF = SCR_BYTES, MISC_OFF = LDSCTL_OFF + 320;
constexpr int LDS_BYTES = 155648;
constexpr int NWAVES = 8, NTHR = 512;

struct Frame {
    LAS unsigned char* lds; char* ldsg;
    volatile LAS unsigned* MISC;
    gu32* ctl;
    int tid, lane, wave, vcu, G, bx;
    const float* in[22];
    float* X;
    unsigned char* ws;
};
__device__ __forceinline__ float wave_sum(float v) {
#pragma unroll
    for (int o = 1; o < 64; o <<= 1) v += __shfl_xor(v, o);
    return v;
}
__device__ __forceinline__ float wave_max(float v) {
#pragma unroll
    for (int o = 1; o < 64; o <<= 1) v = fmaxf(v, __shfl_xor(v, o));
    return v;
}
__device__ __forceinline__ float bf2f(unsigned short b) { return __uint_as_float((unsigned)b << 16); }
__device__ __forceinline__ void WG_SYNC() { __syncthreads(); }

__device__ __forceinline__ void ln_norm(f32x4 (&v)[8], const float* g, const float* b, int lane) {
    float s = 0.f;
#pragma unroll
    for (int j = 0; j < 8; ++j) s += (v[j].x + v[j].y) + (v[j].z + v[j].w);
    const float mean = wave_sum(s) * (1.f / D); float s2 = 0.f;
#pragma unroll
    for (int j = 0; j < 8; ++j) { v[j] = v[j] - mean; s2 += (v[j].x * v[j].x + v[j].y * v[j].y) + (v[j].z * v[j].z + v[j].w * v[j].w); }
    const float rstd = 1.f / sqrtf(wave_sum(s2) * (1.f / D) + LN_EPS);
#pragma unroll
    for (int j = 0; j < 8; ++j) { const int o = 8 * lane + 512 * (j >> 1) + 4 * (j & 1); const f32x4 gg = *(const f32x4*)(g + o), bb = *(const f32x4*)(b + o); v[j] = v[j] * rstd * gg + bb; }
}
__device__ __forceinline__ void row_load_f32(const float* row, f32x4 (&v)[8], int lane) {
#pragma unroll
    for (int j = 0; j < 8; ++j) v[j] = *(const f32x4*)(row + 8 * lane + 512 * (j >> 1) + 4 * (j & 1));
}
__device__ __forceinline__ void row_store_f32(float* row, const f32x4 (&v)[8], int lane) {
#pragma unroll
    for (int j = 0; j < 8; ++j) *(f32x4*)(row + 8 * lane + 512 * (j >> 1) + 4 * (j & 1)) = v[j];
}
__device__ __forceinline__ void row_store_bf16(bfu* row, const f32x4 (&v)[8], int lane) {
#pragma unroll
    for (int j = 0; j < 4; ++j) { v4u w; w.x = pk2(v[2 * j].x, v[2 * j].y); w.y = pk2(v[2 * j].z, v[2 * j].w); w.z = pk2(v[2 * j + 1].x, v[2 * j + 1].y); w.w = pk2(v[2 * j + 1].z, v[2 * j + 1].w);
        *(v4u*)(row + 8 * lane + 512 * j) = w; }
}
__device__ __forceinline__ void row_store_fp8(unsigned char* row, const f32x4 (&v)[8], int lane) {
#pragma unroll
    for (int j = 0; j < 4; ++j) { pg8::u32x2 w; w.x = pg8::cvt4_fp8(v[2 * j].x, v[2 * j].y, v[2 * j].z, v[2 * j].w); w.y = pg8::cvt4_fp8(v[2 * j + 1].x, v[2 * j + 1].y, v[2 * j + 1].z, v[2 * j + 1].w);
        *(pg8::u32x2*)(row + 8 * lane + 512 * j) = w; }
}
__device__ __forceinline__ void row_add_fp8(const unsigned char* row, f32x4 (&v)[8], int lane, float scale) {
#pragma unroll
    for (int j = 0; j < 4; ++j) { const pg8::u32x2 w = *(const pg8::u32x2*)(row + 8 * lane + 512 * j);
        const pg8::f32x2 a = __builtin_amdgcn_cvt_pk_f32_fp8(w.x, false), b = __builtin_amdgcn_cvt_pk_f32_fp8(w.x, true), c = __builtin_amdgcn_cvt_pk_f32_fp8(w.y, false), d = __builtin_amdgcn_cvt_pk_f32_fp8(w.y, true);
        v[2 * j].x += a.x * scale; v[2 * j].y += a.y * scale; v[2 * j].z += b.x * scale; v[2 * j].w += b.y * scale;
        v[2 * j + 1].x += c.x * scale; v[2 * j + 1].y += c.y * scale; v[2 * j + 1].z += d.x * scale; v[2 * j + 1].w += d.y * scale; }
}
__device__ __forceinline__ void row_store_i8(unsigned char* row, float* rsc_row, const f32x4 (&v)[8], int lane) {
    float mx = 0.f;
#pragma unroll
    for (int j = 0; j < 8; ++j) mx = fmaxf(mx, fmaxf(fmaxf(fabsf(v[j].x), fabsf(v[j].y)), fmaxf(fabsf(v[j].z), fabsf(v[j].w))));
    mx = wave_max(mx); mx = fmaxf(mx, 1e-20f);
    const float inv = 127.f / mx;
    if (lane == 0) *rsc_row = mx * (1.f / 127.f);
#pragma unroll
    for (int j = 0; j < 4; ++j) { pg8::u32x2 w;
        { const int a = __float2int_rn(v[2 * j].x * inv), b = __float2int_rn(v[2 * j].y * inv), c = __float2int_rn(v[2 * j].z * inv), d = __float2int_rn(v[2 * j].w * inv);
          w.x = (unsigned)(a & 255) | ((unsigned)(b & 255) << 8) | ((unsigned)(c & 255) << 16) | ((unsigned)(d & 255) << 24); }
        { const int a = __float2int_rn(v[2 * j + 1].x * inv), b = __float2int_rn(v[2 * j + 1].y * inv), c = __float2int_rn(v[2 * j + 1].z * inv), d = __float2int_rn(v[2 * j + 1].w * inv);
          w.y = (unsigned)(a & 255) | ((unsigned)(b & 255) << 8) | ((unsigned)(c & 255) << 16) | ((unsigned)(d & 255) << 24); }
        *(pg8::u32x2*)(row + 8 * lane + 512 * j) = w; }
}
__device__ __forceinline__ void row_load_bf16(const bfu* row, f32x4 (&v)[8], int lane, float scale) {
#pragma unroll
    for (int j = 0; j < 4; ++j) { const v4u w = *(const v4u*)(row + 8 * lane + 512 * j);
        v[2 * j] = (f32x4){__uint_as_float(w.x << 16) * scale, __uint_as_float(w.x & 0xffff0000u) * scale, __uint_as_float(w.y << 16) * scale, __uint_as_float(w.y & 0xffff0000u) * scale};
        v[2 * j + 1] = (f32x4){__uint_as_float(w.z << 16) * scale, __uint_as_float(w.z & 0xffff0000u) * scale, __uint_as_float(w.w << 16) * scale, __uint_as_float(w.w & 0xffff0000u) * scale}; }
}
__device__ __forceinline__ void row_add_bf16(const bfu* row, f32x4 (&v)[8], int lane) {
#pragma unroll
    for (int j = 0; j < 4; ++j) { const v4u w = *(const v4u*)(row + 8 * lane + 512 * j);
        v[2 * j].x += __uint_as_float(w.x << 16); v[2 * j].y += __uint_as_float(w.x & 0xffff0000u); v[2 * j].z += __uint_as_float(w.y << 16); v[2 * j].w += __uint_as_float(w.y & 0xffff0000u);
        v[2 * j + 1].x += __uint_as_float(w.z << 16); v[2 * j + 1].y += __uint_as_float(w.z & 0xffff0000u); v[2 * j + 1].z += __uint_as_float(w.w << 16); v[2 * j + 1].w += __uint_as_float(w.w & 0xffff0000u); }
}

__device__ __forceinline__ void p0_transpose_item(const float* W, int K, int N, bfu* WT, int k0, int n0, int dst_row0, LAS float* scr, int lane) {
#pragma unroll 8
    for (int i = 0; i < 32; ++i) { const int kk = 2 * i + (lane >> 5); scr[kk * 33 + (lane & 31)] = W[(size_t)(k0 + kk) * N + n0 + (lane & 31)]; }
    LDS_WAIT(); asm volatile("" ::: "memory");
    const int c = lane & 7;
#pragma unroll
    for (int j = 0; j < 4; ++j) { const int n = (lane >> 3) + 8 * j; const LAS float* s = scr + (8 * c) * 33 + n;
        v4u o; o.x = pk2(s[0 * 33], s[1 * 33]); o.y = pk2(s[2 * 33], s[3 * 33]); o.z = pk2(s[4 * 33], s[5 * 33]); o.w = pk2(s[6 * 33], s[7 * 33]);
        *(GAS v4u*)(WT + (size_t)(dst_row0 + n) * K + k0 + 8 * c) = o; }
    LDS_WAIT(); asm volatile("" ::: "memory");
}
__device__ __forceinline__ void p0_transpose_item_fp8(const float* W, int K, int N, unsigned char* WT, int k0, int n0, int dst_row0, float wscale, LAS float* scr, int lane) {
#pragma unroll 8
    for (int i = 0; i < 32; ++i) { const int kk = 2 * i + (lane >> 5); scr[kk * 33 + (lane & 31)] = W[(size_t)(k0 + kk) * N + n0 + (lane & 31)]; }
    LDS_WAIT(); asm volatile("" ::: "memory");
#pragma unroll
    for (int j = 0; j < 2; ++j) { const int c = lane + 64 * j, n = c >> 2, kq = (c & 3) * 16; const LAS float* sp = scr + kq * 33 + n;
        v4u o;
        { unsigned w = 0u; w = __builtin_amdgcn_cvt_pk_fp8_f32(sp[0 * 33] * wscale, sp[1 * 33] * wscale, w, false); w = __builtin_amdgcn_cvt_pk_fp8_f32(sp[2 * 33] * wscale, sp[3 * 33] * wscale, w, true); o.x = w; }
        { unsigned w = 0u; w = __builtin_amdgcn_cvt_pk_fp8_f32(sp[4 * 33] * wscale, sp[5 * 33] * wscale, w, false); w = __builtin_amdgcn_cvt_pk_fp8_f32(sp[6 * 33] * wscale, sp[7 * 33] * wscale, w, true); o.y = w; }
        { unsigned w = 0u; w = __builtin_amdgcn_cvt_pk_fp8_f32(sp[8 * 33] * wscale, sp[9 * 33] * wscale, w, false); w = __builtin_amdgcn_cvt_pk_fp8_f32(sp[10 * 33] * wscale, sp[11 * 33] * wscale, w, true); o.z = w; }
        { unsigned w = 0u; w = __builtin_amdgcn_cvt_pk_fp8_f32(sp[12 * 33] * wscale, sp[13 * 33] * wscale, w, false); w = __builtin_amdgcn_cvt_pk_fp8_f32(sp[14 * 33] * wscale, sp[15 * 33] * wscale, w, true); o.w = w; }
        *(GAS v4u*)(WT + (size_t)(dst_row0 + n) * K + k0 + kq) = o; }
    LDS_WAIT(); asm volatile("" ::: "memory");
}
constexpr int CONV_E_ITEMS = 3 * NEXP * 2048;
constexpr int CONV_QW = 14336;
__device__ __forceinline__ void conv_expert_item(Frame& F, int l, int idx, LAS float* scr) {
    const int which = idx / (NEXP * 2048); int r = idx % (NEXP * 2048);
    const int e = r / 2048; r %= 2048; const int kb = r / 64, nb = r % 64, n0 = 32 * nb;
    const size_t woff = ((size_t)l * NEXP + e) * (size_t)D * DFF;
    if (which == 0)      p0_transpose_item_fp8(F.in[17] + woff, D, DFF, F.ws + WS_WGU + l * WGU_L + e * WGU_E, 64 * kb, n0, (n0 >> 7) * 256 + (n0 & 127), WGU_SCALE, scr, F.lane);
    else if (which == 1) p0_transpose_item_fp8(F.in[18] + woff, D, DFF, F.ws + WS_WGU + l * WGU_L + e * WGU_E, 64 * kb, n0, (n0 >> 7) * 256 + 128 + (n0 & 127), WGU_SCALE, scr, F.lane);
    else                 p0_transpose_item_fp8(F.in[19] + woff, DFF, D, F.ws + WS_WD + l * WD_L + e * WD_E, 64 * kb, n0, n0, WD_SCALE, scr, F.lane);
}
__device__ __forceinline__ void conv_i8_block(Frame& F, const float* W, int ldw, int n0, bool valid, unsigned char* WT, int drow0, float* csc) {
    float* red = (float*)(F.ldsg + 8 * 16384);
    const int tid = F.tid, lane = F.lane, wave = F.wave;
    if (!valid) {
        for (int i = tid; i < 32 * D / 16; i += NTHR) *(GAS v4u*)(WT + (size_t)drow0 * D + (size_t)i * 16) = (v4u){0u, 0u, 0u, 0u};
        if (tid < 32) csc[tid] = 0.f;
        return; }
    f32x4 t[4][8];
#pragma unroll
    for (int j = 0; j < 4; ++j)
#pragma unroll
        for (int i = 0; i < 8; ++i) t[j][i] = __builtin_nontemporal_load((const f32x4*)(W + (size_t)(64 * (wave + 8 * j) + (lane >> 3) + 8 * i) * ldw + n0 + (lane & 7) * 4));
    f32x4 mx = {0.f, 0.f, 0.f, 0.f};
#pragma unroll
    for (int j = 0; j < 4; ++j)
#pragma unroll
        for (int i = 0; i < 8; ++i) { mx.x = fmaxf(mx.x, fabsf(t[j][i].x)); mx.y = fmaxf(mx.y, fabsf(t[j][i].y)); mx.z = fmaxf(mx.z, fabsf(t[j][i].z)); mx.w = fmaxf(mx.w, fabsf(t[j][i].w)); }
#pragma unroll
    for (int o = 8; o < 64; o <<= 1) { mx.x = fmaxf(mx.x, __shfl_xor(mx.x, o)); mx.y = fmaxf(mx.y, __shfl_xor(mx.y, o)); mx.z = fmaxf(mx.z, __shfl_xor(mx.z, o)); mx.w = fmaxf(mx.w, __shfl_xor(mx.w, o)); }
    WG_SYNC();
    if (lane < 8) { float* r_ = red + wave * 32 + lane * 4; r_[0] = mx.x; r_[1] = mx.y; r_[2] = mx.z; r_[3] = mx.w; }
    WG_SYNC();
    if (tid < 32) { float m = 1e-30f;
#pragma unroll
        for (int q = 0; q < 8; ++q) m = fmaxf(m, red[q * 32 + tid]);
        csc[tid] = m * (1.f / 127.f); red[256 + tid] = 127.f / m; }
    WG_SYNC();
    LAS float* scr = (LAS float*)(F.lds + wave * 16384);
#pragma unroll
    for (int j = 0; j < 4; ++j) { const int k0 = 64 * (wave + 8 * j);
#pragma unroll
        for (int i = 0; i < 8; ++i) { LAS float* d_ = scr + ((lane >> 3) + 8 * i) * 33 + (lane & 7) * 4; d_[0] = t[j][i].x; d_[1] = t[j][i].y; d_[2] = t[j][i].z; d_[3] = t[j][i].w; }
        LDS_WAIT(); asm volatile("" ::: "memory");
#pragma unroll
        for (int jj = 0; jj < 2; ++jj) { const int c = lane + 64 * jj, n = c >> 2, kqq = (c & 3) * 16; const LAS float* sp = scr + kqq * 33 + n; const float inv = red[256 + n];
            v4u o; unsigned* ou = (unsigned*)&o;
#pragma unroll
            for (int g = 0; g < 4; ++g) { const int a = __float2int_rn(sp[(4 * g) * 33] * inv), b = __float2int_rn(sp[(4 * g + 1) * 33] * inv), cc = __float2int_rn(sp[(4 * g + 2) * 33] * inv), d = __float2int_rn(sp[(4 * g + 3) * 33] * inv);
                ou[g] = (unsigned)(a & 255) | ((unsigned)(b & 255) << 8) | ((unsigned)(cc & 255) << 16) | ((unsigned)(d & 255) << 24); }
            *(GAS v4u*)(WT + (size_t)(drow0 + n) * D + k0 + kqq) = o; }
        LDS_WAIT(); asm volatile("" ::: "memory");
    }
}
struct ConvSrc { const float* W; unsigned char* WT; int K, N, k0, n0, drow; float sc; };
__device__ __forceinline__ ConvSrc conv_decode(Frame& F, int l, int idx) {
    const int which = idx / (NEXP * 2048); int r = idx % (NEXP * 2048);
    const int e = r / 2048; r %= 2048; const int kb = r / 64, nb = r % 64, n0 = 32 * nb;
    const size_t woff = ((size_t)l * NEXP + e) * (size_t)D * DFF;
    ConvSrc c; c.K = which == 2 ? DFF : D; c.N = which == 2 ? D : DFF; c.k0 = 64 * kb; c.n0 = n0;
    const float* wg_ = F.in[17]; const float* wu_ = F.in[18]; const float* wd_ = F.in[19];
    asm volatile("" : "+s"(wg_), "+s"(wu_), "+s"(wd_));
    c.W = (which == 0 ? wg_ : which == 1 ? wu_ : wd_) + woff;
    c.WT = which == 2 ? F.ws + WS_WD + l * WD_L + e * WD_E : F.ws + WS_WGU + l * WGU_L + e * WGU_E;
    c.drow = which == 2 ? n0 : (n0 >> 7) * 256 + (which == 1 ? 128 : 0) + (n0 & 127); c.sc = which == 2 ? WD_SCALE : WGU_SCALE;
    return c;
}
__device__ __forceinline__ void conv_load(const ConvSrc& c, f32x4 (&t)[8], int lane) {
#pragma unroll
    for (int i = 0; i < 8; ++i) t[i] = __builtin_nontemporal_load((const f32x4*)(c.W + (size_t)(c.k0 + (lane >> 3) + 8 * i) * c.N + c.n0 + (lane & 7) * 4));
}
__device__ __forceinline__ void conv_finish(const ConvSrc& c, const f32x4 (&t)[8], LAS float* scr, int lane) {
#pragma unroll
    for (int i = 0; i < 8; ++i) { LAS float* d_ = scr + ((lane >> 3) + 8 * i) * 33 + (lane & 7) * 4; d_[0] = t[i].x; d_[1] = t[i].y; d_[2] = t[i].z; d_[3] = t[i].w; }
    LDS_WAIT(); asm volatile("" ::: "memory");
#pragma unroll
    for (int j = 0; j < 2; ++j) { const int cc = lane + 64 * j, n = cc >> 2, kq = (cc & 3) * 16; const LAS float* sp = scr + kq * 33 + n; const float ws_ = c.sc;
        v4u o;
        { unsigned w = 0u; w = __builtin_amdgcn_cvt_pk_fp8_f32(sp[0 * 33] * ws_, sp[1 * 33] * ws_, w, false); w = __builtin_amdgcn_cvt_pk_fp8_f32(sp[2 * 33] * ws_, sp[3 * 33] * ws_, w, true); o.x = w; }
        { unsigned w = 0u; w = __builtin_amdgcn_cvt_pk_fp8_f32(sp[4 * 33] * ws_, sp[5 * 33] * ws_, w, false); w = __builtin_amdgcn_cvt_pk_fp8_f32(sp[6 * 33] * ws_, sp[7 * 33] * ws_, w, true); o.y = w; }
        { unsigned w = 0u; w = __builtin_amdgcn_cvt_pk_fp8_f32(sp[8 * 33] * ws_, sp[9 * 33] * ws_, w, false); w = __builtin_amdgcn_cvt_pk_fp8_f32(sp[10 * 33] * ws_, sp[11 * 33] * ws_, w, true); o.z = w; }
        { unsigned w = 0u; w = __builtin_amdgcn_cvt_pk_fp8_f32(sp[12 * 33] * ws_, sp[13 * 33] * ws_, w, false); w = __builtin_amdgcn_cvt_pk_fp8_f32(sp[14 * 33] * ws_, sp[15 * 33] * ws_, w, true); o.w = w; }
        *(GAS v4u*)(c.WT + (size_t)(c.drow + n) * c.K + c.k0 + kq) = o; }
    LDS_WAIT(); asm volatile("" ::: "memory");
}
__device__ __forceinline__ void conv_gu_block(Frame& F, int b) {
    const int l = b >> 11, e = (b >> 7) & 15, which = (b >> 6) & 1, nbk = b & 63, n0 = 32 * nbk;
    const size_t woff = ((size_t)l * NEXP + e) * (size_t)D * DFF;
    const float* wg_ = F.in[17]; const float* wu_ = F.in[18];
    asm volatile("" : "+s"(wg_), "+s"(wu_));
    const int drow0 = (n0 >> 7) * 256 + (which ? 128 : 0) + (n0 & 127);
    conv_i8_block(F, (which ? wu_ : wg_) + woff, DFF, n0, true, F.ws + WS_WGU + l * WGU_L + e * WGU_E, drow0, (float*)(F.ws + WS_CSCGU) + ((size_t)l * NEXP + e) * 4096 + drow0);
}
constexpr int CONV_GU_BLOCKS = DEPTH * NEXP * 128;
constexpr int WIN_BLOCKS = 896;
constexpr int DOWN_ITEMS = NEXP * 2048;
constexpr int NCONV = 96;
constexpr int CONV_TOTAL = 2 * DOWN_ITEMS;
__device__ __forceinline__ void conv_window(Frame& F, int w, int rank, int nrank) {
    LAS float* scr = (LAS float*)(F.lds + F.wave * 16384);
    (void)scr;
    for (int bk = w * WIN_BLOCKS + rank; bk < (w + 1) * WIN_BLOCKS; bk += nrank) conv_gu_block(F, CONV_GU_BLOCKS / 2 + bk);
}
__device__ __forceinline__ void conv_worker(Frame& F, int rank, int nrank) {
    constexpr int NB_W = CONV_GU_BLOCKS / 2 + (CONV_GU_BLOCKS / 2 - 2 * WIN_BLOCKS);
    for (int i = rank; i < NB_W; i += nrank) conv_gu_block(F, i < CONV_GU_BLOCKS / 2 ? i : i + 2 * WIN_BLOCKS);
    LAS float* scr = (LAS float*)(F.lds + F.wave * 16384);
    const int stride = nrank * NWAVES; int it = rank * NWAVES + F.wave;
    if (it >= CONV_TOTAL) return;
#define CONV_DEC(ix) conv_decode(F, (ix) < DOWN_ITEMS ? 0 : 1, 2 * NEXP * 2048 + ((ix) < DOWN_ITEMS ? (ix) : (ix) - DOWN_ITEMS))
    ConvSrc c = CONV_DEC(it);
    f32x4 t[8]; conv_load(c, t, F.lane);
    for (;;) {
        const int nx = it + stride; const bool more = nx < CONV_TOTAL; const int ny = more ? nx : it;
        const ConvSrc cn = CONV_DEC(ny);
        f32x4 tn[8]; conv_load(cn, tn, F.lane);
        conv_finish(c, t, scr, F.lane);
        if (!more) break;
        c = cn; it = nx;
#pragma unroll
        for (int i = 0; i < 8; ++i) t[i] = tn[i];
    }
#undef CONV_DEC
}
__device__ __forceinline__ void p0_prologue(Frame& F) {
    { constexpr int NB_IN = DIN_PAD / 32, NB_OUT = D / 32, NB_L = NB_IN + NB_OUT;
      for (int it = F.vcu; it < DEPTH * NB_L; it += F.G) { const int l = it / NB_L, r = it % NB_L;
          const bool isin = r < NB_IN; const int nb = isin ? r : r - NB_IN, n0 = 32 * nb;
          const float* win_ = F.in[5]; const float* wout_ = F.in[13]; asm volatile("" : "+s"(win_), "+s"(wout_));
          conv_i8_block(F, isin ? win_ + (size_t)l * D * DIN : wout_ + (size_t)l * D * D, isin ? DIN : D, n0, isin ? n0 < DIN : true,
                        isin ? F.ws + WS_WINI8 + l * WINI8_L : F.ws + WS_WOUTI8 + l * WOUTI8_L, 32 * nb, isin ? (float*)(F.ws + WS_CSC) + l * DIN_PAD + 32 * nb : (float*)(F.ws + WS_CSC2) + l * D + 32 * nb); } }
    LAS float* scr = (LAS float*)(F.lds + F.wave * 16384);
    const int gw = F.vcu * NWAVES + F.wave, NGW = F.G * NWAVES;
    constexpr int I_IN = 32 * (DIN / 32), I_OUT = 32 * 64;
    constexpr int E1_FIRST = 2 * CONV_QW;
    const bool conv_later = F.G > 2 * NCONV;
    if (!conv_later) { for (int bk = F.vcu; bk < CONV_GU_BLOCKS; bk += F.G) conv_gu_block(F, bk); }
    const int PER_L0 = I_IN + I_OUT + (conv_later ? 0 : DOWN_ITEMS), PER_L1 = I_IN + I_OUT + (conv_later ? 0 : DOWN_ITEMS), NITEMS = PER_L0 + PER_L1;
    for (int it = gw; it < NITEMS; it += NGW) {
        const int l = it < PER_L0 ? 0 : 1; int r = it - l * PER_L0;
        if (r < I_IN) continue;
        r -= I_IN;
        if (r < I_OUT) continue;
        r -= I_OUT;
        conv_expert_item(F, l, 2 * NEXP * 2048 + r, scr);
    }
    { const int gt = F.vcu * NTHR + F.tid, NGT = F.G * NTHR; constexpr int PADV = (DIN_PAD - DIN) * D * 2 / 16;
      for (int i = gt; i < DEPTH * PADV; i += NGT) { const int l = i / PADV, j = i % PADV; *(GAS v4u*)(F.ws + WS_WIN + l * WIN_L + (size_t)DIN * D * 2 + (size_t)j * 16) = (v4u){0u, 0u, 0u, 0u}; } }
    f32x4 pv[8];
#pragma unroll
    for (int j = 0; j < 8; ++j) pv[j] = (f32x4){0.f, 0.f, 0.f, 0.f};
    if (gw < M) row_load_f32(gw < TP ? F.in[0] + (size_t)gw * D : F.in[1] + (size_t)(gw - TP) * D, pv, F.lane);
    for (int m = gw; m < M; m += NGW) {
        f32x4 v[8];
#pragma unroll
        for (int j = 0; j < 8; ++j) v[j] = pv[j];
        if (m + NGW < M) { const int mn = m + NGW; row_load_f32(mn < TP ? F.in[0] + (size_t)mn * D : F.in[1] + (size_t)(mn - TP) * D, pv, F.lane); }
        ln_norm(v, F.in[2], F.in[3], F.lane);
        row_store_bf16((bfu*)(F.ws + WS_XN) + (size_t)m * D, v, F.lane);
        row_store_i8(F.ws + WS_XNI8 + (size_t)m * D, (float*)(F.ws + WS_RSC) + m, v, F.lane);
    }
}

__device__ __forceinline__ void qk_prep(Frame& F, int l) {
    const int gw = F.vcu * NWAVES + F.wave, NGW = F.G * NWAVES, lane = F.lane;
    const int hh = lane >> 3, sub = lane & 7, half = sub >> 2, a1 = 64 * half + 8 * (sub & 3);
    const float* gn = (hh < 6 ? F.in[6] : F.in[7]) + l * 128;
    float g1[8], g2[8], inv[8];
#pragma unroll
    for (int c = 0; c < 8; ++c) { g1[c] = gn[a1 + c]; g2[c] = gn[a1 + 32 + c]; inv[c] = exp2f(-(float)(2 * (8 * (sub & 3) + c)) * (13.287712379549449f / 64.f)) * 0.15915494309189535f; }
    bfu* P = (bfu*)(F.ws + WS_PROJ);
    const int coff = (hh < 6 ? C_AQ + hh * 128 : C_AK + (hh - 6) * 128) + a1;
    v4u w1 = {0u, 0u, 0u, 0u}, w2 = {0u, 0u, 0u, 0u};
    if (gw < M) { const bfu* p = P + (size_t)gw * PP + coff; w1 = *(const v4u*)p; w2 = *(const v4u*)(p + 32); }
    for (int m = gw; m < M; m += NGW) {
        const v4u c1 = w1, c2 = w2;
        if (m + NGW < M) { const bfu* p = P + (size_t)(m + NGW) * PP + coff; w1 = *(const v4u*)p; w2 = *(const v4u*)(p + 32); }
        const int t = m < TP ? m : (m - TP) % TS;
        const float pos = (float)(half == 0 ? (t >> 6) : (t & 63));
        float x1[8], x2[8]; float ss = 0.f;
        const unsigned* u1 = (const unsigned*)&c1; const unsigned* u2 = (const unsigned*)&c2;
#pragma unroll
        for (int k = 0; k < 4; ++k) { x1[2 * k] = __uint_as_float(u1[k] << 16); x1[2 * k + 1] = __uint_as_float(u1[k] & 0xffff0000u); x2[2 * k] = __uint_as_float(u2[k] << 16); x2[2 * k + 1] = __uint_as_float(u2[k] & 0xffff0000u); }
#pragma unroll
        for (int c = 0; c < 8; ++c) ss += x1[c] * x1[c] + x2[c] * x2[c];
        ss += __shfl_xor(ss, 1); ss += __shfl_xor(ss, 2); ss += __shfl_xor(ss, 4);
        const float rstd = 1.f / sqrtf(ss * (1.f / 128.f) + RMS_EPS);
        float o1[8], o2[8];
#pragma unroll
        for (int c = 0; c < 8; ++c) { const float rev = pos * inv[c]; const float cs = __builtin_amdgcn_cosf(rev), sn = __builtin_amdgcn_sinf(rev);
            const float n1 = x1[c] * rstd * g1[c], n2 = x2[c] * rstd * g2[c]; o1[c] = n1 * cs - n2 * sn; o2[c] = n1 * sn + n2 * cs; }
        v4u r1, r2; r1.x = pk2(o1[0], o1[1]); r1.y = pk2(o1[2], o1[3]); r1.z = pk2(o1[4], o1[5]); r1.w = pk2(o1[6], o1[7]); r2.x = pk2(o2[0], o2[1]); r2.y = pk2(o2[2], o2[3]); r2.z = pk2(o2[4], o2[5]); r2.w = pk2(o2[6], o2[7]);
        bfu* q = P + (size_t)m * PP + coff; *(v4u*)q = r1; *(v4u*)(q + 32) = r2;
        if (hh >= 6) { unsigned char* k8 = F.ws + WS_K8 + (size_t)m * 256 + (hh - 6) * 128 + a1;
            pg8::u32x2 e1, e2; e1.x = pg8::cvt4_fp8(o1[0], o1[1], o1[2], o1[3]); e1.y = pg8::cvt4_fp8(o1[4], o1[5], o1[6], o1[7]); e2.x = pg8::cvt4_fp8(o2[0], o2[1], o2[2], o2[3]); e2.y = pg8::cvt4_fp8(o2[4], o2[5], o2[6], o2[7]);
            *(pg8::u32x2*)k8 = e1; *(pg8::u32x2*)(k8 + 32) = e2; }
    }
}

__device__ __forceinline__ void vt8_pass(Frame& F) {
    const bfu* P = (const bfu*)(F.ws + WS_PROJ); unsigned char* T = (unsigned char*)F.ldsg;
    const int tid = F.tid, s_ = tid >> 3, d0 = (tid & 7) * 16;
    const int pos = 32 * ((s_ >> 2) & 1) + (s_ & 3) + 4 * ((s_ & 31) >> 3) + (s_ >= 32 ? 16 : 0);
    for (int u = F.vcu; u < 2 * NCHUNK; u += F.G) { const int kvh = u / NCHUNK, tt = u % NCHUNK;
        const bfu* src = P + (size_t)(64 * tt + s_) * PP + C_AV + kvh * 128 + d0;
        const attn::bf16x8 va = *(const attn::bf16x8*)src, vb = *(const attn::bf16x8*)(src + 8);
        WG_SYNC();
#pragma unroll
        for (int i = 0; i < 8; ++i) { const float x = bf2f((bfu)va[i]), y = bf2f((bfu)vb[i]);
            T[(d0 + i) * 64 + pos] = (unsigned char)(__builtin_amdgcn_cvt_pk_fp8_f32(x, x, 0, false) & 0xff); T[(d0 + 8 + i) * 64 + pos] = (unsigned char)(__builtin_amdgcn_cvt_pk_fp8_f32(y, y, 0, false) & 0xff); }
        WG_SYNC();
        *(v4u*)(F.ws + WS_VT8 + ((size_t)(kvh * NCHUNK + tt) * 128) * 64 + (size_t)tid * 16) = *(const v4u*)(T + tid * 16);
    }
    WG_SYNC();
}
__device__ __forceinline__ void attn_a_unit(Frame& F, int id) {
    int row0, kv0, nkeys, h;
    if (id < 192) { h = id >> 5; const int qb = id & 31; row0 = qb * 256; kv0 = 0; nkeys = TP; }
    else { const int j = id - 192, s = j / 48, rem = j % 48; h = rem >> 3; const int qb = rem & 7; kv0 = TP + s * TS; row0 = kv0 + qb * 256; nkeys = TS; }
    const attn::bf16* P = (const attn::bf16*)(F.ws + WS_PROJ);
    const int kvh = h / 3;
    attn::attn_dense_body88q(P + (size_t)row0 * PP + C_AQ + h * 128, F.ws + WS_K8 + (size_t)kv0 * 256 + kvh * 128, F.ws + WS_VT8 + ((size_t)kvh * NCHUNK + kv0 / 64) * 8192,
                            (attn::bf16*)(F.ws + WS_MIX) + (size_t)row0 * D + h * 128, nkeys, F.ldsg);
}
__device__ __forceinline__ void attn_a_phase(Frame& F) {
    const int c = F.vcu;
    const int cnt = (F.G == 256) ? (c < 192 ? 3 : 6) : (960 - c + F.G - 1) / F.G;
    for (int i = 0; i < cnt; ++i) {
        int id;
        if (F.G == 256) id = c < 192 ? (i == 0 ? c : 192 + 2 * c + (i - 1)) : 192 + 384 + (c - 192) * 6 + i;
        else id = c + i * F.G;
        attn_a_unit(F, id);
    }
}

namespace mixb {
using attn::bf16x8; using attn::f32x16; using attn::u32x4;
constexpr float NEG = -1e30f;
__device__ __forceinline__ int t5_bucket(int rp) {
    const int n = rp < 0 ? -rp : rp;
    int large = 8 + (int)(logf((float)(n > 1 ? n : 1) / 8.f) / 4.852030263919617f * 8.f);
    large = large < 15 ? large : 15;
    return (rp > 0 ? 16 : 0) + (n < 8 ? n : large);
}
__device__ __forceinline__ void stage_tile(Frame& F, char* slot, bool isV, int bn, int nb, int tok0, int dil, int colbase, int tp) {
    const bfu* P = (const bfu*)(F.ws + WS_PROJ);
    const bool valid = bn >= 0 && bn < nb; const int sr = tp >> 4, sc = (tp & 15) * 8;
    bf16x8 v[8];
#pragma unroll
    for (int i = 0; i < 8; ++i) { const int kk = sr + 8 * i; v[i] = (bf16x8){0, 0, 0, 0, 0, 0, 0, 0};
        if (valid) v[i] = *(const bf16x8*)(P + (size_t)(tok0 + (64 * bn + kk) * dil) * PP + colbase + sc); }
#pragma unroll
    for (int i = 0; i < 8; ++i) { const int kk = sr + 8 * i;
        if (isV) *(bf16x8*)(slot + attn::v_st(kk, sc)) = v[i]; else *(bf16x8*)(slot + KSWZ(kk, sc * 2)) = v[i]; }
}
#define MB_PK4(P, BASE, OUT) do { unsigned a0 = attn::cvtpk(P[BASE + 0], P[BASE + 1]), a1 = attn::cvtpk(P[BASE + 2], P[BASE + 3]);   \
    unsigned b0 = attn::cvtpk(P[BASE + 4], P[BASE + 5]), b1 = attn::cvtpk(P[BASE + 6], P[BASE + 7]);                              \
    auto r0 = __builtin_amdgcn_permlane32_swap(a0, b0, false, false); auto r1 = __builtin_amdgcn_permlane32_swap(a1, b1, false, false); \
    u32x4 w = {r0[0], r1[0], r0[1], r1[1]}; OUT = *reinterpret_cast<bf16x8*>(&w); } while (0)
__device__ __forceinline__ float score_fix(f32x16& p0, f32x16& p1, int kt, bool bvalid, int iq, int hi, const float* bt, float mx) {
#pragma unroll
    for (int r = 0; r < 16; ++r) {
        const int kk = attn::crow(r, hi);
        { const int rel = 64 * (kt - 1) + kk - iq; const bool ok = bvalid && rel >= -64 && rel <= 64; const int bi = ok ? rel + 64 : 64;
          const float s = ok ? p0[r] * attn::SCALE + bt[bi] : NEG; p0[r] = s; mx = fmaxf(mx, s); }
        { const int rel = 64 * (kt - 1) + kk + 32 - iq; const bool ok = bvalid && rel >= -64 && rel <= 64; const int bi = ok ? rel + 64 : 64;
          const float s = ok ? p1[r] * attn::SCALE + bt[bi] : NEG; p1[r] = s; mx = fmaxf(mx, s); }
    }
    return mx;
}
__device__ __forceinline__ float score_exp(f32x16& p0, f32x16& p1, float m) {
    float sum = 0.f;
#pragma unroll
    for (int r = 0; r < 16; ++r) { p0[r] = __builtin_amdgcn_exp2f((p0[r] - m) * 1.4426950408889634f); p1[r] = __builtin_amdgcn_exp2f((p1[r] - m) * 1.4426950408889634f); sum += p0[r] + p1[r]; }
    return sum;
}
__device__ __forceinline__ void mixer_b_phase(Frame& F) {
    const int tid = F.tid, lane = F.lane, wave = F.wave, r32 = lane & 31, hi = lane >> 5;
    const int p = wave >> 1, wq = wave & 1, tp = tid & 127;
    char* slotA = F.ldsg + p * 32768; char* slotB = slotA + 16384;
    float* bt = (float*)(F.ldsg + 131072 + p * 528);
    float* li_l = (float*)(F.ldsg + 131072 + 2112 + wave * 128);
    const float* rel_bias = F.in[4];
    bfu* MIXp = (bfu*)(F.ws + WS_MIX); float* LSE = (float*)(F.ws + WS_LSE);
    const bfu* P = (const bfu*)(F.ws + WS_PROJ);
    for (int ui = F.vcu; ui < 960; ui += F.G) {
        const int qid = ui * 4 + p, head6 = qid / 640, blk = qid % 640;
        const int s = blk < 128 ? 0 : 1 + (blk - 128) / 32, lb = blk < 128 ? blk : (blk - 128) % 32;
        const int g = head6 >> 1, dil = 1 << (2 * g), T = seq_len(s), L = T / dil, nb = L / 64, r = lb / nb, n = lb % nb;
        const int tok0 = seq_start(s) + r;
        WG_SYNC();
        for (int bi = tp; bi < 129; bi += 128) bt[bi] = rel_bias[t5_bucket((bi - 64) * dil) * 6 + head6];
        const int iq = 32 * wq + r32;
        bf16x8 qr[8];
        { const bfu* Qw = P + (size_t)(tok0 + (64 * n + iq) * dil) * PP + C_BQ + head6 * 128 + hi * 8;
#pragma unroll
          for (int d0 = 0; d0 < 8; ++d0) qr[d0] = *(const bf16x8*)(Qw + d0 * 16); }
        const int kcol = C_BK + head6 * 128, vcol = C_BV + head6 * 128;
        f32x16 s00, s01, s10, s11, s20, s21;
        stage_tile(F, slotA, false, n - 1, nb, tok0, dil, kcol, tp); stage_tile(F, slotB, false, n, nb, tok0, dil, kcol, tp);
        WG_SYNC();
        attn::qkt(s00, s01, (const attn::bf16*)slotA, qr, r32, hi); attn::qkt(s10, s11, (const attn::bf16*)slotB, qr, r32, hi);
        WG_SYNC();
        stage_tile(F, slotA, false, n + 1, nb, tok0, dil, kcol, tp); stage_tile(F, slotB, true, n - 1, nb, tok0, dil, vcol, tp);
        WG_SYNC();
        attn::qkt(s20, s21, (const attn::bf16*)slotA, qr, r32, hi);
        float mx = NEG;
        mx = score_fix(s00, s01, 0, n - 1 >= 0, iq, hi, bt, mx); mx = score_fix(s10, s11, 1, true, iq, hi, bt, mx); mx = score_fix(s20, s21, 2, n + 1 < nb, iq, hi, bt, mx);
        { auto rr = __builtin_amdgcn_permlane32_swap(__float_as_uint(mx), __float_as_uint(mx), false, false); mx = fmaxf(__uint_as_float(rr[0]), __uint_as_float(rr[1])); }
        float den = score_exp(s00, s01, mx) + score_exp(s10, s11, mx) + score_exp(s20, s21, mx);
        { auto rr = __builtin_amdgcn_permlane32_swap(__float_as_uint(den), __float_as_uint(den), false, false); den = __uint_as_float(rr[0]) + __uint_as_float(rr[1]); }
        f32x16 o[4] = {};
        bf16x8 pa0, pa1, pa2, pa3;
        const int vbA = (int)(uintptr_t)slotA + attn::v_rd_base(lane), vbB = (int)(uintptr_t)slotB + attn::v_rd_base(lane);
        MB_PK4(s00, 0, pa0); MB_PK4(s00, 8, pa1); MB_PK4(s01, 0, pa2); MB_PK4(s01, 8, pa3);
        attn::pv_d0(o, vbB, pa0, pa1, pa2, pa3);
        WG_SYNC();
        stage_tile(F, slotA, true, n, nb, tok0, dil, vcol, tp); stage_tile(F, slotB, true, n + 1, nb, tok0, dil, vcol, tp);
        WG_SYNC();
        MB_PK4(s10, 0, pa0); MB_PK4(s10, 8, pa1); MB_PK4(s11, 0, pa2); MB_PK4(s11, 8, pa3);
        attn::pv_d0(o, vbA, pa0, pa1, pa2, pa3);
        MB_PK4(s20, 0, pa0); MB_PK4(s20, 8, pa1); MB_PK4(s21, 0, pa2); MB_PK4(s21, 8, pa3);
        attn::pv_d0(o, vbB, pa0, pa1, pa2, pa3);
        if (hi == 0) { li_l[r32] = den; LSE[(size_t)(tok0 + (64 * n + iq) * dil) * 6 + head6] = mx + logf(den); }
        asm volatile("s_waitcnt lgkmcnt(0)" ::: "memory");
#pragma unroll
        for (int rr = 0; rr < 16; ++rr) { const int q = attn::crow(rr, hi); const float rl = __builtin_amdgcn_rcpf(li_l[q]);
            bfu* orow = MIXp + (size_t)(tok0 + (64 * n + 32 * wq + q) * dil) * D + MIX_B + head6 * 128 + r32;
#pragma unroll
            for (int d0 = 0; d0 < 4; ++d0) orow[d0 * 32] = (bfu)f2bf(o[d0][rr] * rl); }
    }
    WG_SYNC();
}
__device__ __forceinline__ void mix_row_pass(Frame& F) {
    const int gw = F.vcu * NWAVES + F.wave, NGW = F.G * NWAVES, lane = F.lane;
    const bfu* MIXp = (const bfu*)(F.ws + WS_MIX); const float* LSE = (const float*)(F.ws + WS_LSE);
    for (int m = gw; m < M; m += NGW) {
        const float* l6 = LSE + (size_t)m * 6;
        float w[6];
#pragma unroll
        for (int j = 0; j < 2; ++j) { const float a = l6[j], b = l6[2 + j], c = l6[4 + j], mx = fmaxf(a, fmaxf(b, c));
            const float ea = expf(a - mx), eb = expf(b - mx), ec = expf(c - mx), inv = 1.f / (ea + eb + ec); w[j] = ea * inv; w[2 + j] = eb * inv; w[4 + j] = ec * inv; }
        f32x4 v[8];
        row_load_bf16(MIXp + (size_t)m * D, v, lane, 1.f);
#pragma unroll
        for (int j = 0; j < 4; ++j) { const int col = 8 * lane + 512 * j;
            if (col >= MIX_B && col < MIX_C) { const int h6 = (col - MIX_B) >> 7; float wt = w[0];
#pragma unroll
                for (int k = 1; k < 6; ++k) wt = (h6 == k) ? w[k] : wt;
                v[2 * j] = v[2 * j] * wt; v[2 * j + 1] = v[2 * j + 1] * wt; } }
        row_store_i8(F.ws + WS_MIXI8 + (size_t)m * D, (float*)(F.ws + WS_RSC2) + m, v, lane);
    }
}
}

namespace gla {
using attn::bf16x8; using attn::f32x16;
constexpr int L_CUM = 0, L_GT = 16384, L_TOT = 18432, L_Z = 18688, L_QT = 22784, L_KT = 32000, L_ATT = 41216, L_VT = 50432, L_ST = 68864, L_O = 87296, LD = 72, LDO_ = 132;
static_assert(L_O + 64 * LDO_ * 4 <= SCR_BYTES, "gla lds");
__device__ __forceinline__ float logsig(float x) { return fminf(x, 0.f) - log1pf(expf(-fabsf(x))); }
__device__ __forceinline__ f32x16 lds_mma(const bfu* A, const bfu* Bt, int K, f32x16 acc, int lane) {
    const int r = lane & 31, hi = lane >> 5;
    for (int k0 = 0; k0 < K; k0 += 16) {
        const bf16x8 a = *(const bf16x8*)(A + r * LD + k0 + hi * 8), b = *(const bf16x8*)(Bt + r * LD + k0 + hi * 8);
        acc = __builtin_amdgcn_mfma_f32_32x32x16_bf16(a, b, acc, 0, 0, 0);
    }
    return acc;
}
__device__ __forceinline__ void compute_cum(Frame& F, int l, int row0, int h, int dir) {
    float* CUM = (float*)(F.ldsg + L_CUM); float* GT = (float*)(F.ldsg + L_GT); float* TOT = (float*)(F.ldsg + L_TOT); float* Z = (float*)(F.ldsg + L_Z);
    const bfu* P = (const bfu*)(F.ws + WS_PROJ);
    const int tid = F.tid;
    { const int t = tid >> 3, r2 = (tid & 7) * 2; const unsigned zz = *(const unsigned*)(P + (size_t)(row0 + t) * PP + (dir ? C_ZB : C_ZF) + r2);
      Z[t * 16 + r2] = __uint_as_float(zz << 16); Z[t * 16 + r2 + 1] = __uint_as_float(zz & 0xffff0000u); }
    const int k = tid & 63, tg = tid >> 6, col = h * 64 + k;
    const float* wv = (dir ? F.in[10] : F.in[8]) + (size_t)l * 16 * 256; const float bias = ((dir ? F.in[11] : F.in[9]) + l * 256)[col];
    float w[16];
#pragma unroll
    for (int r = 0; r < 16; ++r) w[r] = wv[r * 256 + col];
    WG_SYNC();
    float la[8];
#pragma unroll
    for (int i = 0; i < 8; ++i) { const float* z = Z + (8 * tg + i) * 16; float pre = bias;
#pragma unroll
        for (int r = 0; r < 16; ++r) pre += z[r] * w[r];
        la[i] = logsig(pre) * (1.f / 16.f); }
    float run = 0.f;
    if (dir == 0) {
#pragma unroll
        for (int i = 0; i < 8; ++i) { run += la[i]; la[i] = run; }
    } else {
#pragma unroll
        for (int i = 7; i >= 0; --i) { run += la[i]; la[i] = run; }
    }
    GT[tg * 64 + k] = run;
    WG_SYNC();
    float off = 0.f, tot = 0.f;
#pragma unroll
    for (int g = 0; g < 8; ++g) { const float x = GT[g * 64 + k]; tot += x; if (dir == 0 ? (g < tg) : (g > tg)) off += x; }
#pragma unroll
    for (int i = 0; i < 8; ++i) CUM[(8 * tg + i) * 64 + k] = la[i] + off;
    if (tg == 0) TOT[k] = tot;
    WG_SYNC();
}
__device__ __forceinline__ void stage_vt(Frame& F, int row0, int h) {
    const bfu* P = (const bfu*)(F.ws + WS_PROJ); bfu* VT = (bfu*)(F.ldsg + L_VT);
    const int s = F.tid >> 3, vg = (F.tid & 7) * 16;
    const bfu* src = P + (size_t)(row0 + s) * PP + C_CV + h * 128 + vg;
    const bf16x8 a = *(const bf16x8*)src, b = *(const bf16x8*)(src + 8);
#pragma unroll
    for (int j = 0; j < 8; ++j) { VT[(vg + j) * LD + s] = (bfu)a[j]; VT[(vg + 8 + j) * LD + s] = (bfu)b[j]; }
}
constexpr int N_CUM0 = 0, N_CUM1 = 16384, N_GT0 = 32768, N_GT1 = 34816, N_TOT0 = 36864, N_TOT1 = 37120, N_Z0 = 37376, N_Z1 = 41472, N_KH0 = 45568, N_KH1 = 54784, N_VT = 64000;
static_assert(N_VT + 18432 <= SCR_BYTES, "gla c1 lds");
__device__ __forceinline__ float fexp(float x) { return __builtin_amdgcn_exp2f(x * 1.4426950408889634f); }
__device__ __forceinline__ float logsig_fast(float x) { return fminf(x, 0.f) - 0.6931471805599453f * __builtin_amdgcn_logf(1.f + fexp(-fabsf(x))); }
__device__ __forceinline__ void c1_phase(Frame& F, int l) {
    const bfu* P = (const bfu*)(F.ws + WS_PROJ);
    bfu* DUT = (bfu*)(F.ws + WS_HID); float* ADEC = (float*)(F.ws + WS_ADEC);
    bfu* QKT = (bfu*)(F.ws + WS_QKT);
    float* CUM0 = (float*)(F.ldsg + N_CUM0); float* CUM1 = (float*)(F.ldsg + N_CUM1); float* GT0 = (float*)(F.ldsg + N_GT0); float* GT1 = (float*)(F.ldsg + N_GT1);
    float* TOT0 = (float*)(F.ldsg + N_TOT0); float* TOT1 = (float*)(F.ldsg + N_TOT1); float* Z0 = (float*)(F.ldsg + N_Z0); float* Z1 = (float*)(F.ldsg + N_Z1);
    bfu* KH0 = (bfu*)(F.ldsg + N_KH0); bfu* KH1 = (bfu*)(F.ldsg + N_KH1); bfu* VT = (bfu*)(F.ldsg + N_VT);
    const int tid = F.tid, lane = F.lane, wave = F.wave;
    const int k_ = tid & 63, tg = tid >> 6, s_ = tid >> 3, kg = (tid & 7) * 8, vg = (tid & 7) * 16, r2 = (tid & 7) * 2;
#define C1_LBAR() do { asm volatile("s_waitcnt lgkmcnt(0)" ::: "memory"); __builtin_amdgcn_s_barrier(); asm volatile("" ::: "memory"); } while (0)
#define C1_LOAD(u_, zf_, zb_, kk_, qq_, va_, vb_) do { const int h_ = (u_) & 3; const bfu* rp_ = P + (size_t)(((u_) >> 2) * 64 + s_) * PP; \
        zf_ = *(const unsigned*)(rp_ + C_ZF + r2); zb_ = *(const unsigned*)(rp_ + C_ZB + r2); \
        kk_ = *(const bf16x8*)(rp_ + C_CK + h_ * 64 + kg); qq_ = *(const bf16x8*)(rp_ + C_CQ + h_ * 64 + kg); \
        va_ = *(const bf16x8*)(rp_ + C_CV + h_ * 128 + vg); vb_ = *(const bf16x8*)(rp_ + C_CV + h_ * 128 + vg + 8); } while (0)
    unsigned zf = 0u, zb = 0u; bf16x8 kk = {0, 0, 0, 0, 0, 0, 0, 0}, qq = kk, va = kk, vb = kk;
    if (F.vcu < NCHUNK * 4) C1_LOAD(F.vcu, zf, zb, kk, qq, va, vb);
    for (int u = F.vcu; u < NCHUNK * 4; u += F.G) {
        const int gc = u >> 2, h = u & 3, col = h * 64 + k_;
        float wf[16], wb[16];
        { const float* pf = F.in[8] + (size_t)l * 16 * 256 + col; const float* pb = F.in[10] + (size_t)l * 16 * 256 + col;
#pragma unroll
          for (int r = 0; r < 16; ++r) { wf[r] = pf[r * 256]; wb[r] = pb[r * 256]; } }
        const float bif = (F.in[9] + l * 256)[col], bib = (F.in[11] + l * 256)[col];
        C1_LBAR();
        Z0[s_ * 16 + r2] = __uint_as_float(zf << 16); Z0[s_ * 16 + r2 + 1] = __uint_as_float(zf & 0xffff0000u);
        Z1[s_ * 16 + r2] = __uint_as_float(zb << 16); Z1[s_ * 16 + r2 + 1] = __uint_as_float(zb & 0xffff0000u);
#pragma unroll
        for (int j = 0; j < 8; ++j) { VT[(vg + j) * LD + s_] = (bfu)va[j]; VT[(vg + 8 + j) * LD + s_] = (bfu)vb[j]; }
        unsigned nzf = 0u, nzb = 0u; bf16x8 nkk = {0, 0, 0, 0, 0, 0, 0, 0}, nqq = nkk, nva = nkk, nvb = nkk;
        if (u + F.G < NCHUNK * 4) C1_LOAD(u + F.G, nzf, nzb, nkk, nqq, nva, nvb);
        C1_LBAR();
        float la0[8], la1[8];
#pragma unroll
        for (int i = 0; i < 8; ++i) { const float* z0 = Z0 + (8 * tg + i) * 16; const float* z1 = Z1 + (8 * tg + i) * 16; float p0 = bif, p1 = bib;
#pragma unroll
            for (int r = 0; r < 16; ++r) { p0 += z0[r] * wf[r]; p1 += z1[r] * wb[r]; }
            la0[i] = logsig_fast(p0) * (1.f / 16.f); la1[i] = logsig_fast(p1) * (1.f / 16.f); }
        { float run = 0.f;
#pragma unroll
          for (int i = 0; i < 8; ++i) { run += la0[i]; la0[i] = run; }
          GT0[tg * 64 + k_] = run; run = 0.f;
#pragma unroll
          for (int i = 7; i >= 0; --i) { run += la1[i]; la1[i] = run; }
          GT1[tg * 64 + k_] = run; }
        C1_LBAR();
        { float off0 = 0.f, tot0 = 0.f, off1 = 0.f, tot1 = 0.f;
#pragma unroll
          for (int g = 0; g < 8; ++g) { const float x0 = GT0[g * 64 + k_], x1 = GT1[g * 64 + k_]; tot0 += x0; tot1 += x1; if (g < tg) off0 += x0; if (g > tg) off1 += x1; }
#pragma unroll
          for (int i = 0; i < 8; ++i) { CUM0[(8 * tg + i) * 64 + k_] = la0[i] + off0; CUM1[(8 * tg + i) * 64 + k_] = la1[i] + off1; }
          if (tg == 0) { TOT0[k_] = tot0; TOT1[k_] = tot1; } }
        C1_LBAR();
#pragma unroll
        for (int dir = 0; dir < 2; ++dir) { const float* CUM = dir ? CUM1 : CUM0; const float* TOT = dir ? TOT1 : TOT0; bfu* KhT = dir ? KH1 : KH0;
            float qv[8], kv[8];
#pragma unroll
            for (int j = 0; j < 8; ++j) { const float c = CUM[s_ * 64 + kg + j], kf = bf2f((bfu)kk[j]), en = fexp(-c);
                KhT[(kg + j) * LD + s_] = (bfu)f2bf(kf * en * fexp(TOT[kg + j]));
                kv[j] = kf * en; qv[j] = bf2f((bfu)qq[j]) * 0.125f * fexp(c); }
            v4u wq_, wk_; wq_.x = pk2(qv[0], qv[1]); wq_.y = pk2(qv[2], qv[3]); wq_.z = pk2(qv[4], qv[5]); wq_.w = pk2(qv[6], qv[7]);
            wk_.x = pk2(kv[0], kv[1]); wk_.y = pk2(kv[2], kv[3]); wk_.z = pk2(kv[4], kv[5]); wk_.w = pk2(kv[6], kv[7]);
            bfu* qk = QKT + ((size_t)((gc * 4 + h) * 2 + dir) * 2) * 4096 + s_ * 64 + kg;
            *(v4u*)qk = wq_; *(v4u*)(qk + 4096) = wk_; }
        C1_LBAR();
        { const int dir = wave >> 2, vt = wave & 3; const bfu* KhT = dir ? KH1 : KH0; const float* TOT = dir ? TOT1 : TOT0;
          const int unit = (gc * 4 + h) * 2 + dir; bfu* dst = DUT + (size_t)unit * 8192;
#pragma unroll
          for (int kt = 0; kt < 2; ++kt) { f32x16 acc = {};
              acc = lds_mma(VT + 32 * vt * LD, KhT + 32 * kt * LD, 64, acc, lane);
#pragma unroll
              for (int rr = 0; rr < 16; ++rr) dst[(32 * vt + attn::crow(rr, lane >> 5)) * 64 + 32 * kt + (lane & 31)] = (bfu)f2bf(acc[rr]); }
          if ((tid & 255) < 64) ADEC[unit * 64 + (tid & 255)] = fexp(TOT[tid & 255]); }
        zf = nzf; zb = nzb; kk = nkk; qq = nqq; va = nva; vb = nvb;
    }
    WG_SYNC();
#undef C1_LBAR
#undef C1_LOAD
}
__device__ __forceinline__ void c2_phase(Frame& F) {
    bfu* DUT = (bfu*)(F.ws + WS_HID); const float* ADEC = (const float*)(F.ws + WS_ADEC);
    const int NT = 17 * 8 * 1024;
    for (int idx = F.vcu * NTHR + F.tid; idx < NT; idx += F.G * NTHR) {
        const int grp = idx >> 10, e8 = idx & 1023, s = grp >> 3, h = (grp >> 1) & 3, d = grp & 1;
        const int nch = seq_len(s) / 64, gc0 = seq_start(s) / 64;
        float S[8];
#pragma unroll
        for (int c = 0; c < 8; ++c) S[c] = 0.f;
        for (int n = 0; n < nch; n += 8) {
            v4u x[8]; f32x4 a0[8], a1[8]; v4u* p[8];
#pragma unroll
            for (int q = 0; q < 8; ++q) { const int gc = d == 0 ? gc0 + n + q : gc0 + nch - 1 - (n + q); const int unit = (gc * 4 + h) * 2 + d;
                p[q] = (v4u*)(DUT + (size_t)unit * 8192) + e8; x[q] = *p[q]; const float* ap = ADEC + unit * 64 + (e8 & 7) * 8; a0[q] = *(const f32x4*)ap; a1[q] = *(const f32x4*)(ap + 4); }
#pragma unroll
            for (int q = 0; q < 8; ++q) { v4u o; o.x = pk2(S[0], S[1]); o.y = pk2(S[2], S[3]); o.z = pk2(S[4], S[5]); o.w = pk2(S[6], S[7]); *p[q] = o;
                const unsigned* xu = (const unsigned*)&x[q];
                S[0] = a0[q].x * S[0] + __uint_as_float(xu[0] << 16); S[1] = a0[q].y * S[1] + __uint_as_float(xu[0] & 0xffff0000u);
                S[2] = a0[q].z * S[2] + __uint_as_float(xu[1] << 16); S[3] = a0[q].w * S[3] + __uint_as_float(xu[1] & 0xffff0000u);
                S[4] = a1[q].x * S[4] + __uint_as_float(xu[2] << 16); S[5] = a1[q].y * S[5] + __uint_as_float(xu[2] & 0xffff0000u);
                S[6] = a1[q].z * S[6] + __uint_as_float(xu[3] << 16); S[7] = a1[q].w * S[7] + __uint_as_float(xu[3] & 0xffff0000u); }
        }
    }
}
constexpr int M_QT0 = 0, M_KT0 = 9216, M_QT1 = 18432, M_KT1 = 27648, M_ATT0 = 36864, M_ATT1 = 46080, M_VT = 55296, M_ST0 = 73728, M_ST1 = 92160, M_O = 0;
static_assert(M_ST1 + 18432 <= SCR_BYTES && 64 * LDO_ * 4 <= M_ATT0, "gla c3 lds");
__device__ __forceinline__ void c3_phase(Frame& F, int l) {
    const bfu* P = (const bfu*)(F.ws + WS_PROJ); const bfu* DUT = (const bfu*)(F.ws + WS_HID); const bfu* QKT = (const bfu*)(F.ws + WS_QKT);
    bfu* VT = (bfu*)(F.ldsg + M_VT); float* O = (float*)(F.ldsg + M_O);
    bfu* MIXp = (bfu*)(F.ws + WS_MIX); const float* ng = F.in[12] + l * 128;
    const int tid = F.tid, lane = F.lane, wave = F.wave, hi = lane >> 5;
    const int s_ = tid >> 3, kg = (tid & 7) * 8, vg = (tid & 7) * 16, sv = tid >> 2, sk0 = (tid & 3) * 16;
    v4u q0, k0, q1, k1; bf16x8 va, vb, g0, g1; v4u sa0, sa1, sb0, sb1;
#define C3_LOAD(uu) do { const int gc_ = (uu) >> 2, h_ = (uu) & 3, row0_ = gc_ * 64; \
        const bfu* qk_ = QKT + (size_t)((gc_ * 4 + h_) * 4) * 4096 + s_ * 64 + kg;                \
        q0 = *(const v4u*)qk_; k0 = *(const v4u*)(qk_ + 4096); q1 = *(const v4u*)(qk_ + 8192); k1 = *(const v4u*)(qk_ + 12288); \
        const bfu* vsrc_ = P + (size_t)(row0_ + s_) * PP + C_CV + h_ * 128 + vg; va = *(const bf16x8*)vsrc_; vb = *(const bf16x8*)(vsrc_ + 8); \
        const bfu* gp_ = P + (size_t)(row0_ + s_) * PP + C_CG + h_ * 128 + vg; g0 = *(const bf16x8*)gp_; g1 = *(const bf16x8*)(gp_ + 8); \
        const bfu* s0p_ = DUT + (size_t)((gc_ * 4 + h_) * 2) * 8192 + sv * 64 + sk0; const bfu* s1p_ = s0p_ + 8192; \
        sa0 = *(const v4u*)s0p_; sa1 = *(const v4u*)(s0p_ + 8); sb0 = *(const v4u*)s1p_; sb1 = *(const v4u*)(s1p_ + 8); } while (0)
    if (F.vcu < NCHUNK * 4) C3_LOAD(F.vcu);
    for (int u = F.vcu; u < NCHUNK * 4; u += F.G) {
        const int gc = u >> 2, h = u & 3, row0 = gc * 64;
        const bf16x8 g0c = g0, g1c = g1;
        WG_SYNC();
        *(v4u*)(F.ldsg + M_QT0 + (s_ * LD + kg) * 2) = q0; *(v4u*)(F.ldsg + M_KT0 + (s_ * LD + kg) * 2) = k0;
        *(v4u*)(F.ldsg + M_QT1 + (s_ * LD + kg) * 2) = q1; *(v4u*)(F.ldsg + M_KT1 + (s_ * LD + kg) * 2) = k1;
#pragma unroll
        for (int j = 0; j < 8; ++j) { VT[(vg + j) * LD + s_] = (bfu)va[j]; VT[(vg + 8 + j) * LD + s_] = (bfu)vb[j]; }
        *(v4u*)(F.ldsg + M_ST0 + (sv * LD + sk0) * 2) = sa0; *(v4u*)(F.ldsg + M_ST0 + (sv * LD + sk0 + 8) * 2) = sa1;
        *(v4u*)(F.ldsg + M_ST1 + (sv * LD + sk0) * 2) = sb0; *(v4u*)(F.ldsg + M_ST1 + (sv * LD + sk0 + 8) * 2) = sb1;
        if (u + F.G < NCHUNK * 4) C3_LOAD(u + F.G);
        WG_SYNC();
        {
          const int dir = wave >> 2, th = (wave >> 1) & 1, sh = wave & 1;
          const bfu* QTd = (const bfu*)(F.ldsg + (dir ? M_QT1 : M_QT0)); const bfu* KTd = (const bfu*)(F.ldsg + (dir ? M_KT1 : M_KT0)); bfu* ATTd = (bfu*)(F.ldsg + (dir ? M_ATT1 : M_ATT0));
          f32x16 a = {};
          a = lds_mma(QTd + 32 * th * LD, KTd + 32 * sh * LD, 64, a, lane);
#pragma unroll
          for (int rr = 0; rr < 16; ++rr) { const int t = 32 * th + attn::crow(rr, hi), sx = 32 * sh + (lane & 31); const bool keep = dir == 0 ? (sx <= t) : (sx >= t);
              ATTd[t * LD + sx] = (bfu)f2bf(keep ? a[rr] : 0.f); } }
        WG_SYNC();
        f32x16 oacc = {};
        { const int th = wave >> 2, vq = wave & 3;
          oacc = lds_mma((const bfu*)(F.ldsg + M_ATT0) + 32 * th * LD, VT + 32 * vq * LD, 64, oacc, lane);
          oacc = lds_mma((const bfu*)(F.ldsg + M_QT0) + 32 * th * LD, (const bfu*)(F.ldsg + M_ST0) + 32 * vq * LD, 64, oacc, lane);
          oacc = lds_mma((const bfu*)(F.ldsg + M_ATT1) + 32 * th * LD, VT + 32 * vq * LD, 64, oacc, lane);
          oacc = lds_mma((const bfu*)(F.ldsg + M_QT1) + 32 * th * LD, (const bfu*)(F.ldsg + M_ST1) + 32 * vq * LD, 64, oacc, lane); }
        WG_SYNC();
        { const int th = wave >> 2, vq = wave & 3;
#pragma unroll
          for (int rr = 0; rr < 16; ++rr) O[(32 * th + attn::crow(rr, hi)) * LDO_ + 32 * vq + (lane & 31)] = oacc[rr]; }
        WG_SYNC();
        { const int t = s_; float ov[16]; float ss = 0.f;
#pragma unroll
          for (int j = 0; j < 16; ++j) { ov[j] = O[t * LDO_ + vg + j]; ss += ov[j] * ov[j]; }
          ss += __shfl_xor(ss, 1); ss += __shfl_xor(ss, 2); ss += __shfl_xor(ss, 4);
          const float rstd = 1.f / sqrtf(ss * (1.f / 128.f) + RMS_EPS);
          float r[16];
#pragma unroll
          for (int j = 0; j < 16; ++j) { const float gt = bf2f((bfu)(j < 8 ? g0c[j] : g1c[j - 8])); const float sg = gt / (1.f + expf(-gt)); r[j] = ov[j] * rstd * ng[vg + j] * sg; }
          v4u w0, w1; w0.x = pk2(r[0], r[1]); w0.y = pk2(r[2], r[3]); w0.z = pk2(r[4], r[5]); w0.w = pk2(r[6], r[7]); w1.x = pk2(r[8], r[9]); w1.y = pk2(r[10], r[11]); w1.z = pk2(r[12], r[13]); w1.w = pk2(r[14], r[15]);
          bfu* dst = MIXp + (size_t)(row0 + t) * D + MIX_C + h * 128 + vg;
          *(v4u*)dst = w0; *(v4u*)(dst + 8) = w1; }
    }
    WG_SYNC();
}
}

__device__ __forceinline__ void ln1_router_phase(Frame& F, int l) {
    float* WL = (float*)F.ldsg;
    const float* wr = F.in[16] + (size_t)l * D * NEXP;
    WG_SYNC();
    for (int idx = F.tid; idx < D * 4; idx += NTHR) { const int col = idx >> 2, e4 = (idx & 3) * 4; const f32x4 w = *(const f32x4*)(wr + col * 16 + e4);
        const int jj = (col >> 9) * 2 + ((col >> 2) & 1), ln = (col & 511) >> 3, c = col & 3;
        float* dst = WL + (jj * 64 + ln) * 4 + c;
        dst[(e4 + 0) * D] = w.x; dst[(e4 + 1) * D] = w.y; dst[(e4 + 2) * D] = w.z; dst[(e4 + 3) * D] = w.w; }
    WG_SYNC();
    const int gw = F.vcu * NWAVES + F.wave, NGW = F.G * NWAVES, lane = F.lane;
    const float* g = F.in[14] + l * D; const float* b = F.in[15] + l * D;
    float* AFFT = (float*)(F.ws + WS_AFFT);
    const bfu* XNb = (const bfu*)(F.ws + WS_XN); const bfu* MOb = (const bfu*)(F.ws + WS_HID);
    v4u px[4], pm[4];
#pragma unroll
    for (int j = 0; j < 4; ++j) { px[j] = (v4u){0u, 0u, 0u, 0u}; pm[j] = px[j]; }
    if (gw < M) {
#pragma unroll
        for (int j = 0; j < 4; ++j) { px[j] = *(const v4u*)(XNb + (size_t)gw * D + 8 * lane + 512 * j); pm[j] = *(const v4u*)(MOb + (size_t)gw * D + 8 * lane + 512 * j); } }
    for (int m = gw; m < M; m += NGW) {
        bfu* xn = (bfu*)(F.ws + WS_XN) + (size_t)m * D;
        f32x4 v[8];
#pragma unroll
        for (int j = 0; j < 4; ++j) { const v4u x = px[j], y = pm[j];
            v[2 * j] = (f32x4){__uint_as_float(x.x << 16) * DN_ALPHA + __uint_as_float(y.x << 16), __uint_as_float(x.x & 0xffff0000u) * DN_ALPHA + __uint_as_float(y.x & 0xffff0000u),
                               __uint_as_float(x.y << 16) * DN_ALPHA + __uint_as_float(y.y << 16), __uint_as_float(x.y & 0xffff0000u) * DN_ALPHA + __uint_as_float(y.y & 0xffff0000u)};
            v[2 * j + 1] = (f32x4){__uint_as_float(x.z << 16) * DN_ALPHA + __uint_as_float(y.z << 16), __uint_as_float(x.z & 0xffff0000u) * DN_ALPHA + __uint_as_float(y.z & 0xffff0000u),
                                   __uint_as_float(x.w << 16) * DN_ALPHA + __uint_as_float(y.w << 16), __uint_as_float(x.w & 0xffff0000u) * DN_ALPHA + __uint_as_float(y.w & 0xffff0000u)}; }
        if (m + NGW < M) {
#pragma unroll
            for (int j = 0; j < 4; ++j) { px[j] = *(const v4u*)(XNb + (size_t)(m + NGW) * D + 8 * lane + 512 * j); pm[j] = *(const v4u*)(MOb + (size_t)(m + NGW) * D + 8 * lane + 512 * j); } }
        ln_norm(v, g, b, lane);
        row_store_bf16(xn, v, lane);
        row_store_i8(F.ws + WS_XNI8 + (size_t)m * D, (float*)(F.ws + WS_RSC) + m, v, lane);
        float lg[16];
#pragma unroll
        for (int e = 0; e < 16; ++e) lg[e] = 0.f;
#pragma unroll
        for (int j = 0; j < 8; ++j) {
#pragma unroll
            for (int e = 0; e < 16; ++e) { const f32x4 w = *(const f32x4*)(WL + e * D + (j * 64 + lane) * 4); lg[e] += (v[j].x * w.x + v[j].y * w.y) + (v[j].z * w.z + v[j].w * w.w); }
            asm volatile("" ::: "memory");
        }
        float r8[8], r4[4], r2[2], r1;
        { const bool up = (lane & 32) != 0;
#pragma unroll
          for (int i = 0; i < 8; ++i) { const float keep = up ? lg[i + 8] : lg[i], send = up ? lg[i] : lg[i + 8]; r8[i] = keep + __shfl_xor(send, 32); } }
        { const bool up = (lane & 16) != 0;
#pragma unroll
          for (int i = 0; i < 4; ++i) { const float keep = up ? r8[i + 4] : r8[i], send = up ? r8[i] : r8[i + 4]; r4[i] = keep + __shfl_xor(send, 16); } }
        { const bool up = (lane & 8) != 0;
#pragma unroll
          for (int i = 0; i < 2; ++i) { const float keep = up ? r4[i + 2] : r4[i], send = up ? r4[i] : r4[i + 2]; r2[i] = keep + __shfl_xor(send, 8); } }
        { const bool up = (lane & 4) != 0; const float keep = up ? r2[1] : r2[0], send = up ? r2[0] : r2[1]; r1 = keep + __shfl_xor(send, 4); }
        r1 += __shfl_xor(r1, 2); r1 += __shfl_xor(r1, 1);
        float mx = r1;
        mx = fmaxf(mx, __shfl_xor(mx, 4)); mx = fmaxf(mx, __shfl_xor(mx, 8)); mx = fmaxf(mx, __shfl_xor(mx, 16)); mx = fmaxf(mx, __shfl_xor(mx, 32));
        const float ex = expf(r1 - mx);
        float sum = ex;
        sum += __shfl_xor(sum, 4); sum += __shfl_xor(sum, 8); sum += __shfl_xor(sum, 16); sum += __shfl_xor(sum, 32);
        const int eL = ((lane >> 5) & 1) * 8 + ((lane >> 4) & 1) * 4 + ((lane >> 3) & 1) * 2 + ((lane >> 2) & 1);
        if ((lane & 3) == 0) AFFT[(size_t)eL * M + m] = ex / sum;
    }
    WG_SYNC();
}

#define VPH(i) ((i) + ((i) >> 6))
template <int NV> __device__ __forceinline__ void topk_fill(unsigned* VALS, const float* srcf, int tid) {
    const v4u* src = (const v4u*)srcf; v4u t[NV];
#pragma unroll
    for (int j = 0; j < NV; ++j) t[j] = src[j * NTHR + tid];
#pragma unroll
    for (int j = 0; j < NV; ++j) { unsigned* d_ = VALS + VPH((j * NTHR + tid) * 4); d_[0] = t[j].x; d_[1] = t[j].y; d_[2] = t[j].z; d_[3] = t[j].w; }
}
__device__ __forceinline__ void topk_phase(Frame& F) {
    unsigned* VALS = (unsigned*)F.ldsg; unsigned* HIST = (unsigned*)(F.ldsg + 135168); unsigned* SC = (unsigned*)(F.ldsg + 135168 + 8192); unsigned* BC = (unsigned*)(F.ldsg + 135168 + 8192 + 1024);
    static_assert(135168 + 8192 + 1024 + 64 <= SCR_BYTES, "top-k lds");
    const float* AFFT = (const float*)(F.ws + WS_AFFT);
    int* SLOT = (int*)(F.ws + WS_SLOT); int* IDX = (int*)(F.ws + WS_IDX); float* GATE = (float*)(F.ws + WS_GATE);
    float* XRS = (float*)(F.ws + WS_XRS); const float* RSC = (const float*)(F.ws + WS_RSC);
    const int tid = F.tid;
    for (int u = F.vcu; u < 32; u += F.G) {
        const int tr = u >> 4, e = u & 15, n = tr ? NSAMP * TS : TP, base = tr ? TP : 0, cap = n / 8, vpt = n / NTHR;
        WG_SYNC();
        if (tr) topk_fill<16>(VALS, AFFT + (size_t)e * M + base, tid); else topk_fill<4>(VALS, AFFT + (size_t)e * M + base, tid);
        unsigned prefix = 0u, remaining = (unsigned)cap;
        for (int pass = 0; pass < 3; ++pass) {
            const int shift = pass == 0 ? 21 : pass == 1 ? 10 : 0, width = pass == 2 ? 10 : 11; const unsigned mask = (1u << width) - 1u;
            HIST[tid] = 0u; HIST[tid + 512] = 0u; HIST[tid + 1024] = 0u; HIST[tid + 1536] = 0u;
            WG_SYNC();
            for (int i = tid; i < n; i += NTHR) { const unsigned k = VALS[VPH(i)]; if (pass == 0 || (k >> (shift + width)) == prefix) atomicAdd(&HIST[(k >> shift) & mask], 1u); }
            WG_SYNC();
            if (F.wave == 0) {
                const int ln = F.lane; unsigned sl = 0u;
#pragma unroll 8
                for (int q = 0; q < 32; ++q) sl += HIST[32 * ln + ((q + ln) & 31)];
                unsigned suf = sl;
#pragma unroll
                for (int o = 1; o < 64; o <<= 1) { const unsigned t = __shfl_down(suf, o); if (ln + o < 64) suf += t; }
                const unsigned above = suf - sl;
                if (above < remaining && remaining <= above + sl) { unsigned cum = above; int bsel = 0;
                    for (int q = 31; q >= 0; --q) { const unsigned h = HIST[32 * ln + q]; if (cum + h >= remaining) { bsel = q; break; } cum += h; }
                    BC[0] = (unsigned)(32 * ln + bsel); BC[1] = remaining - cum; } }
            WG_SYNC();
            prefix = (prefix << width) | BC[0]; remaining = BC[1];
            WG_SYNC();
        }
        const unsigned thr = prefix, need_eq = remaining;
        unsigned cgt = 0u, ceq = 0u;
        for (int i = 0; i < vpt; ++i) { const unsigned k = VALS[VPH(tid * vpt + i)]; cgt += k > thr; ceq += k == thr; }
        unsigned gtb, eqb;
        {
          unsigned ia = cgt, ib = ceq;
#pragma unroll
          for (int o = 1; o < 64; o <<= 1) { const unsigned ta = __shfl_up(ia, o), tb = __shfl_up(ib, o); if (F.lane >= o) { ia += ta; ib += tb; } }
          if (F.lane == 63) { SC[F.wave] = ia; SC[8 + F.wave] = ib; }
          WG_SYNC();
          unsigned oa = 0u, ob = 0u;
#pragma unroll
          for (int w = 0; w < 8; ++w) { const unsigned xa = SC[w], xb = SC[8 + w]; if (w < F.wave) { oa += xa; ob += xb; } }
          gtb = oa + ia - cgt; eqb = ob + ib - ceq;
          WG_SYNC(); }
        const int xbase = e * XE_PER_E + (tr ? 1024 : 0);
        for (int i = 0; i < vpt; ++i) { const int ix = tid * vpt + i; const unsigned k = VALS[VPH(ix)];
            const bool sel = k > thr || (k == thr && eqb < need_eq);
            const unsigned slot = gtb + (eqb < need_eq ? eqb : need_eq);
            int xr = -1;
            if (sel) { xr = xbase + (int)slot; IDX[xr] = base + ix; GATE[xr] = __uint_as_float(k); XRS[xr] = RSC[base + ix]; }
            VALS[VPH(ix)] = (unsigned)xr;
            gtb += k > thr; eqb += k == thr; }
        WG_SYNC();
        for (int i = tid; i < n; i += NTHR) SLOT[(size_t)e * M + base + i] = (int)VALS[VPH(i)];
    }
    WG_SYNC();
}
__device__ __forceinline__ void gather_phase(Frame& F) {
    const int gw = F.vcu * NWAVES + F.wave, NGW = F.G * NWAVES, lane = F.lane;
    const int* IDX = (const int*)(F.ws + WS_IDX); const bfu* XN = (const bfu*)(F.ws + WS_XN); bfu* XE = (bfu*)(F.ws + WS_PROJ);
    for (int xr = gw; xr < XE_ROWS; xr += NGW) { const int tok = IDX[xr]; const v4u* src = (const v4u*)(XN + (size_t)tok * D); v4u* dst = (v4u*)(XE + (size_t)xr * D);
        v4u a = src[lane], b = src[64 + lane], c = src[128 + lane], d = src[192 + lane]; dst[lane] = a; dst[64 + lane] = b; dst[128 + lane] = c; dst[192 + lane] = d; }
}
__device__ __forceinline__ void ln2_phase(Frame& F, int l) {
    const int gw = F.vcu * NWAVES + F.wave, NGW = F.G * NWAVES, lane = F.lane;
    const float* g = F.in[20] + l * D; const float* b = F.in[21] + l * D;
    const int* SLOT = (const int*)(F.ws + WS_SLOT); const unsigned char* YE = F.ws + WS_PROJ;
    const bool poison = (l + 1 == DEPTH) && __hip_atomic_load(F.ctl + CW_BAR + XB_TMO, RLX_AGENT) != 0u; const float qnan = __builtin_nanf("");
    const bfu* XNb = (const bfu*)(F.ws + WS_XN);
    v4u px[4]; int pxs = -1;
#pragma unroll
    for (int j = 0; j < 4; ++j) px[j] = (v4u){0u, 0u, 0u, 0u};
    if (gw < M) { pxs = lane < 16 ? SLOT[(size_t)lane * M + gw] : -1;
#pragma unroll
        for (int j = 0; j < 4; ++j) px[j] = *(const v4u*)(XNb + (size_t)gw * D + 8 * lane + 512 * j); }
    for (int m = gw; m < M; m += NGW) {
        bfu* xn = (bfu*)(F.ws + WS_XN) + (size_t)m * D;
        f32x4 v[8];
#pragma unroll
        for (int j = 0; j < 4; ++j) { const v4u x = px[j];
            v[2 * j] = (f32x4){__uint_as_float(x.x << 16) * DN_ALPHA, __uint_as_float(x.x & 0xffff0000u) * DN_ALPHA, __uint_as_float(x.y << 16) * DN_ALPHA, __uint_as_float(x.y & 0xffff0000u) * DN_ALPHA};
            v[2 * j + 1] = (f32x4){__uint_as_float(x.z << 16) * DN_ALPHA, __uint_as_float(x.z & 0xffff0000u) * DN_ALPHA, __uint_as_float(x.w << 16) * DN_ALPHA, __uint_as_float(x.w & 0xffff0000u) * DN_ALPHA}; }
        const int xs = pxs;
        if (m + NGW < M) { pxs = lane < 16 ? SLOT[(size_t)lane * M + m + NGW] : -1;
#pragma unroll
            for (int j = 0; j < 4; ++j) px[j] = *(const v4u*)(XNb + (size_t)(m + NGW) * D + 8 * lane + 512 * j); }
        unsigned long long mask = __ballot(xs >= 0);
        while (mask) {
            const int e1 = __builtin_ctzll(mask); mask &= mask - 1ull; const int xr1 = __builtin_amdgcn_readlane(xs, e1);
            if (mask) { const int e2 = __builtin_ctzll(mask); mask &= mask - 1ull; const int xr2 = __builtin_amdgcn_readlane(xs, e2);
                pg8::u32x2 a_[4], b_[4];
#pragma unroll
                for (int j = 0; j < 4; ++j) { a_[j] = *(const pg8::u32x2*)(YE + (size_t)xr1 * D + 8 * lane + 512 * j); b_[j] = *(const pg8::u32x2*)(YE + (size_t)xr2 * D + 8 * lane + 512 * j); }
#pragma unroll
                for (int j = 0; j < 4; ++j) {
                    const pg8::f32x2 a0 = __builtin_amdgcn_cvt_pk_f32_fp8(a_[j].x, false), a1 = __builtin_amdgcn_cvt_pk_f32_fp8(a_[j].x, true), a2 = __builtin_amdgcn_cvt_pk_f32_fp8(a_[j].y, false), a3 = __builtin_amdgcn_cvt_pk_f32_fp8(a_[j].y, true);
                    const pg8::f32x2 b0 = __builtin_amdgcn_cvt_pk_f32_fp8(b_[j].x, false), b1 = __builtin_amdgcn_cvt_pk_f32_fp8(b_[j].x, true), b2 = __builtin_amdgcn_cvt_pk_f32_fp8(b_[j].y, false), b3 = __builtin_amdgcn_cvt_pk_f32_fp8(b_[j].y, true);
                    const float sc = 1.f / YE_SCALE;
                    v[2 * j].x += (a0.x + b0.x) * sc; v[2 * j].y += (a0.y + b0.y) * sc; v[2 * j].z += (a1.x + b1.x) * sc; v[2 * j].w += (a1.y + b1.y) * sc;
                    v[2 * j + 1].x += (a2.x + b2.x) * sc; v[2 * j + 1].y += (a2.y + b2.y) * sc; v[2 * j + 1].z += (a3.x + b3.x) * sc; v[2 * j + 1].w += (a3.y + b3.y) * sc; }
            } else row_add_fp8(YE + (size_t)xr1 * D, v, lane, 1.f / YE_SCALE);
        }
        ln_norm(v, g, b, lane);
        if (poison) {
#pragma unroll
            for (int j = 0; j < 8; ++j) v[j] = (f32x4){qnan, qnan, qnan, qnan}; }
        if (l + 1 < DEPTH) { row_store_bf16(xn, v, lane); row_store_i8(F.ws + WS_XNI8 + (size_t)m * D, (float*)(F.ws + WS_RSC) + m, v, lane); } else row_store_f32(F.X + (size_t)m * D, v, lane);
    }
}


constexpr int NPL = 11, NPH = 1 + DEPTH * NPL;
#if defined(PROBE_CONSIST)
__device__ __forceinline__ void chk_region(Frame& F, const void* base, size_t bytes, unsigned long long* dst, unsigned long long salt) {
    const unsigned* buf = (const unsigned*)base; const size_t nwords = bytes / 4;
    unsigned long long acc = 0ull;
    for (size_t i = (size_t)F.vcu * NTHR + F.tid; i < nwords; i += (size_t)F.G * NTHR) acc += (unsigned long long)buf[i] * (2ull * i + 1ull + salt);
    for (int o = 1; o < 64; o <<= 1) acc += __shfl_xor(acc, o);
    if (F.lane == 0) atomicAdd(dst, acc);
}
__device__ __forceinline__ void probe_chk(Frame& F, int run, int ph) {
    unsigned long long* dst = (unsigned long long*)(F.ws + 512 * 1024) + run * 32 + ph;
    unsigned char* ws = F.ws; const int k = ph == 0 ? -1 : (ph - 1) % NPL;
    if (ph == 0) { chk_region(F, ws + WS_WIN, WS_XN - WS_WIN, dst, 1); chk_region(F, F.X, (size_t)M * D * 4, dst, 3); chk_region(F, ws + WS_XN, (size_t)M * D * 2, dst, 5); }
    else if (k == 0) chk_region(F, ws + WS_PROJ, (size_t)M * PP * 2, dst, 7);
    else if (k == 1) { chk_region(F, ws + WS_PROJ, (size_t)M * PP * 2, dst, 7); chk_region(F, ws + WS_HID, (size_t)NCHUNK * 8 * 8192 * 4, dst, 9); chk_region(F, ws + WS_ADEC, (size_t)NCHUNK * 8 * 64 * 4, dst, 11); }
    else if (k == 2) {
        { const unsigned* buf = (const unsigned*)(ws + WS_MIX); unsigned long long accA = 0ull, accB = 0ull;
          for (size_t i = (size_t)F.vcu * NTHR + F.tid; i < (size_t)M * D / 2; i += (size_t)F.G * NTHR) { const int cw = (int)(i % (D / 2)); const unsigned long long t = (unsigned long long)buf[i] * (2ull * i + 1ull);
              if (cw < 384) accA += t; else if (cw < 768) accB += t; }
          for (int o = 1; o < 64; o <<= 1) { accA += __shfl_xor(accA, o); accB += __shfl_xor(accB, o); }
          if (F.lane == 0) { atomicAdd(dst, accA); atomicAdd(dst + 1, accB); } }
        chk_region(F, ws + WS_HID, (size_t)NCHUNK * 8 * 8192 * 4, dst + 2, 9); chk_region(F, ws + WS_LSE, (size_t)M * 6 * 4, dst + 3, 15); }
    else if (k == 3) chk_region(F, ws + WS_MIX, (size_t)M * D * 2, dst, 13);
    else if (k == 4) chk_region(F, F.X, (size_t)M * D * 4, dst, 3);
    else if (k == 5) { chk_region(F, F.X, (size_t)M * D * 4, dst, 3); chk_region(F, ws + WS_XN, (size_t)M * D * 2, dst, 5); chk_region(F, ws + WS_AFFT, (size_t)16 * M * 4, dst, 17); }
    else if (k == 6) { chk_region(F, ws + WS_SLOT, (size_t)16 * M * 4, dst, 19); chk_region(F, ws + WS_IDX, (size_t)XE_ROWS * 4, dst, 21); chk_region(F, ws + WS_GATE, (size_t)XE_ROWS * 4, dst, 23); }
    else if (k == 7) chk_region(F, ws + WS_PROJ, (size_t)XE_ROWS * D * 2, dst, 25);
    else if (k == 8) chk_region(F, ws + WS_HID, (size_t)XE_ROWS * DFF * 2, dst, 27);
    else if (k == 9) chk_region(F, ws + WS_PROJ, (size_t)XE_ROWS * D * 2, dst, 25);
    else if (k == 10) chk_region(F, F.X, (size_t)M * D * 4, dst, 3);
}
__device__ __forceinline__ void probe_report(Frame& F, int R, int n_out) {
    const unsigned long long* chk = (const unsigned long long*)(F.ws + 512 * 1024);
    int first = 99;
    for (int r = 1; r < R; ++r) for (int p = 0; p < NPH; ++p) if (__hip_atomic_load(chk + r * 32 + p, __ATOMIC_RELAXED, __HIP_MEMORY_SCOPE_AGENT) != __hip_atomic_load(chk + p, __ATOMIC_RELAXED, __HIP_MEMORY_SCOPE_AGENT)) { if (p < first) first = p; break; }
    const float c = first == 99 ? 2.0f : 3.0f + (float)first;
    for (long i = (long)F.vcu * NTHR + F.tid; i < n_out; i += (long)F.G * NTHR) F.X[i] = c;
}
#endif
struct Args { const float* in[22]; float* out; unsigned char* ws; int ph_lo, ph_hi, run, pad; };
#define KARG_RUN() (((const Args __attribute__((address_space(4)))*)__builtin_amdgcn_kernarg_segment_ptr())->run)
__global__ void __launch_bounds__(NWAVES * 64, 2) trunk_fwd(Args args) {
    extern __shared__ __attribute__((aligned(16))) unsigned char lds[];
    Frame F;
    F.lds = (LAS unsigned char*)lds; F.ldsg = (char*)lds;
    F.MISC = (volatile LAS unsigned*)(F.lds + MISC_OFF);
    F.tid = threadIdx.x; F.lane = F.tid & 63; F.wave = __builtin_amdgcn_readfirstlane(F.tid >> 6);
#define KAS __attribute__((address_space(4)))
#define REFRESH() do { const unsigned char KAS* ka_ = (const unsigned char KAS*)__builtin_amdgcn_kernarg_segment_ptr(); asm volatile("" : "+s"(ka_)); const Args KAS* ap_ = (const Args KAS*)ka_; \
    _Pragma("unroll") for (int i_ = 0; i_ < 22; ++i_) F.in[i_] = ap_->in[i_]; F.X = ap_->out; F.ws = ap_->ws; F.ctl = (gu32*)(F.ws + WS_CTL); \
    F.tid = threadIdx.x; asm volatile("" : "+v"(F.tid)); F.lane = F.tid & 63; F.wave = __builtin_amdgcn_readfirstlane(F.tid >> 6); \
    { int bx_ = blockIdx.x, g_ = gridDim.x; asm volatile("" : "+s"(bx_), "+s"(g_)); F.G = g_; F.bx = bx_; F.vcu = (g_ % 8 == 0) ? (bx_ % 8) * (g_ / 8) + bx_ / 8 : bx_; } } while (0)
    REFRESH();
    for (int u = F.tid; u < (LDS_BYTES - LDSCTL_OFF) / 4; u += NWAVES * 64) ((LAS unsigned*)(F.lds + LDSCTL_OFF))[u] = 0u;
    __syncthreads();
#if MK_FIXED_RANGE
    const bool multi = true;
#else
    const int lo = args.ph_lo, hi = args.ph_hi;
    const bool multi = (hi - lo) > 1;
#endif
    XcdBarrier bar; bar.bar = (unsigned*)(F.ctl + CW_BAR) + args.run * XCD_BAR_WORDS; bar.x = 0; bar.st = nullptr;
    if (multi) bar = xcd_barrier_post((unsigned*)(F.ctl + CW_BAR) + args.run * XCD_BAR_WORDS, F.MISC + 8);
#ifndef TIMING_DUP
#define TIMING_DUP 0
#endif
#ifndef PHASE_MASK
#define PHASE_MASK 0xFFFFFFFFu
#endif
#define PM(b) ((PHASE_MASK >> (b)) & 1u)
#if MK_FIXED_RANGE
#define IN(k) true
#else
#define IN(k) (lo <= (k) && (k) < hi)
#endif
#if defined(PROBE_CONSIST)
#define SEAM(k) do { if (IN(k)) { xcd_barrier(bar); REFRESH(); probe_chk(F, KARG_RUN(), (k)); if (IN((k) + 1)) xcd_barrier(bar); } } while (0)
#else
#define SEAM(k) do { if (IN(k) && IN((k) + 1)) xcd_barrier(bar); } while (0)
#endif
#define XN_ ((bfu*)(F.ws + WS_XN))
#define PROJ_ ((bfu*)(F.ws + WS_PROJ))
#define MIX_ ((bfu*)(F.ws + WS_MIX))
#define HID_ ((bfu*)(F.ws + WS_HID))

    if (IN(0) && PM(0)) { REFRESH(); p0_prologue(F);
#if (TIMING_DUP & 32)
        __syncthreads(); p0_prologue(F);
#endif
    } SEAM(0);
    {
        constexpr int l = 0; constexpr int pb = 1 + l * NPL;
        if (IN(pb + 0) && PM(1)) { REFRESH();
            const bool split = (l == 0) && F.G > 2 * NCONV;
            const int GW = split ? F.G - NCONV : F.G;
            if (F.bx < GW) {
            {
              pg8::Gemm g{(const bfu*)(F.ws + WS_XNI8), (const bfu*)(F.ws + WS_WINI8 + l * WINI8_L), M, DIN_PAD, D / 2  , 0}; pg8::StaticOrder S; S.init(M, DIN_PAD, GW, F.bx);
              pg8::EpiProjI8 E{PROJ_, PP, DIN, 0, (const float*)(F.ws + WS_RSC), (const float*)(F.ws + WS_CSC) + l * DIN_PAD};
              pg8::gemm_phase<pg8::EpiProjI8, pg8::StaticOrder, true, true, false, false, true>(F.lds, g, S, E); }
            } else conv_worker(F, F.bx - GW, NCONV);
        } SEAM(pb + 0);
        if (IN(pb + 1) && PM(2)) { REFRESH(); if (PM(12)) { qk_prep(F, l); vt8_pass(F); } if (PM(13)) gla::c1_phase(F, l);
#if (TIMING_DUP & 8)
            gla::c1_phase(F, l);
#endif
            } SEAM(pb + 1);
        if (IN(pb + 2) && PM(3)) { REFRESH(); if (PM(14)) attn_a_phase(F);
#if (TIMING_DUP & 2)
            attn_a_phase(F);
#endif
            if (PM(15)) mixb::mixer_b_phase(F);
#if (TIMING_DUP & 4)
            mixb::mixer_b_phase(F);
#endif
            if (PM(16)) gla::c2_phase(F); } SEAM(pb + 2);
        if (IN(pb + 3) && PM(4)) { REFRESH(); if (PM(17)) gla::c3_phase(F, l);
#if (TIMING_DUP & 8)
            gla::c3_phase(F, l);
#endif
            } SEAM(pb + 3);
        if (IN(pb + 4) && PM(5)) { REFRESH();
            mixb::mix_row_pass(F); xcd_barrier(bar); REFRESH();
            pg8::Gemm g{(const bfu*)(F.ws + WS_MIXI8), (const bfu*)(F.ws + WS_WOUTI8 + l * WOUTI8_L), M, D, D / 2  , 0}; pg8::StaticOrder S; S.init(M, D, F.G, F.bx);
            pg8::EpiProjI8 E{HID_  , D, D, 0, (const float*)(F.ws + WS_RSC2), (const float*)(F.ws + WS_CSC2) + l * D};
            pg8::gemm_phase<pg8::EpiProjI8, pg8::StaticOrder, true, true, false, false, true>(F.lds, g, S, E);
        } SEAM(pb + 4);
        if (IN(pb + 5) && PM(6)) { REFRESH(); ln1_router_phase(F, l); } SEAM(pb + 5);
        if (IN(pb + 6) && PM(7)) { REFRESH(); topk_phase(F);
#if (TIMING_DUP & 16)
            topk_phase(F);
#endif
            if (F.G <= 32) conv_window(F, l, F.vcu, F.G); else if (F.vcu >= 32) conv_window(F, l, F.vcu - 32, F.G - 32);
            } SEAM(pb + 6);
        if (IN(pb + 8) && PM(9)) { REFRESH();
            pg8::Gemm g{(const bfu*)(F.ws + WS_XNI8)  , (const bfu*)(F.ws + WS_WGU + l * WGU_L), XE_ROWS, 2 * DFF, D / 2  , WGU_E}; pg8::StaticOrder S; S.init(XE_ROWS, 2 * DFF, F.G, F.bx, XE_PER_E / 256);
            pg8::EpiSwiGLUI8 E{F.ws + WS_HID, DFF, (const float*)(F.ws + WS_XRS), (const float*)(F.ws + WS_CSCGU) + (size_t)l * NEXP * 4096};
            pg8::gemm_phase<pg8::EpiSwiGLUI8, pg8::StaticOrder, true, true, true, false, true>(F.lds, g, S, E, (const int*)(F.ws + WS_IDX));
#if (TIMING_DUP & 1)
            __syncthreads(); pg8::gemm_phase<pg8::EpiSwiGLU8, pg8::StaticOrder, true, true, true, true>(F.lds, g, S, E, (const int*)(F.ws + WS_IDX));
#endif
        } SEAM(pb + 8);
        if (IN(pb + 9) && PM(10)) { REFRESH();
#if defined(NOP_SLED)
            asm volatile(".rept 16384\n s_nop 0\n .endr" ::: "memory");
#endif
            pg8::Gemm g{HID_  , (const bfu*)(F.ws + WS_WD + l * WD_L), XE_ROWS, D, DFF / 2  , WD_E}; pg8::StaticOrder S; S.init(XE_ROWS, D, F.G, F.bx, XE_PER_E / 256);
            pg8::EpiGate8 E{F.ws + WS_PROJ  , D, (const float*)(F.ws + WS_GATE), YE_SCALE / WD_SCALE};
            pg8::gemm_phase<pg8::EpiGate8, pg8::StaticOrder, true, true, false, true>(F.lds, g, S, E);
#if (TIMING_DUP & 1)
            __syncthreads(); pg8::gemm_phase<pg8::EpiGate8, pg8::StaticOrder, true, true, false, true>(F.lds, g, S, E);
#endif
        } SEAM(pb + 9);
        if (IN(pb + 10) && PM(11)) { REFRESH(); ln2_phase(F, l); } SEAM(pb + 10);
    }
    {
        constexpr int l = 1; constexpr int pb = 1 + l * NPL;
        if (IN(pb + 0) && PM(1)) { REFRESH();
            const bool split = (l == 0) && F.G > 2 * NCONV;
            const int GW = split ? F.G - NCONV : F.G;
            if (F.bx < GW) {
            {
              pg8::Gemm g{(const bfu*)(F.ws + WS_XNI8), (const bfu*)(F.ws + WS_WINI8 + l * WINI8_L), M, DIN_PAD, D / 2  , 0}; pg8::StaticOrder S; S.init(M, DIN_PAD, GW, F.bx);
              pg8::EpiProjI8 E{PROJ_, PP, DIN, 0, (const float*)(F.ws + WS_RSC), (const float*)(F.ws + WS_CSC) + l * DIN_PAD};
              pg8::gemm_phase<pg8::EpiProjI8, pg8::StaticOrder, true, true, false, false, true>(F.lds, g, S, E); }
            } else conv_worker(F, F.bx - GW, NCONV);
        } SEAM(pb + 0);
        if (IN(pb + 1) && PM(2)) { REFRESH(); if (PM(12)) { qk_prep(F, l); vt8_pass(F); } if (PM(13)) gla::c1_phase(F, l);
#if (TIMING_DUP & 8)
            gla::c1_phase(F, l);
#endif
            } SEAM(pb + 1);
        if (IN(pb + 2) && PM(3)) { REFRESH(); if (PM(14)) attn_a_phase(F);
#if (TIMING_DUP & 2)
            attn_a_phase(F);
#endif
            if (PM(15)) mixb::mixer_b_phase(F);
#if (TIMING_DUP & 4)
            mixb::mixer_b_phase(F);
#endif
            if (PM(16)) gla::c2_phase(F); } SEAM(pb + 2);
        if (IN(pb + 3) && PM(4)) { REFRESH(); if (PM(17)) gla::c3_phase(F, l);
#if (TIMING_DUP & 8)
            gla::c3_phase(F, l);
#endif
            } SEAM(pb + 3);
        if (IN(pb + 4) && PM(5)) { REFRESH();
            mixb::mix_row_pass(F); xcd_barrier(bar); REFRESH();
            pg8::Gemm g{(const bfu*)(F.ws + WS_MIXI8), (const bfu*)(F.ws + WS_WOUTI8 + l * WOUTI8_L), M, D, D / 2  , 0}; pg8::StaticOrder S; S.init(M, D, F.G, F.bx);
            pg8::EpiProjI8 E{HID_  , D, D, 0, (const float*)(F.ws + WS_RSC2), (const float*)(F.ws + WS_CSC2) + l * D};
            pg8::gemm_phase<pg8::EpiProjI8, pg8::StaticOrder, true, true, false, false, true>(F.lds, g, S, E);
        } SEAM(pb + 4);
        if (IN(pb + 5) && PM(6)) { REFRESH(); ln1_router_phase(F, l); } SEAM(pb + 5);
        if (IN(pb + 6) && PM(7)) { REFRESH(); topk_phase(F);
#if (TIMING_DUP & 16)
            topk_phase(F);
#endif
            if (F.G <= 32) conv_window(F, l, F.vcu, F.G); else if (F.vcu >= 32) conv_window(F, l, F.vcu - 32, F.G - 32);
            } SEAM(pb + 6);
        if (IN(pb + 8) && PM(9)) { REFRESH();
            pg8::Gemm g{(const bfu*)(F.ws + WS_XNI8)  , (const bfu*)(F.ws + WS_WGU + l * WGU_L), XE_ROWS, 2 * DFF, D / 2  , WGU_E}; pg8::StaticOrder S; S.init(XE_ROWS, 2 * DFF, F.G, F.bx, XE_PER_E / 256);
            pg8::EpiSwiGLUI8 E{F.ws + WS_HID, DFF, (const float*)(F.ws + WS_XRS), (const float*)(F.ws + WS_CSCGU) + (size_t)l * NEXP * 4096};
            pg8::gemm_phase<pg8::EpiSwiGLUI8, pg8::StaticOrder, true, true, true, false, true>(F.lds, g, S, E, (const int*)(F.ws + WS_IDX));
#if (TIMING_DUP & 1)
            __syncthreads(); pg8::gemm_phase<pg8::EpiSwiGLU8, pg8::StaticOrder, true, true, true, true>(F.lds, g, S, E, (const int*)(F.ws + WS_IDX));
#endif
        } SEAM(pb + 8);
        if (IN(pb + 9) && PM(10)) { REFRESH();
#if defined(NOP_SLED)
            asm volatile(".rept 16384\n s_nop 0\n .endr" ::: "memory");
#endif
            pg8::Gemm g{HID_  , (const bfu*)(F.ws + WS_WD + l * WD_L), XE_ROWS, D, DFF / 2  , WD_E}; pg8::StaticOrder S; S.init(XE_ROWS, D, F.G, F.bx, XE_PER_E / 256);
            pg8::EpiGate8 E{F.ws + WS_PROJ  , D, (const float*)(F.ws + WS_GATE), YE_SCALE / WD_SCALE};
            pg8::gemm_phase<pg8::EpiGate8, pg8::StaticOrder, true, true, false, true>(F.lds, g, S, E);
#if (TIMING_DUP & 1)
            __syncthreads(); pg8::gemm_phase<pg8::EpiGate8, pg8::StaticOrder, true, true, false, true>(F.lds, g, S, E);
#endif
        } SEAM(pb + 9);
        if (IN(pb + 10) && PM(11)) { REFRESH(); ln2_phase(F, l); } SEAM(pb + 10);
    }
#undef IN
#undef SEAM
}


#if defined(PROBE_CONSIST)
__global__ void __launch_bounds__(256) chk_report(const unsigned long long* chk, int R, int nph, float* out, int n_out) {
    int first = 99;
    for (int r = 1; r < R; ++r) for (int p = 0; p < nph; ++p) if (chk[r * 32 + p] != chk[p]) { if (p < first) first = p; break; }
    const float c = first == 99 ? 2.0f : 3.0f + (float)first;
    for (long i = (long)blockIdx.x * 256 + threadIdx.x; i < n_out; i += (long)gridDim.x * 256) out[i] = c;
}
#endif
#ifndef MK_ONE_LAUNCH
#define MK_ONE_LAUNCH 1
#endif
extern "C" void kernel_launch(void* const* d_in, const int* in_sizes, int n_in, void* d_out, int out_size, void* d_ws, size_t ws_size, hipStream_t stream) {
    static int grid = 0;
    if (grid == 0) {
        if (n_in != 22 || out_size != M * D || ws_size < WS_END) { fprintf(stderr, "kernel_launch: shape mismatch (n_in %d out %d ws %zu, need ws >= %zu); nothing launched\n", n_in, out_size, ws_size, (size_t)WS_END); grid = -1; return; }
        int dev = 0, cus = 0, per_cu = 0;
        if (hipGetDevice(&dev) != hipSuccess || hipDeviceGetAttribute(&cus, hipDeviceAttributeMultiprocessorCount, dev) != hipSuccess) { grid = -1; return; }
        if (hipFuncSetAttribute((const void*)trunk_fwd, hipFuncAttributeMaxDynamicSharedMemorySize, LDS_BYTES) != hipSuccess) { fprintf(stderr, "kernel_launch: hipFuncSetAttribute failed\n"); grid = -1; return; }
        if (hipOccupancyMaxActiveBlocksPerMultiprocessor(&per_cu, (const void*)trunk_fwd, NWAVES * 64, LDS_BYTES) != hipSuccess || per_cu < 1)
            fprintf(stderr, "kernel_launch: note: occupancy query reports %d workgroups per CU\n", per_cu);
        (void)hipGetLastError();
        grid = cus;
    }
    if (grid < 0) return;
#if defined(PROBE_POISON)
    (void)hipMemsetAsync((char*)d_ws + 2 * MiB, 0xAA, WS_END - 2 * MiB, stream); (void)hipMemsetAsync(d_out, 0xAA, (size_t)M * D * 4, stream);
#endif
    if (hipMemsetAsync((char*)d_ws + WS_CTL, 0, CTL_ZERO_BYTES, stream) != hipSuccess) return;
    Args a{};
    for (int i = 0; i < 22; ++i) a.in[i] = (const float*)d_in[i];
    a.out = (float*)d_out; a.ws = (unsigned char*)d_ws;
#ifndef CUT_MASK
#define CUT_MASK 0u
#endif
#if defined(PROBE_CONSIST)
    for (int r = 0; r < PROBE_CONSIST; ++r) { a.ph_lo = 0; a.ph_hi = NPH; a.run = r; hipLaunchKernelGGL(trunk_fwd, dim3(grid), dim3(NWAVES * 64), LDS_BYTES, stream, a); }
    hipLaunchKernelGGL(chk_report, dim3(1024), dim3(256), 0, stream, (const unsigned long long*)((char*)d_ws + 512 * 1024), (int)PROBE_CONSIST, NPH, (float*)d_out, out_size);
#else
    { int lo = 0;
      for (int ph = 0; ph < NPH; ++ph) {
          const bool cut = (ph == NPH - 1) || ((CUT_MASK >> ph) & 1u) || !MK_ONE_LAUNCH;
          if (cut) { a.ph_lo = lo; a.ph_hi = ph + 1; if (lo != 0 && ph + 1 - lo > 1) (void)hipMemsetAsync((char*)d_ws + WS_CTL, 0, CTL_ZERO_BYTES, stream); hipLaunchKernelGGL(trunk_fwd, dim3(grid), dim3(NWAVES * 64), LDS_BYTES, stream, a); lo = ph + 1; }
      } }

#endif
    const hipError_t le = hipPeekAtLastError();
    if (le != hipSuccess) fprintf(stderr, "kernel_launch: launch failed: %s\n", hipGetErrorName(le));
}
```
